# Optimizing an MI355X kernel written in HIP

```python
import math
import jax, jax.numpy as jnp
from jax import lax
import numpy as np

D_MODEL = 1024
BATCH = 32
SEQ = 256
DEPTH = 4
DEC_BATCH = 4
DEC_SEQ = 4096
PAST_LEN = 256

GRID_W = 64
A_HEADS = 4
A_DK = 128
A_DV = 128
A_KW = A_HEADS * A_DK
A_WIDTH = A_HEADS * A_DV
B_HEADS = 16
B_HEADDIM = 64
B_WIDTH = B_HEADS * B_HEADDIM
B_GROUPS = 4
B_STATE = 64
B_CONV_CH = B_WIDTH + 2 * B_GROUPS * B_STATE
CONV_W = 3
D_FF = 2816
A_CHUNK = 32
B_CHUNK = 64
N_MOD = 6
EPS = 1e-6
IN_SIZES = (A_KW, A_WIDTH, A_KW, A_KW, A_WIDTH, B_WIDTH, B_CONV_CH, B_HEADS, B_HEADS, 2 * D_MODEL)
IN_COLS = sum(IN_SIZES)

kernel_name = 'hybrid_hgrn2_ssd_diffusion_step'


def _split_points():
    pts, acc = [], 0
    for s in IN_SIZES[:-1]:
        acc += s
        pts.append(acc)
    return pts


def _rmsnorm(x, gain):
    xf = x.astype(jnp.float32)
    y = xf * lax.rsqrt(jnp.mean(xf * xf, axis=-1, keepdims=True) + EPS)
    return (y * gain.astype(jnp.float32)).astype(x.dtype)


def _group_rmsnorm(x, gain, groups):
    shp = x.shape
    xf = x.astype(jnp.float32).reshape(shp[:-1] + (groups, shp[-1] // groups))
    y = xf * lax.rsqrt(jnp.mean(xf * xf, axis=-1, keepdims=True) + EPS)
    return (y.reshape(shp) * gain.astype(jnp.float32)).astype(x.dtype)


def _flip(t):
    return jnp.flip(t, axis=1)


def _dwconv(x, w, b):
    l = x.shape[1]
    pad = CONV_W // 2
    xp = jnp.pad(x, ((0, 0), (pad, pad), (0, 0)))
    out = b
    for k in range(CONV_W):
        out = out + xp[:, k:k + l] * w[k]
    return out


def _seq_conv(x, w, b, on_grid):
    if on_grid:
        bsz, l, ch = x.shape
        rows = l // GRID_W
        return _dwconv(x.reshape(bsz * rows, GRID_W, ch), w, b).reshape(bsz, l, ch)
    return _dwconv(x, w, b)


def _chunks(t, csize):
    b, l, h, f = t.shape
    return t.reshape(b, l // csize, csize, h, f).transpose(1, 0, 3, 2, 4)


def _unchunk(t):
    n, b, h, c, f = t.shape
    return t.transpose(1, 0, 3, 2, 4).reshape(b, n * c, h, f)


def _hgrn2_scan(q, k, v, log_f, s0):
    f32 = jnp.float32
    mask = jnp.tril(jnp.ones((A_CHUNK, A_CHUNK), bool))[:, :, None]

    def step(S, inp):
        qc, kc, vc, gc = inp
        bcum = jnp.cumsum(gc, axis=2)
        diff = bcum[:, :, :, None, :] - bcum[:, :, None, :, :]
        decay = jnp.where(mask, jnp.exp(jnp.where(mask, diff, 0.0)), 0.0)
        scores = jnp.einsum('bhtk,bhsk,bhtsk->bhts', qc, kc, decay)
        o = (jnp.einsum('bhts,bhsv->bhtv', scores, vc)
             + jnp.einsum('bhtk,bhkv->bhtv', qc * jnp.exp(bcum), S))
        blast = bcum[:, :, -1:, :]
        S = (jnp.exp(bcum[:, :, -1, :])[..., None] * S
             + jnp.einsum('bhsk,bhsv->bhkv', kc * jnp.exp(blast - bcum), vc))
        return S, o

    xs = tuple(_chunks(t.astype(f32), A_CHUNK) for t in (q, k, v, log_f))
    s_fin, o = lax.scan(step, s0.astype(f32), xs)
    return _unchunk(o), s_fin


def _ssd_scan(xs, dt, a, bm, cm, s0):
    f32 = jnp.float32
    b, l, h, p = xs.shape
    g, n = bm.shape[2], bm.shape[3]
    j = h // g
    nc = l // B_CHUNK
    xc = xs.astype(f32).reshape(b, nc, B_CHUNK, g, j, p).transpose(1, 0, 3, 4, 2, 5)
    dtc = dt.astype(f32).reshape(b, nc, B_CHUNK, g, j).transpose(1, 0, 3, 4, 2)
    ac = a.astype(f32).reshape(b, nc, B_CHUNK, g, j).transpose(1, 0, 3, 4, 2)
    bc = bm.astype(f32).reshape(b, nc, B_CHUNK, g, n).transpose(1, 0, 3, 2, 4)
    cc = cm.astype(f32).reshape(b, nc, B_CHUNK, g, n).transpose(1, 0, 3, 2, 4)
    mask = jnp.tril(jnp.ones((B_CHUNK, B_CHUNK), bool))

    def step(S, inp):
        xq, dq, aq, bq, cq = inp
        acum = jnp.cumsum(aq, axis=-1)
        seg = acum[..., :, None] - acum[..., None, :]
        lmat = jnp.where(mask, jnp.exp(jnp.where(mask, seg, 0.0)), 0.0)
        cb = jnp.einsum('bgtn,bgsn->bgts', cq, bq)
        y = jnp.einsum('bgjts,bgjsp->bgjtp', cb[:, :, None] * lmat, xq * dq[..., None])
        y = y + jnp.einsum('bgtn,bgjpn->bgjtp', cq, S) * jnp.exp(acum)[..., None]
        alast = acum[..., -1:]
        wgt = jnp.exp(alast - acum) * dq
        S = jnp.exp(alast)[..., None] * S + jnp.einsum('bgjs,bgsn,bgjsp->bgjpn', wgt, bq, xq)
        return S, y

    s_fin, y = lax.scan(step, s0.astype(f32).reshape(b, g, j, p, n), (xc, dtc, ac, bc, cc))
    y = y.transpose(1, 0, 4, 2, 3, 5).reshape(b, l, h, p)
    return y, s_fin.reshape(b, h, p, n)


def _mixer(u, on_grid, s_a, s_b, lp):
    f32 = jnp.float32
    bsz, l, _ = u.shape
    proj = u @ lp['w_in']
    q, i_in, f_fw, f_bw, g_a, z, xbc, dt_fw, dt_bw, gates = jnp.split(proj, _split_points(), axis=-1)

    qh = jax.nn.silu(q).reshape(bsz, l, A_HEADS, A_DK)
    vh = i_in.reshape(bsz, l, A_HEADS, A_DV)
    outs_a, fin_a = [], []
    for d, (fraw, s0) in enumerate(((f_fw, s_a[0]), (f_bw, s_a[1]))):
        lbd = lp['lb'][d]
        fx = fraw.astype(f32)
        log_f = jnp.logaddexp(jnp.log(lbd), jnp.log1p(-lbd) + jax.nn.log_sigmoid(fx))
        kk = (1.0 - lbd) * jax.nn.sigmoid(-fx)
        args = (qh, kk.reshape(bsz, l, A_HEADS, A_DK), vh, log_f.reshape(bsz, l, A_HEADS, A_DK))
        if d == 1:
            args = tuple(_flip(t) for t in args)
        o, sf = _hgrn2_scan(*args, s0)
        if d == 1:
            o = _flip(o)
        outs_a.append(o)
        fin_a.append(sf)
    o_a = (outs_a[0] + outs_a[1]).reshape(bsz, l, A_WIDTH).astype(u.dtype)
    o_a = _group_rmsnorm(o_a, lp['a_norm'], A_HEADS) * jax.nn.silu(g_a)

    xbc = jax.nn.silu(_seq_conv(xbc, lp['conv_w'], lp['conv_b'], on_grid))
    xs, bm, cm = jnp.split(xbc, [B_WIDTH, B_WIDTH + B_GROUPS * B_STATE], axis=-1)
    xs = xs.reshape(bsz, l, B_HEADS, B_HEADDIM)
    bm = bm.reshape(bsz, l, B_GROUPS, B_STATE)
    cm = cm.reshape(bsz, l, B_GROUPS, B_STATE)
    outs_b, fin_b = [], []
    for d, (dtraw, s0) in enumerate(((dt_fw, s_b[0]), (dt_bw, s_b[1]))):
        dt = jax.nn.softplus(dtraw.astype(f32) + lp['dt_bias'][d].astype(f32))
        a = -jnp.exp(lp['a_log'][d].astype(f32)) * dt
        args = (xs, dt, a, bm, cm)
        if d == 1:
            args = tuple(_flip(t) for t in args)
        y, sf = _ssd_scan(*args, s0)
        if d == 1:
            y = _flip(y)
        outs_b.append(y)
        fin_b.append(sf)
    y_b = outs_b[0] + outs_b[1] + lp['d_skip'].astype(f32)[:, None] * xs.astype(f32)
    y_b = y_b.reshape(bsz, l, B_WIDTH).astype(u.dtype) * jax.nn.silu(z)
    y_b = _group_rmsnorm(y_b, lp['b_norm'], B_GROUPS)

    g_A, g_B = jnp.split(jax.nn.sigmoid(gates), 2, axis=-1)
    merged = g_A * (o_a @ lp['w_br_a']) + g_B * (y_b @ lp['w_br_b'])
    return merged @ lp['w_out'], (fin_a[0], fin_a[1], fin_b[0], fin_b[1])


def _conv_ffn(u, on_grid, lp):
    h = _seq_conv(u @ lp['w_ff_up'], lp['ff_conv_w'], lp['ff_conv_b'], on_grid)
    a, b = jnp.split(h, 2, axis=-1)
    return (jax.nn.silu(a) * b) @ lp['w_ff_down']


def _block(x, mod, on_grid, s_a, s_b, lp):
    sh1, sc1, g1, sh2, sc2, g2 = jnp.split(mod[:, None, :], N_MOD, axis=-1)
    u = _rmsnorm(x, lp['ln1']) * (1.0 + sc1) + sh1
    mix, fin = _mixer(u, on_grid, s_a, s_b, lp)
    x = x + g1 * mix
    u = _rmsnorm(x, lp['ln2']) * (1.0 + sc2) + sh2
    x = x + g2 * _conv_ffn(u, on_grid, lp)
    return x, fin


def setup_inputs(seed: int = 0) -> dict:
    key = jax.random.key(seed)
    ks = jax.random.split(key, 32)
    f32 = jnp.float32

    def nrm(k, shape, scale):
        return scale * jax.random.normal(k, shape, f32)

    dt0 = jnp.exp(jax.random.uniform(ks[16], (DEPTH, 2, B_HEADS), f32, math.log(1e-3), math.log(1e-1)))
    return {
        'x_prompt': nrm(ks[0], (BATCH, SEQ, D_MODEL), 1.0),
        'x_sample': nrm(ks[1], (DEC_BATCH, DEC_SEQ, D_MODEL), 1.0),
        'c': nrm(ks[2], (DEC_BATCH, D_MODEL), 1.0),
        'state_hgrn': nrm(ks[3], (DEC_BATCH, DEPTH, 2, A_HEADS, A_DK, A_DV), 0.5),
        'state_ssd': nrm(ks[4], (DEC_BATCH, DEPTH, 2, B_HEADS, B_HEADDIM, B_STATE), 0.5),
        'c_ctx': nrm(ks[5], (D_MODEL,), 1.0),
        'w_ada': nrm(ks[6], (DEPTH, D_MODEL, N_MOD * D_MODEL), 0.3 * D_MODEL ** -0.5),
        'b_ada': nrm(ks[7], (DEPTH, N_MOD * D_MODEL), 0.02),
        'ln1': 1.0 + nrm(ks[8], (DEPTH, D_MODEL), 0.02),
        'ln2': 1.0 + nrm(ks[9], (DEPTH, D_MODEL), 0.02),
        'ln_f': 1.0 + nrm(ks[10], (D_MODEL,), 0.02),
        'w_in': nrm(ks[11], (DEPTH, D_MODEL, IN_COLS), D_MODEL ** -0.5),
        'lb_logits': nrm(ks[12], (DEPTH, 2, A_KW), 1.0),
        'a_norm': 1.0 + nrm(ks[13], (DEPTH, A_WIDTH), 0.02),
        'conv_w': nrm(ks[14], (DEPTH, CONV_W, B_CONV_CH), CONV_W ** -0.5),
        'conv_b': nrm(ks[15], (DEPTH, B_CONV_CH), 0.02),
        'dt_bias': dt0 + jnp.log(-jnp.expm1(-dt0)),
        'a_log': jnp.log(jax.random.uniform(ks[17], (DEPTH, 2, B_HEADS), f32, 1.0, 16.0)),
        'd_skip': 1.0 + nrm(ks[18], (DEPTH, B_HEADS), 0.1),
        'b_norm': 1.0 + nrm(ks[19], (DEPTH, B_WIDTH), 0.02),
        'w_br_a': nrm(ks[20], (DEPTH, A_WIDTH, D_MODEL), A_WIDTH ** -0.5),
        'w_br_b': nrm(ks[21], (DEPTH, B_WIDTH, D_MODEL), B_WIDTH ** -0.5),
        'w_out': nrm(ks[22], (DEPTH, D_MODEL, D_MODEL), D_MODEL ** -0.5),
        'w_ff_up': nrm(ks[23], (DEPTH, D_MODEL, 2 * D_FF), D_MODEL ** -0.5),
        'ff_conv_w': nrm(ks[24], (DEPTH, CONV_W, 2 * D_FF), CONV_W ** -0.5),
        'ff_conv_b': nrm(ks[25], (DEPTH, 2 * D_FF), 0.02),
        'w_ff_down': nrm(ks[26], (DEPTH, D_FF, D_MODEL), D_FF ** -0.5),
    }


def reference(x_prompt, x_sample, c, state_hgrn, state_ssd, c_ctx, w_ada, b_ada, ln1, ln2, ln_f,
              w_in, lb_logits, a_norm, conv_w, conv_b, dt_bias, a_log, d_skip, b_norm,
              w_br_a, w_br_b, w_out, w_ff_up, ff_conv_w, ff_conv_b, w_ff_down):
    f32 = jnp.float32
    lb_all = jnp.cumsum(jax.nn.softmax(lb_logits.astype(f32), axis=0), axis=0)
    lb_all = jnp.maximum(lb_all - lb_all[0:1], 0.0)
    layers = [dict(ln1=ln1[l], ln2=ln2[l], w_in=w_in[l], lb=lb_all[l], a_norm=a_norm[l],
                   conv_w=conv_w[l], conv_b=conv_b[l], dt_bias=dt_bias[l], a_log=a_log[l],
                   d_skip=d_skip[l], b_norm=b_norm[l], w_br_a=w_br_a[l], w_br_b=w_br_b[l],
                   w_out=w_out[l], w_ff_up=w_ff_up[l], ff_conv_w=ff_conv_w[l],
                   ff_conv_b=ff_conv_b[l], w_ff_down=w_ff_down[l]) for l in range(DEPTH)]

    bp = x_prompt.shape[0]
    za = jnp.zeros((bp, A_HEADS, A_DK, A_DV), f32)
    zb = jnp.zeros((bp, B_HEADS, B_HEADDIM, B_STATE), f32)
    h = x_prompt
    st_a, st_b = [], []
    for l in range(DEPTH):
        mod = (jax.nn.silu(c_ctx) @ w_ada[l] + b_ada[l])[None]
        h, fin = _block(h, mod, False, (za, za), (zb, zb), layers[l])
        st_a.append(jnp.stack(fin[:2], axis=1))
        st_b.append(jnp.stack(fin[2:], axis=1))
    y_prompt = _rmsnorm(h, ln_f)
    new_state_hgrn = jnp.stack(st_a, axis=1).astype(x_prompt.dtype)
    new_state_ssd = jnp.stack(st_b, axis=1).astype(x_prompt.dtype)

    h = x_sample
    for l in range(DEPTH):
        mod = jax.nn.silu(c) @ w_ada[l] + b_ada[l]
        sa = state_hgrn[:, l]
        sb = state_ssd[:, l]
        h, _ = _block(h, mod, True, (sa[:, 0], sa[:, 1]), (sb[:, 0], sb[:, 1]), layers[l])
    y_sample = _rmsnorm(h, ln_f)
    return (y_prompt, y_sample, new_state_hgrn, new_state_ssd)
```

```cpp
#include <hip/hip_runtime.h>
#include <hip/hip_cooperative_groups.h>
#include <cstdio>
namespace cg = cooperative_groups;
#define MULTI 1
namespace pg8 {
#define PG8_LAS __attribute__((address_space(3)))
typedef unsigned short bf16_t;
typedef short bf16x8 __attribute__((ext_vector_type(8)));
typedef float f32x4 __attribute__((ext_vector_type(4)));
typedef unsigned u32x4 __attribute__((ext_vector_type(4)));
constexpr int BM = 256, BK = 64, HALF = 128, HTB = HALF * BK * 2  , STAGE_BYTES = 8 * HTB, NXCD = 8, WGM = 8;

__host__ __device__ __forceinline__ int lds_byte(int r, int c) { const int st = (r >> 4) * 2 + (c >> 5), rr = r & 15, cc = c & 31, ob = rr * 64 + cc * 2; return st * 1024 + (ob ^ (((ob >> 9) & 1) << 5)); }
__host__ __device__ __forceinline__ void stage_rc(int b, int& R, int& C) { const int st = b / 1024, sb = b % 1024, swz = sb ^ (((sb >> 9) & 1) << 5); R = (st >> 1) * 16 + swz / 64; C = (st & 1) * 32 + (swz % 64) / 2; }
__host__ __device__ __forceinline__ int perm32(int rho) { const int n = rho >> 4, i = rho & 15; return 8 * (i >> 2) + 4 * n + (i & 3); }

struct Unit { int pm, pn; };
struct Gemm { const bf16_t* A; const bf16_t* Bt; int M, N, K; };

struct StaticOrder {
    int nM, nN, nwg, G, c;
    __host__ __device__ void init(int M, int N, int G_, int c_) { nM = M / BM; nN = N / BM; nwg = nM * nN; G = G_; c = c_; }
    __host__ __device__ bool next(int i, Unit& u) const {
        const long L = (long)i * G + c; if (L >= nwg) return false;
        int wgid = (int)L; { const int q = nwg / NXCD, r = nwg % NXCD, xcd = wgid % NXCD, off = wgid / NXCD; wgid = (xcd < r ? xcd * (q + 1) : r * (q + 1) + (xcd - r) * q) + off; }
        const int nig = WGM * nN, gid = wgid / nig, fm = gid * WGM, gsz = (nM - fm) < WGM ? (nM - fm) : WGM;
        u.pm = fm + ((wgid % nig) % gsz); u.pn = (wgid % nig) / gsz; return true;
    }
    __device__ __forceinline__ void a_ready(const Unit&) const {}
    __device__ __forceinline__ void done(const Unit&) const {}
};
__device__ __forceinline__ unsigned cvt_pk_bf16(float lo, float hi) { unsigned r; asm volatile("v_cvt_pk_bf16_f32 %0, %1, %2" : "=v"(r) : "v"(lo), "v"(hi)); return r; }
typedef float f32x2 __attribute__((ext_vector_type(2)));
__device__ __forceinline__ f32x2 gelu_pk(f32x2 v) {
    const f32x2 av = __builtin_elementwise_abs(v), d = av * 0.2316418882f + 1.0f;
    f32x2 t; t.x = __builtin_amdgcn_rcpf(d.x); t.y = __builtin_amdgcn_rcpf(d.y);
    f32x2 q = t * 0.5307027145f + (-0.7265760135f); q = q * t + 0.7107068705f; q = q * t + (-0.142248368f); q = q * t + 0.127414796f; q = q * t;
    const f32x2 s = (v * v) * (-0.72134752044f);
    f32x2 e; e.x = __builtin_amdgcn_exp2f(s.x); e.y = __builtin_amdgcn_exp2f(s.y);
    const f32x2 m = v * (q * e), r = v - m;
    f32x2 o; o.x = v.x < 0.f ? m.x : r.x; o.y = v.y < 0.f ? m.y : r.y; return o;
}
template <int ACT  > struct EpiBf16 {
    static constexpr bool PERM = true, AFTER_DRAIN = false;
    bf16_t* O; int ldc; const float* bias; int split_cols; size_t split_stride;
    __device__ __forceinline__ void operator()(const f32x4 (&acc)[2][2][4][2], const Unit& u, int wr, int wc, int fr, int fq) const {
        const int row0 = u.pm * BM + wr * 64 + fr; int colt = u.pn * BM; bf16_t* base = O;
        if (split_cols) { const int t = colt / split_cols; base += (size_t)t * split_stride; colt -= t * split_cols; }
        const int col0 = colt + wc * 32 + 8 * fq, bcol0 = u.pn * BM + wc * 32 + 8 * fq;
        f32x4 bv[2][2];
#pragma unroll
        for (int bj = 0; bj < 2; ++bj)
#pragma unroll
            for (int n = 0; n < 2; ++n) bv[bj][n] = bias ? *(const f32x4*)(bias + bcol0 + bj * HALF + 4 * n) : (f32x4){0.f, 0.f, 0.f, 0.f};
#pragma unroll
        for (int ai = 0; ai < 2; ++ai)
#pragma unroll
            for (int m = 0; m < 4; ++m) { bf16_t* rowp = base + (size_t)(row0 + ai * HALF + m * 16) * ldc + col0;
#pragma unroll
                for (int bj = 0; bj < 2; ++bj) { f32x4 v0 = acc[ai][bj][m][0] + bv[bj][0], v1 = acc[ai][bj][m][1] + bv[bj][1];
                    if (ACT == 1) { f32x2 a = gelu_pk((f32x2){v0[0], v0[1]}), b = gelu_pk((f32x2){v0[2], v0[3]}), c = gelu_pk((f32x2){v1[0], v1[1]}), d = gelu_pk((f32x2){v1[2], v1[3]});
                        v0 = (f32x4){a.x, a.y, b.x, b.y}; v1 = (f32x4){c.x, c.y, d.x, d.y}; }
                    if (ACT == 2) {
#pragma unroll
                        for (int j = 0; j < 4; ++j) { v0[j] = 0.5f * v0[j] * (1.0f + erff(v0[j] * 0.70710678f)); v1[j] = 0.5f * v1[j] * (1.0f + erff(v1[j] * 0.70710678f)); } }
                    u32x4 w; w.x = cvt_pk_bf16(v0[0], v0[1]); w.y = cvt_pk_bf16(v0[2], v0[3]); w.z = cvt_pk_bf16(v1[0], v1[1]); w.w = cvt_pk_bf16(v1[2], v1[3]);
                    *(u32x4*)(rowp + bj * HALF) = w; } }
    }
};
__device__ __forceinline__ float epi_bf2f(unsigned short b) { return __uint_as_float(((unsigned)b) << 16); }
__device__ __forceinline__ float epi_sigmoid(float x) { return 1.f / (1.f + __expf(-x)); }
typedef unsigned u32x2 __attribute__((ext_vector_type(2)));
struct EpiGateF32 {
    static constexpr bool PERM = false, AFTER_DRAIN = false;
    float* TMP; const bf16_t* G; int ldg; int goff;
    __device__ __forceinline__ void operator()(const f32x4 (&acc)[2][2][4][2], const Unit& u, int wr, int wc, int fr, int fq) const {
        const int row0 = u.pm * BM + wr * 64 + fr, col0 = u.pn * BM + wc * 32 + 4 * fq;
#pragma unroll
        for (int ai = 0; ai < 2; ++ai)
#pragma unroll
            for (int m = 0; m < 4; ++m) { const int row = row0 + ai * HALF + m * 16; float* rowp = TMP + (size_t)row * 1024 + col0; const bf16_t* gp = G + (size_t)row * ldg + goff + col0;
#pragma unroll
                for (int bj = 0; bj < 2; ++bj)
#pragma unroll
                    for (int n = 0; n < 2; ++n) { const u32x2 gw = *(const u32x2*)(gp + bj * HALF + n * 16); const f32x4 a = acc[ai][bj][m][n]; f32x4 o;
                        o[0] = a[0] * epi_sigmoid(__uint_as_float(gw.x << 16)); o[1] = a[1] * epi_sigmoid(__uint_as_float(gw.x & 0xffff0000u));
                        o[2] = a[2] * epi_sigmoid(__uint_as_float(gw.y << 16)); o[3] = a[3] * epi_sigmoid(__uint_as_float(gw.y & 0xffff0000u));
                        *(f32x4*)(rowp + bj * HALF + n * 16) = o; } }
    }
};
struct EpiGateAddBf16 {
    static constexpr bool PERM = false, AFTER_DRAIN = false;
    const float* TMP; bf16_t* O; const bf16_t* G; int ldg; int goff;
    __device__ __forceinline__ void operator()(const f32x4 (&acc)[2][2][4][2], const Unit& u, int wr, int wc, int fr, int fq) const {
        const int row0 = u.pm * BM + wr * 64 + fr, col0 = u.pn * BM + wc * 32 + 4 * fq;
#pragma unroll
        for (int ai = 0; ai < 2; ++ai)
#pragma unroll
            for (int m = 0; m < 4; ++m) { const int row = row0 + ai * HALF + m * 16; const float* rowp = TMP + (size_t)row * 1024 + col0; bf16_t* op = O + (size_t)row * 1024 + col0; const bf16_t* gp = G + (size_t)row * ldg + goff + col0;
#pragma unroll
                for (int bj = 0; bj < 2; ++bj)
#pragma unroll
                    for (int n = 0; n < 2; ++n) { const u32x2 gw = *(const u32x2*)(gp + bj * HALF + n * 16); const f32x4 a = acc[ai][bj][m][n]; const f32x4 t = *(const f32x4*)(rowp + bj * HALF + n * 16); f32x4 o;
                        o[0] = t[0] + a[0] * epi_sigmoid(__uint_as_float(gw.x << 16)); o[1] = t[1] + a[1] * epi_sigmoid(__uint_as_float(gw.x & 0xffff0000u));
                        o[2] = t[2] + a[2] * epi_sigmoid(__uint_as_float(gw.y << 16)); o[3] = t[3] + a[3] * epi_sigmoid(__uint_as_float(gw.y & 0xffff0000u));
                        u32x2 w; w.x = cvt_pk_bf16(o[0], o[1]); w.y = cvt_pk_bf16(o[2], o[3]);
                        *(u32x2*)(op + bj * HALF + n * 16) = w; } }
    }
};
struct EpiResid {
    static constexpr bool PERM = false, AFTER_DRAIN = false;
    float* X; const float* MODG; int rowbase;
    __device__ __forceinline__ void operator()(const f32x4 (&acc)[2][2][4][2], const Unit& u, int wr, int wc, int fr, int fq) const {
        const int row0 = rowbase + u.pm * BM + wr * 64 + fr, col0 = u.pn * BM + wc * 32 + 4 * fq;
        const int tok0 = rowbase + u.pm * BM; const int grp = tok0 < 8192 ? 0 : 1 + ((tok0 - 8192) >> 12);
        const float* gv = MODG + (size_t)grp * 6144 + col0;
        f32x4 g[2][2];
#pragma unroll
        for (int bj = 0; bj < 2; ++bj)
#pragma unroll
            for (int n = 0; n < 2; ++n) g[bj][n] = *(const f32x4*)(gv + bj * HALF + n * 16);
#pragma unroll
        for (int ai = 0; ai < 2; ++ai)
#pragma unroll
            for (int m = 0; m < 4; ++m) { float* rowp = X + (size_t)(row0 + ai * HALF + m * 16) * 1024 + col0;
#pragma unroll
                for (int bj = 0; bj < 2; ++bj)
#pragma unroll
                    for (int n = 0; n < 2; ++n) { f32x4 x = *(const f32x4*)(rowp + bj * HALF + n * 16); x = x + g[bj][n] * acc[ai][bj][m][n]; *(f32x4*)(rowp + bj * HALF + n * 16) = x; } }
    }
};
template <class Epi, class Sched, bool STAMP = false>
__device__ __forceinline__ void gemm_phase(PG8_LAS unsigned char* lds, const Gemm g, const Sched& S, const Epi& E, unsigned long long* stamps) {
    int tid_l = threadIdx.x; asm volatile("" : "+v"(tid_l)); const int tid = tid_l, wid = __builtin_amdgcn_readfirstlane(tid >> 6), lane = tid & 63, wr = wid >> 2, wc = wid & 3, fr = lane & 15, fq = lane >> 4;
    const int K = g.K, nt = K / BK;
    int ts_lo = 0, ts_hi = 0, nts = 0; const unsigned long long rt_entry = STAMP ? (unsigned long long)wall_clock64() : 0ull;
#define PG8_STAMP() do { if (STAMP && wid == 0 && nts < 64) { const unsigned long long _c = (unsigned long long)clock64(); \
        ts_lo = (lane == nts) ? (int)(unsigned)_c : ts_lo; ts_hi = (lane == nts) ? (int)(unsigned)(_c >> 32) : ts_hi; ++nts; } } while (0)
    PG8_STAMP();
    unsigned voffA[2], voffB[2];
#pragma unroll
    for (int i = 0; i < 2; ++i) { int R, C; stage_rc(tid * 16 + i * 8192, R, C); const int Rb = Epi::PERM ? ((R & ~31) + perm32(R & 31)) : R;
        voffA[i] = (unsigned)(R * K + C) * 2u; voffB[i] = (unsigned)(Rb * K + C) * 2u; }
    const size_t kstep = (size_t)(BK * 2);
    const size_t hstep = (size_t)HALF * K * 2;
    const size_t tstep = 2 * hstep;
    const unsigned ldsw = (unsigned)wid * 1024u;
    const int aoff = lds_byte(wr * 64 + fr, fq * 8), boff = lds_byte(wc * 32 + fr, fq * 8);
#define PG8_SA(b, h) (((b) * 2 + (h)) * HTB)
#define PG8_SB(b, h) ((4 + (b) * 2 + (h)) * HTB)
#define PG8_STAGE(bufoff, gbase, voff) do { _Pragma("unroll") for (int _i = 0; _i < 2; ++_i) \
        __builtin_amdgcn_global_load_lds((const unsigned*)((const char*)(gbase) + (voff)[_i]), (PG8_LAS unsigned*)(lds + (bufoff) + ldsw + _i * 8192), 16, 0, 0); } while (0)
#define PG8_LDA(dst, b, h) do { _Pragma("unroll") for (int m = 0; m < 4; ++m) _Pragma("unroll") for (int k = 0; k < 2; ++k) dst[m][k] = *(const PG8_LAS bf16x8*)(lds + PG8_SA(b, h) + aoff + m * 2048 + k * 1024); } while (0)
#define PG8_LDB(dst, b, h) do { _Pragma("unroll") for (int n = 0; n < 2; ++n) _Pragma("unroll") for (int k = 0; k < 2; ++k) dst[n][k] = *(const PG8_LAS bf16x8*)(lds + PG8_SB(b, h) + boff + n * 2048 + k * 1024); } while (0)
#define PG8_MMA(ai, bj, At, Bt) do { __builtin_amdgcn_s_setprio(1); _Pragma("unroll") for (int m = 0; m < 4; ++m) _Pragma("unroll") for (int n = 0; n < 2; ++n) _Pragma("unroll") for (int k = 0; k < 2; ++k) \
        acc[ai][bj][m][n] = __builtin_amdgcn_mfma_f32_16x16x32_bf16(Bt[n][k], At[m][k], acc[ai][bj][m][n], 0, 0, 0); __builtin_amdgcn_s_setprio(0); } while (0)
#define PG8_WAIT_V(n) asm volatile("s_waitcnt vmcnt(" #n ")" ::: "memory")
#define PG8_WAIT_L(n) asm volatile("s_waitcnt lgkmcnt(" #n ")" ::: "memory")
#define PG8_BAR __builtin_amdgcn_s_barrier()
#define PG8_SCHED __builtin_amdgcn_sched_barrier(0)
    Unit cur, nxt; int ui = 0;
    if (!S.next(0, cur)) return;
    f32x4 acc[2][2][4][2];
#pragma unroll
    for (int a = 0; a < 2; ++a)
#pragma unroll
        for (int b = 0; b < 2; ++b)
#pragma unroll
            for (int m = 0; m < 4; ++m)
#pragma unroll
                for (int n = 0; n < 2; ++n) acc[a][b][m][n] = (f32x4){0.f, 0.f, 0.f, 0.f};
    bf16x8 At[4][2], B0[2][2], B1[2][2];
    const char* cA = (const char*)g.A + (size_t)cur.pm * tstep; const char* cB = (const char*)g.Bt + (size_t)cur.pn * tstep;
    S.a_ready(cur);
    PG8_STAGE(PG8_SB(0, 0), cB, voffB); PG8_STAGE(PG8_SA(0, 0), cA, voffA); PG8_STAGE(PG8_SB(0, 1), cB + hstep, voffB); PG8_STAGE(PG8_SA(0, 1), cA + hstep, voffA);
    if (wr == 1) PG8_BAR;
    PG8_WAIT_V(4); PG8_BAR;
    PG8_STAGE(PG8_SB(1, 0), cB + kstep, voffB); PG8_STAGE(PG8_SA(1, 0), cA + kstep, voffA); PG8_STAGE(PG8_SB(1, 1), cB + hstep + kstep, voffB);
    PG8_WAIT_V(6); PG8_BAR;
    PG8_STAMP();
    for (;;) {
        const bool has_next = S.next(ui + 1, nxt);
        const char* nA = has_next ? (const char*)g.A + (size_t)nxt.pm * tstep : cA; const char* nB = has_next ? (const char*)g.Bt + (size_t)nxt.pn * tstep : cB;
        for (int t = 0; t < nt; t += 2) {
            const bool last = (t == nt - 2);
            const char* a1 = cA + (size_t)(t + 1) * kstep;
            const char* a2 = last ? nA : cA + (size_t)(t + 2) * kstep; const char* b2 = last ? nB : cB + (size_t)(t + 2) * kstep;
            const char* a3 = a2 + kstep; const char* b3 = b2 + kstep;
            if (last && has_next) S.a_ready(nxt);
            PG8_LDB(B0, 0, 0); PG8_SCHED; PG8_LDA(At, 0, 0); PG8_STAGE(PG8_SA(1, 1), a1 + hstep, voffA);
            PG8_WAIT_L(8); PG8_BAR; PG8_WAIT_L(0); PG8_MMA(0, 0, At, B0); PG8_BAR; PG8_SCHED;
            PG8_LDB(B1, 0, 1); PG8_STAGE(PG8_SB(0, 0), b2, voffB);
            PG8_BAR; PG8_WAIT_L(0); PG8_MMA(0, 1, At, B1); PG8_BAR;
            PG8_LDA(At, 0, 1); PG8_STAGE(PG8_SA(0, 0), a2, voffA);
            PG8_BAR; PG8_WAIT_L(0); PG8_MMA(1, 0, At, B0); PG8_BAR; PG8_SCHED;
            PG8_STAGE(PG8_SB(0, 1), b2 + hstep, voffB);
            PG8_WAIT_V(6); PG8_BAR; PG8_MMA(1, 1, At, B1); PG8_BAR;
            PG8_LDB(B0, 1, 0); PG8_SCHED; PG8_LDA(At, 1, 0); PG8_STAGE(PG8_SA(0, 1), a2 + hstep, voffA);
            PG8_WAIT_L(8); PG8_BAR; PG8_WAIT_L(0); PG8_MMA(0, 0, At, B0); PG8_BAR; PG8_SCHED;
            PG8_LDB(B1, 1, 1); PG8_STAGE(PG8_SB(1, 0), b3, voffB);
            PG8_BAR; PG8_WAIT_L(0); PG8_MMA(0, 1, At, B1); PG8_BAR;
            PG8_LDA(At, 1, 1); PG8_STAGE(PG8_SA(1, 0), a3, voffA);
            PG8_BAR; PG8_WAIT_L(0); PG8_MMA(1, 0, At, B0); PG8_BAR; PG8_SCHED;
            PG8_STAGE(PG8_SB(1, 1), b3 + hstep, voffB);
            PG8_WAIT_V(6); PG8_BAR; PG8_MMA(1, 1, At, B1); PG8_BAR;
        }
        PG8_STAMP();
        if constexpr (!Epi::AFTER_DRAIN) { E(acc, cur, wr, wc, fr, fq); S.done(cur); }
        PG8_STAMP();
        if (!has_next) break;
#pragma unroll
        for (int a = 0; a < 2; ++a)
#pragma unroll
            for (int b = 0; b < 2; ++b)
#pragma unroll
                for (int m = 0; m < 4; ++m)
#pragma unroll
                    for (int n = 0; n < 2; ++n) acc[a][b][m][n] = (f32x4){0.f, 0.f, 0.f, 0.f};
        cur = nxt; cA = nA; cB = nB; ++ui;
    }
    PG8_WAIT_V(0);
    if (wr == 0) PG8_BAR;
    PG8_BAR;
    if constexpr (Epi::AFTER_DRAIN) { E.fused(acc, cur, wr, wc, fr, fq, lds, wid, lane); S.done(cur); }
    PG8_STAMP();
    if (STAMP && wid == 0) { stamps[lane] = lane < nts ? (((unsigned long long)(unsigned)ts_hi << 32) | (unsigned)ts_lo) : 0ull;
        if (lane == 62) stamps[62] = rt_entry; if (lane == 63) stamps[63] = (unsigned long long)wall_clock64(); }
#undef PG8_STAMP
#undef PG8_SA
#undef PG8_SB
#undef PG8_STAGE
#undef PG8_LDA
#undef PG8_LDB
#undef PG8_MMA
#undef PG8_WAIT_V
#undef PG8_WAIT_L
#undef PG8_BAR
#undef PG8_SCHED
}
}

#ifndef MULTI
#define MULTI 0
#endif
#define DI __device__ __forceinline__
typedef unsigned short bf16_t;
typedef short bf16x8 __attribute__((ext_vector_type(8)));
typedef float f32x4 __attribute__((ext_vector_type(4)));
typedef float f32x16 __attribute__((ext_vector_type(16)));
typedef unsigned u32x4 __attribute__((ext_vector_type(4)));
typedef unsigned u32x2 __attribute__((ext_vector_type(2)));

constexpr int DM = 1024, NLAYER = 4, NP = 7424, NIN = 7200, DFF = 2816, NUP = 5632;
constexpr int TTOK = 24576, HT = 12288, NCH = 192;
constexpr int C_Q = 0, C_V = 512, C_F = 1024, C_GA = 2048, C_Z = 2560, C_XBC = 3584, C_DT = 5120, C_GATE = 5152;
constexpr float EPSN = 1e-6f;
constexpr int NTHR = 512;

constexpr size_t MiB = 1u << 20;
constexpr size_t WS_MOD = 0;
constexpr size_t WS_LB = 512 * 1024;
constexpr size_t WS_DECA = 1 * MiB;
constexpr size_t WS_DECB = 3 * MiB;
constexpr size_t WS_WIN = 4 * MiB;
constexpr size_t WS_WBRA = 19 * MiB;
constexpr size_t WS_WBRB = 20 * MiB;
constexpr size_t WS_WOUT = 22 * MiB;
constexpr size_t WS_WUP = 24 * MiB;
constexpr size_t WS_WDN = 35 * MiB;
constexpr size_t WS_U = 41 * MiB;
constexpr size_t WS_OA = 65 * MiB;
constexpr size_t WS_YB = 77 * MiB;
constexpr size_t WS_SA = 101 * MiB;
constexpr size_t WS_SB = 149 * MiB;
constexpr size_t WS_PROJ = 197 * MiB;
constexpr size_t WS_END = 372 * MiB;

struct Params {
    const float *x_prompt, *x_sample, *c, *state_hgrn, *state_ssd, *c_ctx, *w_ada, *b_ada, *ln1, *ln2, *ln_f, *w_in, *lb_logits, *a_norm,
        *conv_w, *conv_b, *dt_bias, *a_log, *d_skip, *b_norm, *w_br_a, *w_br_b, *w_out, *w_ff_up, *ff_conv_w, *ff_conv_b, *w_ff_down;
    float* out; unsigned char* ws; int ph_lo, ph_hi;
};
typedef const __attribute__((address_space(4))) Params CParams;
constexpr size_t OUT_SH = (size_t)TTOK * DM;
constexpr size_t OUT_SS = OUT_SH + (size_t)32 * 4 * 2 * 4 * 128 * 128;

DI int get_tid() { int t = threadIdx.x; asm volatile("" : "+v"(t)); return t; }
DI float bf2f(bf16_t b) { return __uint_as_float(((unsigned)b) << 16); }
DI unsigned f2bf(float f) { unsigned u = __float_as_uint(f); return (u + 0x7fffu + ((u >> 16) & 1u)) >> 16; }
DI unsigned pk2(float lo, float hi) { return f2bf(lo) | (f2bf(hi) << 16); }
DI float sigm(float x) { return 1.f / (1.f + __expf(-x)); }
DI float silu(float x) { return x / (1.f + __expf(-x)); }
DI float wave_sum(float v) {
#pragma unroll
    for (int o = 1; o < 64; o <<= 1) v += __shfl_xor(v, o);
    return v;
}
DI f32x16 mfma32(bf16x8 a, bf16x8 b, f32x16 c) { return __builtin_amdgcn_mfma_f32_32x32x16_bf16(a, b, c, 0, 0, 0); }
DI f32x16 zero16() { f32x16 z;
#pragma unroll
    for (int i = 0; i < 16; ++i) z[i] = 0.f; return z; }

struct SeqInfo { int first, nch, latent, batch; };
DI SeqInfo seq_of(int hf, int sq) { SeqInfo s; if (hf == 0) { if (sq < 32) { s.first = 4 * sq; s.nch = 4; s.latent = 0; s.batch = sq; } else { s.first = 128; s.nch = 64; s.latent = 1; s.batch = 0; } }
    else { s.first = 64 * sq; s.nch = 64; s.latent = 1; s.batch = 1 + sq; } return s; }
DI void chunk_halo(int hf, int c, bool& has_prev, bool& has_next) { const bool ctx = (hf == 0 && c < 128); has_prev = ctx && ((c & 3) != 0); has_next = ctx && ((c & 3) != 3); }

DI void phase_init(CParams& p, unsigned char* lds, int bid, int nb) {
    const int tid = get_tid();
    float* MOD = (float*)(p.ws + WS_MOD);
    float* CV = (float*)lds;
    float* RED = (float*)(lds + 20480);
    for (int i = tid; i < 5 * 1024; i += NTHR) { const int g = i >> 10, k = i & 1023; const float v = (g == 0) ? p.c_ctx[k] : p.c[(g - 1) * 1024 + k]; CV[i] = silu(v); }
    __syncthreads();
    for (int item = bid; item < 4 * 48; item += nb) {
        const int l = item / 48, jb = item % 48; const int jj = tid & 31, kp = tid >> 5;
        const float* W = p.w_ada + (size_t)l * 1024 * 6144 + (size_t)(kp * 64) * 6144 + jb * 128 + jj * 4;
        f32x4 a0 = {0, 0, 0, 0}, a1 = a0, a2 = a0, a3 = a0, a4 = a0;
#pragma unroll 8
        for (int k = 0; k < 64; ++k) { const f32x4 w = *(const f32x4*)(W + (size_t)k * 6144); const int kk = kp * 64 + k;
            a0 += w * CV[kk]; a1 += w * CV[1024 + kk]; a2 += w * CV[2048 + kk]; a3 += w * CV[3072 + kk]; a4 += w * CV[4096 + kk]; }
        float* r = RED + (kp * 5) * 128 + jj * 4;
        *(f32x4*)(r) = a0; *(f32x4*)(r + 128) = a1; *(f32x4*)(r + 256) = a2; *(f32x4*)(r + 384) = a3; *(f32x4*)(r + 512) = a4;
        __syncthreads();
        for (int o = tid; o < 640; o += NTHR) { const int g = o >> 7, col = o & 127; float s = p.b_ada[l * 6144 + jb * 128 + col];
#pragma unroll
            for (int q = 0; q < 16; ++q) s += RED[(q * 5 + g) * 128 + col];
            MOD[(size_t)(l * 5 + g) * 6144 + jb * 128 + col] = s; }
        __syncthreads();
    }
    if (bid == nb - 1) {
        float* LB = (float*)(p.ws + WS_LB);
        for (int i = tid; i < 1024; i += NTHR) { float v[4], mx = -1e30f;
#pragma unroll
            for (int l = 0; l < 4; ++l) { v[l] = p.lb_logits[l * 1024 + i]; mx = fmaxf(mx, v[l]); }
            float s = 0.f;
#pragma unroll
            for (int l = 0; l < 4; ++l) { v[l] = __expf(v[l] - mx); s += v[l]; }
            const float inv = 1.f / s; float cum = 0.f; LB[i] = 0.f;
#pragma unroll
            for (int l = 1; l < 4; ++l) { cum += v[l] * inv; LB[l * 1024 + i] = fmaxf(cum, 0.f); } }
    }
    const size_t n4a = (size_t)8192 * 1024 / 4, n4b = (size_t)16384 * 1024 / 4;
    const size_t gt = (size_t)bid * NTHR + tid, gs = (size_t)nb * NTHR;
    f32x4* o4 = (f32x4*)p.out;
    for (size_t i = gt; i < n4a; i += gs) o4[i] = ((const f32x4*)p.x_prompt)[i];
    for (size_t i = gt; i < n4b; i += gs) o4[n4a + i] = ((const f32x4*)p.x_sample)[i];
}

DI void transpose_item(const float* W, int K, int N, bf16_t* WT, float* scr, int item, int lane) {
    const int nblk = N / 32, kb = item / nblk, nbk = item % nblk, k0 = 64 * kb, n0 = 32 * nbk;
#pragma unroll 8
    for (int i = 0; i < 32; ++i) { const int kk = 2 * i + (lane >> 5); scr[kk * 33 + (lane & 31)] = W[(size_t)(k0 + kk) * N + n0 + (lane & 31)]; }
    asm volatile("s_waitcnt lgkmcnt(0)" ::: "memory");
    const int c = lane & 7;
#pragma unroll
    for (int j = 0; j < 4; ++j) { const int n = (lane >> 3) + 8 * j; const float* s = scr + (8 * c) * 33 + n;
        u32x4 o; o.x = pk2(s[0 * 33], s[1 * 33]); o.y = pk2(s[2 * 33], s[3 * 33]); o.z = pk2(s[4 * 33], s[5 * 33]); o.w = pk2(s[6 * 33], s[7 * 33]);
        *(u32x4*)(WT + (size_t)(n0 + n) * K + k0 + 8 * c) = o; }
    asm volatile("s_waitcnt lgkmcnt(0)" ::: "memory");
}
DI void phase_wconv(CParams& p, unsigned char* lds, int l, int bid, int nb) {
    const int tid = get_tid(), lane = tid & 63, wave = __builtin_amdgcn_readfirstlane(tid >> 6);
    float* scr = (float*)(lds + wave * 8704);
    const int gw = bid * 8 + wave, NGW = nb * 8;
    constexpr int I_IN = 16 * 225, I_A = 8 * 32, I_B = 16 * 32, I_O = 16 * 32, I_U = 16 * 176, I_D = 44 * 32;
    constexpr int NIT = I_IN + I_A + I_B + I_O + I_U + I_D;
    unsigned char* ws = p.ws;
    for (int it = gw; it < NIT; it += NGW) {
        int r = it;
        if (r < I_IN) { transpose_item(p.w_in + (size_t)l * 1024 * NIN, 1024, NIN, (bf16_t*)(ws + WS_WIN), scr, r, lane); continue; } r -= I_IN;
        if (r < I_A) { transpose_item(p.w_br_a + (size_t)l * 512 * 1024, 512, 1024, (bf16_t*)(ws + WS_WBRA), scr, r, lane); continue; } r -= I_A;
        if (r < I_B) { transpose_item(p.w_br_b + (size_t)l * 1024 * 1024, 1024, 1024, (bf16_t*)(ws + WS_WBRB), scr, r, lane); continue; } r -= I_B;
        if (r < I_O) { transpose_item(p.w_out + (size_t)l * 1024 * 1024, 1024, 1024, (bf16_t*)(ws + WS_WOUT), scr, r, lane); continue; } r -= I_O;
        if (r < I_U) { transpose_item(p.w_ff_up + (size_t)l * 1024 * NUP, 1024, NUP, (bf16_t*)(ws + WS_WUP), scr, r, lane); continue; } r -= I_U;
        transpose_item(p.w_ff_down + (size_t)l * DFF * 1024, DFF, 1024, (bf16_t*)(ws + WS_WDN), scr, r, lane);
    }
    u32x4* z = (u32x4*)((bf16_t*)(ws + WS_WIN) + (size_t)NIN * 1024); const int nz = (NP - NIN) * 1024 / 8;
    for (int i = bid * NTHR + tid; i < nz; i += nb * NTHR) z[i] = (u32x4){0u, 0u, 0u, 0u};
}

DI void phase_norm(CParams& p, int l, int hf, int which, int bid, int nb) {
    const int tid = get_tid(), lane = tid & 63, wave = __builtin_amdgcn_readfirstlane(tid >> 6);
    const float* MOD = (const float*)(p.ws + WS_MOD);
    bf16_t* U = (bf16_t*)(p.ws + WS_U);
    const float* ln = (which == 0 ? p.ln1 : p.ln2) + l * 1024;
    for (int r = bid * 8 + wave; r < HT; r += nb * 8) {
        const int tok = hf * HT + r; const int grp = tok < 8192 ? 0 : 1 + ((tok - 8192) >> 12);
        const float* md = MOD + (size_t)(l * 5 + grp) * 6144 + which * 3072;
        const f32x4* xr = (const f32x4*)(p.out + (size_t)tok * 1024) + lane;
        f32x4 v[4]; float s = 0.f;
#pragma unroll
        for (int j = 0; j < 4; ++j) { v[j] = xr[64 * j]; s += (v[j].x * v[j].x + v[j].y * v[j].y) + (v[j].z * v[j].z + v[j].w * v[j].w); }
        const float rstd = rsqrtf(wave_sum(s) * (1.f / 1024.f) + EPSN);
        unsigned long long* o8 = (unsigned long long*)(U + (size_t)r * 1024) + lane;
#pragma unroll
        for (int j = 0; j < 4; ++j) { const int col = 4 * (64 * j + lane);
            const f32x4 g = *(const f32x4*)(ln + col), sh = *(const f32x4*)(md + col), sc = *(const f32x4*)(md + 1024 + col);
            const f32x4 y = v[j] * rstd * g * (sc + 1.f) + sh;
            o8[64 * j] = (unsigned long long)pk2(y.x, y.y) | ((unsigned long long)pk2(y.z, y.w) << 32); }
    }
}
DI void phase_final_norm(CParams& p, int bid, int nb) {
    const int tid = get_tid(), lane = tid & 63, wave = __builtin_amdgcn_readfirstlane(tid >> 6);
    for (int r = bid * 8 + wave; r < TTOK; r += nb * 8) {
        f32x4* xr = (f32x4*)(p.out + (size_t)r * 1024) + lane;
        f32x4 v[4]; float s = 0.f;
#pragma unroll
        for (int j = 0; j < 4; ++j) { v[j] = xr[64 * j]; s += (v[j].x * v[j].x + v[j].y * v[j].y) + (v[j].z * v[j].z + v[j].w * v[j].w); }
        const float rstd = rsqrtf(wave_sum(s) * (1.f / 1024.f) + EPSN);
#pragma unroll
        for (int j = 0; j < 4; ++j) { const int col = 4 * (64 * j + lane); const f32x4 g = *(const f32x4*)(p.ln_f + col); xr[64 * j] = v[j] * rstd * g; }
    }
}

DI void phase_convact(CParams& p, int l, int hf, int bid, int nb) {
    const bf16_t* H = (const bf16_t*)(p.ws + WS_PROJ); bf16_t* ACT = (bf16_t*)(p.ws + WS_SA);
    const float* cw = p.ff_conv_w + (size_t)l * 3 * NUP; const float* cb = p.ff_conv_b + (size_t)l * NUP;
    const int nitem = HT * 352;
    const int tid_ = get_tid();
    for (int it = bid * NTHR + tid_; it < nitem; it += nb * NTHR) {
        const int t = it / 352, j8 = (it % 352) * 8;
        const bool latent = (hf == 1) || (t >= 8192); const int per = latent ? 64 : 256; const int pos = t & (per - 1);
        const bool hp = pos != 0, hn = pos != per - 1;
        float res[2][8];
#pragma unroll
        for (int half = 0; half < 2; ++half) { const int col = half * DFF + j8; const bf16_t* hp0 = H + (size_t)t * NUP + col;
            const u32x4 z4 = {0u, 0u, 0u, 0u};
            const u32x4 xm = hp ? *(const u32x4*)(hp0 - NUP) : z4, x0 = *(const u32x4*)hp0, xp = hn ? *(const u32x4*)(hp0 + NUP) : z4;
            f32x4 w0a = *(const f32x4*)(cw + col), w0b = *(const f32x4*)(cw + col + 4);
            f32x4 w1a = *(const f32x4*)(cw + NUP + col), w1b = *(const f32x4*)(cw + NUP + col + 4);
            f32x4 w2a = *(const f32x4*)(cw + 2 * NUP + col), w2b = *(const f32x4*)(cw + 2 * NUP + col + 4);
            f32x4 ba = *(const f32x4*)(cb + col), bb = *(const f32x4*)(cb + col + 4);
#pragma unroll
            for (int q = 0; q < 4; ++q) {
                const float w0l = q < 2 ? w0a[2 * q] : w0b[2 * q - 4], w0h = q < 2 ? w0a[2 * q + 1] : w0b[2 * q - 3];
                const float w1l = q < 2 ? w1a[2 * q] : w1b[2 * q - 4], w1h = q < 2 ? w1a[2 * q + 1] : w1b[2 * q - 3];
                const float w2l = q < 2 ? w2a[2 * q] : w2b[2 * q - 4], w2h = q < 2 ? w2a[2 * q + 1] : w2b[2 * q - 3];
                const float bl = q < 2 ? ba[2 * q] : bb[2 * q - 4], bh = q < 2 ? ba[2 * q + 1] : bb[2 * q - 3];
                res[half][2 * q] = bl + w0l * __uint_as_float(xm[q] << 16) + w1l * __uint_as_float(x0[q] << 16) + w2l * __uint_as_float(xp[q] << 16);
                res[half][2 * q + 1] = bh + w0h * __uint_as_float(xm[q] & 0xffff0000u) + w1h * __uint_as_float(x0[q] & 0xffff0000u) + w2h * __uint_as_float(xp[q] & 0xffff0000u);
            }
        }
        u32x4 o;
        o.x = pk2(silu(res[0][0]) * res[1][0], silu(res[0][1]) * res[1][1]); o.y = pk2(silu(res[0][2]) * res[1][2], silu(res[0][3]) * res[1][3]);
        o.z = pk2(silu(res[0][4]) * res[1][4], silu(res[0][5]) * res[1][5]); o.w = pk2(silu(res[0][6]) * res[1][6], silu(res[0][7]) * res[1][7]);
        *(u32x4*)(ACT + (size_t)t * DFF + j8) = o;
    }
}

DI void hgrn_totals(const bf16_t* fp, float lb, float& total, float& b31) {
    const float oml = 1.f - lb; float t = 0.f, m = 0.f;
#pragma unroll 16
    for (int s = 0; s < 64; ++s) { const float fx = bf2f(fp[(size_t)s * NP]); const float f = lb + oml * sigm(fx); t += __logf(f); if (s == 31) m = t; }
    total = t; b31 = m;
}
DI void stage_vt(const bf16_t* PROJ, int lt0, int h, bf16_t* VT, int tt) {
    const int v = tt & 127, sh = tt >> 7;
    const bf16_t* vp = PROJ + (size_t)(lt0 + sh * 32) * NP + C_V + h * 128 + v;
#pragma unroll
    for (int s8 = 0; s8 < 4; ++s8) { u32x4 o; float x[8];
#pragma unroll
        for (int j = 0; j < 8; ++j) x[j] = bf2f(vp[(size_t)(s8 * 8 + j) * NP]);
        o.x = pk2(x[0], x[1]); o.y = pk2(x[2], x[3]); o.z = pk2(x[4], x[5]); o.w = pk2(x[6], x[7]);
        *(u32x4*)(VT + v * 72 + sh * 32 + s8 * 8) = o; }
}

DI void scanA_hgrn(CParams& p, unsigned char* lds, int l, int hf, int c, int h) {
    const int tid = get_tid(), lane = tid & 63, wave = __builtin_amdgcn_readfirstlane(tid >> 6), l31 = lane & 31, lh = lane >> 5;
    const bf16_t* PROJ = (const bf16_t*)(p.ws + WS_PROJ);
    bf16_t* KH = (bf16_t*)lds;
    bf16_t* VT = (bf16_t*)(lds + 36864);
    const int lt0 = c * 64;
    if (tid < 256) {
        const int d = tid >> 7, k = tid & 127;
        const bf16_t* fp = PROJ + (size_t)lt0 * NP + C_F + d * 512 + h * 128 + k;
        const float lb = ((const float*)(p.ws + WS_LB))[(l * 2 + d) * 512 + h * 128 + k], oml = 1.f - lb;
        float total, b31; hgrn_totals(fp, lb, total, b31);
        float b = 0.f;
#pragma unroll
        for (int s8 = 0; s8 < 8; ++s8) { float val[8];
#pragma unroll
            for (int j = 0; j < 8; ++j) { const float fx = bf2f(fp[(size_t)(s8 * 8 + j) * NP]); const float f = lb + oml * sigm(fx); const float lf = __logf(f); const float bex = b; b += lf;
                const float e = (d == 0) ? __expf(total - b) : __expf(bex); val[j] = (1.f - f) * e; }
            u32x4 o; o.x = pk2(val[0], val[1]); o.y = pk2(val[2], val[3]); o.z = pk2(val[4], val[5]); o.w = pk2(val[6], val[7]);
            *(u32x4*)(KH + (d * 128 + k) * 72 + s8 * 8) = o; }
        float* DEC = (float*)(p.ws + WS_DECA) + (size_t)((c * 4 + h) * 2 + d) * 256;
        DEC[k] = __expf(total); DEC[128 + k] = (d == 0) ? __expf(b31) : __expf(total - b31);
    } else stage_vt(PROJ, lt0, h, VT, tid - 256);
    __syncthreads();
    {
        const int d = wave >> 2, vq = wave & 3;
        f32x16 acc[4];
#pragma unroll
        for (int i = 0; i < 4; ++i) acc[i] = zero16();
#pragma unroll
        for (int ks = 0; ks < 4; ++ks) { const bf16x8 b = *(const bf16x8*)(VT + (vq * 32 + l31) * 72 + ks * 16 + 8 * lh);
#pragma unroll
            for (int kb = 0; kb < 4; ++kb) { const bf16x8 a = *(const bf16x8*)(KH + (d * 128 + kb * 32 + l31) * 72 + ks * 16 + 8 * lh); acc[kb] = mfma32(a, b, acc[kb]); } }
        bf16_t* S = (bf16_t*)(p.ws + WS_SA) + (size_t)((c * 4 + h) * 2 + d) * 16384 + (size_t)(vq * 32 + l31) * 128;
#pragma unroll
        for (int kb = 0; kb < 4; ++kb)
#pragma unroll
            for (int g = 0; g < 4; ++g) { u32x2 w; w.x = pk2(acc[kb][4 * g], acc[kb][4 * g + 1]); w.y = pk2(acc[kb][4 * g + 2], acc[kb][4 * g + 3]);
                *(u32x2*)(S + kb * 32 + 8 * g + 4 * lh) = w; }
    }
    __syncthreads();
}

DI void ssd_dt(CParams& p, const bf16_t* PROJ, int l, int lt0, int head, int d, int lane, float& dt, float& a, float& ac, float& total) {
    const float raw = bf2f(PROJ[(size_t)(lt0 + lane) * NP + C_DT + d * 16 + head]) + p.dt_bias[(l * 2 + d) * 16 + head];
    dt = raw > 20.f ? raw : log1pf(__expf(raw));
    a = -__expf(p.a_log[(l * 2 + d) * 16 + head]) * dt;
    ac = a;
#pragma unroll
    for (int o = 1; o < 64; o <<= 1) { const float t = __shfl_up(ac, o); if (lane >= o) ac += t; }
    total = __shfl(ac, 63);
}
DI u32x4 conv8(CParams& p, const bf16_t* PROJ, int l, int lt0, int s0, int xcol, bool has_prev, bool has_next) {
    const bf16_t* xp = PROJ + (size_t)lt0 * NP + C_XBC + xcol;
    const float w0 = p.conv_w[(l * 3 + 0) * 1536 + xcol], w1 = p.conv_w[(l * 3 + 1) * 1536 + xcol], w2 = p.conv_w[(l * 3 + 2) * 1536 + xcol], cb = p.conv_b[l * 1536 + xcol];
    float x[10];
#pragma unroll
    for (int j = 0; j < 10; ++j) { const int s = s0 - 1 + j; const bool ok = (s >= 0 || has_prev) && (s < 64 || has_next); x[j] = ok ? bf2f(xp[(long)s * NP]) : 0.f; }
    float y[8];
#pragma unroll
    for (int j = 0; j < 8; ++j) y[j] = silu(cb + w0 * x[j] + w1 * x[j + 1] + w2 * x[j + 2]);
    u32x4 o; o.x = pk2(y[0], y[1]); o.y = pk2(y[2], y[3]); o.z = pk2(y[4], y[5]); o.w = pk2(y[6], y[7]); return o;
}
DI u32x4 conv8c(CParams& p, const bf16_t* PROJ, int l, int lt0, int s, int xcol, bool has_prev, bool has_next) {
    const bf16_t* xp = PROJ + (size_t)(lt0 + s) * NP + C_XBC + xcol;
    const u32x4 z4 = {0u, 0u, 0u, 0u};
    const bool okm = (s > 0 || has_prev), okp = (s < 63 || has_next);
    const u32x4 xm = okm ? *(const u32x4*)(xp - NP) : z4, x0 = *(const u32x4*)xp, xq = okp ? *(const u32x4*)(xp + NP) : z4;
    const float* cw = p.conv_w + (size_t)l * 3 * 1536 + xcol; const float* cbp = p.conv_b + l * 1536 + xcol;
    float y[8];
#pragma unroll
    for (int q = 0; q < 4; ++q) {
        y[2 * q] = silu(cbp[2 * q] + cw[2 * q] * __uint_as_float(xm[q] << 16) + cw[1536 + 2 * q] * __uint_as_float(x0[q] << 16) + cw[3072 + 2 * q] * __uint_as_float(xq[q] << 16));
        y[2 * q + 1] = silu(cbp[2 * q + 1] + cw[2 * q + 1] * __uint_as_float(xm[q] & 0xffff0000u) + cw[1536 + 2 * q + 1] * __uint_as_float(x0[q] & 0xffff0000u) + cw[3072 + 2 * q + 1] * __uint_as_float(xq[q] & 0xffff0000u)); }
    u32x4 o; o.x = pk2(y[0], y[1]); o.y = pk2(y[2], y[3]); o.z = pk2(y[4], y[5]); o.w = pk2(y[6], y[7]); return o;
}

DI void scanA_ssd(CParams& p, unsigned char* lds, int l, int hf, int c, int g) {
    const int tid = get_tid(), lane = tid & 63, wave = __builtin_amdgcn_readfirstlane(tid >> 6), l31 = lane & 31, lh = lane >> 5;
    const bf16_t* PROJ = (const bf16_t*)(p.ws + WS_PROJ);
    bf16_t* XT = (bf16_t*)lds;
    bf16_t* BT = (bf16_t*)(lds + 36864);
    float* WS_ = (float*)(lds + 46080);
    const int lt0 = c * 64; bool hp, hn; chunk_halo(hf, c, hp, hn);
    {
        const int hh = wave >> 1, d = wave & 1, head = g * 4 + hh; float dt, a, ac, total; ssd_dt(p, PROJ, l, lt0, head, d, lane, dt, a, ac, total);
        WS_[wave * 64 + lane] = ((d == 0) ? __expf(total - ac) : __expf(ac - a)) * dt;
        if (lane == 0) ((float*)(p.ws + WS_DECB))[(c * 16 + head) * 2 + d] = __expf(total);
    }
#pragma unroll 1
    for (int it = tid; it < 2560; it += NTHR) { const int sg = it / 320, cl = it % 320; const int xcol = cl < 256 ? g * 256 + cl : 1024 + g * 64 + (cl - 256);
        const u32x4 o = conv8(p, PROJ, l, lt0, sg * 8, xcol, hp, hn);
        *(u32x4*)((cl < 256 ? XT + cl * 72 : BT + (cl - 256) * 72) + sg * 8) = o; }
    __syncthreads();
    {
        const int hh = wave >> 1, d = wave & 1, head = g * 4 + hh;
        f32x16 acc[2][2];
#pragma unroll
        for (int i = 0; i < 2; ++i)
#pragma unroll
            for (int j = 0; j < 2; ++j) acc[i][j] = zero16();
#pragma unroll
        for (int ks = 0; ks < 4; ++ks) { const f32x4 wa = *(const f32x4*)(WS_ + wave * 64 + ks * 16 + 8 * lh), wb = *(const f32x4*)(WS_ + wave * 64 + ks * 16 + 8 * lh + 4);
            bf16x8 bs[2];
#pragma unroll
            for (int ct = 0; ct < 2; ++ct) { const u32x4 r = *(const u32x4*)(XT + (hh * 64 + ct * 32 + l31) * 72 + ks * 16 + 8 * lh); u32x4 o;
                o.x = pk2(__uint_as_float(r.x << 16) * wa[0], __uint_as_float(r.x & 0xffff0000u) * wa[1]); o.y = pk2(__uint_as_float(r.y << 16) * wa[2], __uint_as_float(r.y & 0xffff0000u) * wa[3]);
                o.z = pk2(__uint_as_float(r.z << 16) * wb[0], __uint_as_float(r.z & 0xffff0000u) * wb[1]); o.w = pk2(__uint_as_float(r.w << 16) * wb[2], __uint_as_float(r.w & 0xffff0000u) * wb[3]);
                bs[ct] = __builtin_bit_cast(bf16x8, o); }
#pragma unroll
            for (int rt = 0; rt < 2; ++rt) { const bf16x8 a = *(const bf16x8*)(BT + (rt * 32 + l31) * 72 + ks * 16 + 8 * lh);
#pragma unroll
                for (int ct = 0; ct < 2; ++ct) acc[rt][ct] = mfma32(a, bs[ct], acc[rt][ct]); } }
        bf16_t* S = (bf16_t*)(p.ws + WS_SB) + (size_t)((c * 16 + head) * 2 + d) * 4096;
#pragma unroll
        for (int rt = 0; rt < 2; ++rt)
#pragma unroll
            for (int ct = 0; ct < 2; ++ct)
#pragma unroll
                for (int q = 0; q < 4; ++q) { u32x2 w; w.x = pk2(acc[rt][ct][4 * q], acc[rt][ct][4 * q + 1]); w.y = pk2(acc[rt][ct][4 * q + 2], acc[rt][ct][4 * q + 3]);
                    *(u32x2*)(S + (ct * 32 + l31) * 64 + rt * 32 + 8 * q + 4 * lh) = w; }
    }
    __syncthreads();
}
DI void phase_scanA(CParams& p, unsigned char* lds, int l, int hf, int bid, int nb) {
    for (int it = bid; it < 2 * NCH * 4; it += nb) { if (it < NCH * 4) scanA_hgrn(p, lds, l, hf, it >> 2, it & 3); else { const int j = it - NCH * 4; scanA_ssd(p, lds, l, hf, j >> 2, j & 3); } }
}

DI void phase_scanB(CParams& p, int l, int hf, int bid, int nb) {
    const int nseq = hf == 0 ? 33 : 3; const int total = nseq << 15;
    const int gt = bid * NTHR + get_tid(), gs = nb * NTHR;
    bf16_t* SA = (bf16_t*)(p.ws + WS_SA); const float* DECA = (const float*)(p.ws + WS_DECA);
    for (int it = gt; it < total; it += gs) {
        const int q = it & 4095, combo = (it >> 12) & 7, sq = it >> 15; const int h = combo >> 1, d = combo & 1; const int v = q >> 5, k4 = (q & 31) * 4;
        const SeqInfo si = seq_of(hf, sq);
        float S[4] = {0.f, 0.f, 0.f, 0.f};
        const size_t sidx = ((size_t)(((si.batch * 4 + l) * 2 + d) * 4 + h) * 128 + k4) * 128 + v;
        if (si.latent) {
#pragma unroll
            for (int j = 0; j < 4; ++j) S[j] = p.state_hgrn[sidx + (size_t)j * 128]; }
        for (int i = 0; i < si.nch; ++i) { const int c = si.first + (d == 0 ? i : si.nch - 1 - i); const size_t base = (size_t)((c * 4 + h) * 2 + d);
            bf16_t* sp = SA + base * 16384 + v * 128 + k4; const u32x2 raw = *(const u32x2*)sp;
            const f32x4 dec = *(const f32x4*)(DECA + base * 256 + k4), em = *(const f32x4*)(DECA + base * 256 + 128 + k4);
            u32x2 w; w.x = pk2(S[0] * em[0], S[1] * em[1]); w.y = pk2(S[2] * em[2], S[3] * em[3]); *(u32x2*)sp = w;
            S[0] = dec[0] * S[0] + __uint_as_float(raw.x << 16); S[1] = dec[1] * S[1] + __uint_as_float(raw.x & 0xffff0000u);
            S[2] = dec[2] * S[2] + __uint_as_float(raw.y << 16); S[3] = dec[3] * S[3] + __uint_as_float(raw.y & 0xffff0000u); }
        if (!si.latent) {
#pragma unroll
            for (int j = 0; j < 4; ++j) p.out[OUT_SH + sidx + (size_t)j * 128] = S[j]; }
    }
    bf16_t* SB = (bf16_t*)(p.ws + WS_SB); const float* DECB = (const float*)(p.ws + WS_DECB);
    for (int it = gt; it < total; it += gs) {
        const int q = it & 1023, combo = (it >> 10) & 31, sq = it >> 15; const int head = combo >> 1, d = combo & 1; const int pp = q >> 4, n4 = (q & 15) * 4;
        const SeqInfo si = seq_of(hf, sq);
        f32x4 S = {0.f, 0.f, 0.f, 0.f};
        const size_t sidx = ((size_t)(((si.batch * 4 + l) * 2 + d) * 16 + head) * 64 + pp) * 64 + n4;
        if (si.latent) S = *(const f32x4*)(p.state_ssd + sidx);
        for (int i = 0; i < si.nch; ++i) { const int c = si.first + (d == 0 ? i : si.nch - 1 - i); const size_t base = (size_t)((c * 16 + head) * 2 + d);
            bf16_t* sp = SB + base * 4096 + pp * 64 + n4; const u32x2 raw = *(const u32x2*)sp; const float dec = DECB[base];
            u32x2 w; w.x = pk2(S[0], S[1]); w.y = pk2(S[2], S[3]); *(u32x2*)sp = w;
            S[0] = dec * S[0] + __uint_as_float(raw.x << 16); S[1] = dec * S[1] + __uint_as_float(raw.x & 0xffff0000u);
            S[2] = dec * S[2] + __uint_as_float(raw.y << 16); S[3] = dec * S[3] + __uint_as_float(raw.y & 0xffff0000u); }
        if (!si.latent) *(f32x4*)(p.out + OUT_SS + sidx) = S;
    }
}

DI void scanC_hgrn(CParams& p, unsigned char* lds, int l, int hf, int c, int h) {
    const int tid = get_tid(), lane = tid & 63, wave = __builtin_amdgcn_readfirstlane(tid >> 6), l31 = lane & 31, lh = lane >> 5;
    const bf16_t* PROJ = (const bf16_t*)(p.ws + WS_PROJ);
    bf16_t* QT = (bf16_t*)lds;
    bf16_t* KT = (bf16_t*)(lds + 34816);
    bf16_t* VT = (bf16_t*)(lds + 69632);
    bf16_t* PP = (bf16_t*)(lds + 88064);
    float* OO = (float*)(lds + 34816);
    const int lt0 = c * 64;
    if (tid < 256) {
        const int d = tid >> 7, k = tid & 127;
        const bf16_t* fp = PROJ + (size_t)lt0 * NP + C_F + d * 512 + h * 128 + k;
        const bf16_t* qp = PROJ + (size_t)lt0 * NP + C_Q + h * 128 + k;
        const float lb = ((const float*)(p.ws + WS_LB))[(l * 2 + d) * 512 + h * 128 + k], oml = 1.f - lb;
        float total, b31; hgrn_totals(fp, lb, total, b31);
        float b = 0.f;
#pragma unroll 8
        for (int s = 0; s < 64; ++s) { const float fx = bf2f(fp[(size_t)s * NP]); const float f = lb + oml * sigm(fx); const float lf = __logf(f); const float bex = b; b += lf;
            const float qv = silu(bf2f(qp[(size_t)s * NP]));
            const float aq = (d == 0) ? (b - b31) : (b31 - bex); const float eq = __expf(fminf(aq, 80.f)), ek = __expf(fminf(-aq, 80.f));
            QT[(d * 64 + s) * 136 + k] = (bf16_t)f2bf(qv * eq); KT[(d * 64 + s) * 136 + k] = (bf16_t)f2bf((1.f - f) * ek); }
    } else stage_vt(PROJ, lt0, h, VT, tid - 256);
    __syncthreads();
    const int th = wave & 1, vq = wave >> 1;
    bf16x8 sfr[2][8];
    {
        const bf16_t* SA = (const bf16_t*)(p.ws + WS_SA);
#pragma unroll
        for (int d = 0; d < 2; ++d)
#pragma unroll
            for (int ks = 0; ks < 8; ++ks) sfr[d][ks] = *(const bf16x8*)(SA + (size_t)((c * 4 + h) * 2 + d) * 16384 + (size_t)(vq * 32 + l31) * 128 + ks * 16 + 8 * lh);
    }
    {
        const int d = wave >> 2, tr = (wave >> 1) & 1, tc = wave & 1; f32x16 acc = zero16();
#pragma unroll
        for (int ks = 0; ks < 8; ++ks) { const bf16x8 a = *(const bf16x8*)(QT + (d * 64 + tr * 32 + l31) * 136 + ks * 16 + 8 * lh), b = *(const bf16x8*)(KT + (d * 64 + tc * 32 + l31) * 136 + ks * 16 + 8 * lh); acc = mfma32(a, b, acc); }
        const int s = tc * 32 + l31;
#pragma unroll
        for (int i = 0; i < 16; ++i) { const int t = tr * 32 + 8 * (i >> 2) + 4 * lh + (i & 3); const bool keep = (d == 0) ? (t >= s) : (t <= s); PP[(d * 64 + t) * 72 + s] = (bf16_t)f2bf(keep ? acc[i] : 0.f); }
    }
    __syncthreads();
    {
        f32x16 acc = zero16();
#pragma unroll
        for (int d = 0; d < 2; ++d) {
#pragma unroll
            for (int ks = 0; ks < 4; ++ks) { const bf16x8 a = *(const bf16x8*)(PP + (d * 64 + th * 32 + l31) * 72 + ks * 16 + 8 * lh), b = *(const bf16x8*)(VT + (vq * 32 + l31) * 72 + ks * 16 + 8 * lh); acc = mfma32(a, b, acc); }
#pragma unroll
            for (int ks = 0; ks < 8; ++ks) { const bf16x8 a = *(const bf16x8*)(QT + (d * 64 + th * 32 + l31) * 136 + ks * 16 + 8 * lh); acc = mfma32(a, sfr[d][ks], acc); }
        }
#pragma unroll
        for (int i = 0; i < 16; ++i) { const int t = th * 32 + 8 * (i >> 2) + 4 * lh + (i & 3); OO[t * 132 + vq * 32 + l31] = acc[i]; }
    }
    __syncthreads();
    {
        const int t = tid >> 3, part = tid & 7; const float* orow = OO + t * 132 + part * 16; float x[16]; float ss = 0.f;
#pragma unroll
        for (int j = 0; j < 4; ++j) { const f32x4 v4 = *(const f32x4*)(orow + 4 * j); x[4 * j] = v4[0]; x[4 * j + 1] = v4[1]; x[4 * j + 2] = v4[2]; x[4 * j + 3] = v4[3]; ss += (v4[0] * v4[0] + v4[1] * v4[1]) + (v4[2] * v4[2] + v4[3] * v4[3]); }
        ss += __shfl_xor(ss, 1); ss += __shfl_xor(ss, 2); ss += __shfl_xor(ss, 4);
        const float rstd = rsqrtf(ss * (1.f / 128.f) + EPSN);
        const int ch = h * 128 + part * 16; const float* gn = p.a_norm + l * 512 + ch;
        const bf16_t* gp = PROJ + (size_t)(lt0 + t) * NP + C_GA + ch; const u32x4 g0 = *(const u32x4*)gp, g1 = *(const u32x4*)(gp + 8);
        unsigned o[8];
#pragma unroll
        for (int q = 0; q < 8; ++q) { const unsigned gw = q < 4 ? g0[q & 3] : g1[q & 3];
            const float y0 = x[2 * q] * rstd * gn[2 * q] * silu(__uint_as_float(gw << 16)), y1 = x[2 * q + 1] * rstd * gn[2 * q + 1] * silu(__uint_as_float(gw & 0xffff0000u)); o[q] = pk2(y0, y1); }
        bf16_t* op = (bf16_t*)(p.ws + WS_OA) + (size_t)(lt0 + t) * 512 + ch;
        *(u32x4*)op = (u32x4){o[0], o[1], o[2], o[3]}; *(u32x4*)(op + 8) = (u32x4){o[4], o[5], o[6], o[7]};
    }
    __syncthreads();
}

DI void scanC_ssd(CParams& p, unsigned char* lds, int l, int hf, int c, int g) {
    const int tid = get_tid(), lane = tid & 63, wave = __builtin_amdgcn_readfirstlane(tid >> 6), l31 = lane & 31, lh = lane >> 5;
    const bf16_t* PROJ = (const bf16_t*)(p.ws + WS_PROJ);
    bf16_t* XT = (bf16_t*)lds;
    bf16_t* BM = (bf16_t*)(lds + 36864);
    bf16_t* CM = (bf16_t*)(lds + 46080);
    float* CB = (float*)(lds + 55296);
    float* ACUM = (float*)(lds + 72704);
    float* DTS = (float*)(lds + 74752);
    float* SSQ = (float*)(lds + 76800);
    const int lt0 = c * 64; bool hp, hn; chunk_halo(hf, c, hp, hn);
    {
        const int hh = wave >> 1, d = wave & 1, head = g * 4 + hh; float dt, a, ac, total; ssd_dt(p, PROJ, l, lt0, head, d, lane, dt, a, ac, total);
        ACUM[wave * 64 + lane] = (d == 0) ? ac : (total - ac + a); DTS[wave * 64 + lane] = dt;
    }
#pragma unroll 1
    for (int it = tid; it < 2048; it += NTHR) { const int sg = it >> 8, cl = it & 255; *(u32x4*)(XT + cl * 72 + sg * 8) = conv8(p, PROJ, l, lt0, sg * 8, g * 256 + cl, hp, hn); }
#pragma unroll 1
    for (int it = tid; it < 1024; it += NTHR) { const int s = it >> 4, j = it & 15; const int isC = j >> 3, n8 = (j & 7) * 8;
        *(u32x4*)((isC ? CM : BM) + s * 72 + n8) = conv8c(p, PROJ, l, lt0, s, 1024 + isC * 256 + g * 64 + n8, hp, hn); }
    __syncthreads();
    if (wave < 4) { const int tr = wave >> 1, tc = wave & 1; f32x16 acc = zero16();
#pragma unroll
        for (int ks = 0; ks < 4; ++ks) { const bf16x8 a = *(const bf16x8*)(CM + (tr * 32 + l31) * 72 + ks * 16 + 8 * lh), b = *(const bf16x8*)(BM + (tc * 32 + l31) * 72 + ks * 16 + 8 * lh); acc = mfma32(a, b, acc); }
#pragma unroll
        for (int i = 0; i < 16; ++i) { const int t = tr * 32 + 8 * (i >> 2) + 4 * lh + (i & 3); CB[t * 68 + tc * 32 + l31] = acc[i]; }
    }
    __syncthreads();
    const int hh = wave >> 1, th = wave & 1, head = g * 4 + hh;
    f32x16 acc[2]; acc[0] = zero16(); acc[1] = zero16();
    {
        const bf16_t* SBp = (const bf16_t*)(p.ws + WS_SB);
        const int t = th * 32 + l31;
#pragma unroll 1
        for (int d = 0; d < 2; ++d) { const int combo = hh * 2 + d;
            bf16x8 sfr[2][4];
#pragma unroll
            for (int ct = 0; ct < 2; ++ct)
#pragma unroll
                for (int ks = 0; ks < 4; ++ks) sfr[ct][ks] = *(const bf16x8*)(SBp + (size_t)((c * 16 + head) * 2 + d) * 4096 + (ct * 32 + l31) * 64 + ks * 16 + 8 * lh);
            const float at = ACUM[combo * 64 + t];
#pragma unroll
            for (int ks = 0; ks < 4; ++ks) { const int s0 = ks * 16 + 8 * lh; float m[8];
                const f32x4 c0 = *(const f32x4*)(CB + t * 68 + s0), c1 = *(const f32x4*)(CB + t * 68 + s0 + 4);
                const f32x4 a0 = *(const f32x4*)(ACUM + combo * 64 + s0), a1 = *(const f32x4*)(ACUM + combo * 64 + s0 + 4);
                const f32x4 d0 = *(const f32x4*)(DTS + combo * 64 + s0), d1 = *(const f32x4*)(DTS + combo * 64 + s0 + 4);
#pragma unroll
                for (int j = 0; j < 8; ++j) { const int s = s0 + j; const bool keep = (d == 0) ? (t >= s) : (t <= s); const float cbv = j < 4 ? c0[j & 3] : c1[j & 3], as = j < 4 ? a0[j & 3] : a1[j & 3], ds = j < 4 ? d0[j & 3] : d1[j & 3];
                    m[j] = keep ? cbv * __expf(fminf(at - as, 0.f)) * ds : 0.f; }
                u32x4 o; o.x = pk2(m[0], m[1]); o.y = pk2(m[2], m[3]); o.z = pk2(m[4], m[5]); o.w = pk2(m[6], m[7]); const bf16x8 a = __builtin_bit_cast(bf16x8, o);
#pragma unroll
                for (int ct = 0; ct < 2; ++ct) { const bf16x8 b = *(const bf16x8*)(XT + (hh * 64 + ct * 32 + l31) * 72 + s0); acc[ct] = mfma32(a, b, acc[ct]); } }
            f32x16 acc2[2]; acc2[0] = zero16(); acc2[1] = zero16();
#pragma unroll
            for (int ks = 0; ks < 4; ++ks) { const bf16x8 a = *(const bf16x8*)(CM + (th * 32 + l31) * 72 + ks * 16 + 8 * lh);
#pragma unroll
                for (int ct = 0; ct < 2; ++ct) acc2[ct] = mfma32(a, sfr[ct][ks], acc2[ct]); }
#pragma unroll
            for (int i = 0; i < 16; ++i) { const int ti = th * 32 + 8 * (i >> 2) + 4 * lh + (i & 3); const float sc = __expf(ACUM[combo * 64 + ti]); acc[0][i] += sc * acc2[0][i]; acc[1][i] += sc * acc2[1][i]; }
        }
    }
    {
        const float dsk = p.d_skip[l * 16 + head];
#pragma unroll
        for (int i = 0; i < 16; ++i) { const int ti = th * 32 + 8 * (i >> 2) + 4 * lh + (i & 3); float part = 0.f;
#pragma unroll
            for (int ct = 0; ct < 2; ++ct) { const int pc = ct * 32 + l31; const float xv = bf2f(XT[(hh * 64 + pc) * 72 + ti]); const float z = bf2f(PROJ[(size_t)(lt0 + ti) * NP + C_Z + head * 64 + pc]);
                const float y = (acc[ct][i] + dsk * xv) * silu(z); acc[ct][i] = y; part += y * y; }
            part += __shfl_xor(part, 1); part += __shfl_xor(part, 2); part += __shfl_xor(part, 4); part += __shfl_xor(part, 8); part += __shfl_xor(part, 16);
            if (l31 == 0) SSQ[hh * 64 + ti] = part;
            if ((i & 3) == 3) asm volatile("" ::: "memory"); }
    }
    __syncthreads();
    {
        bf16_t* YB = (bf16_t*)(p.ws + WS_YB);
#pragma unroll
        for (int i = 0; i < 16; ++i) { const int ti = th * 32 + 8 * (i >> 2) + 4 * lh + (i & 3); const float ss = (SSQ[ti] + SSQ[64 + ti]) + (SSQ[128 + ti] + SSQ[192 + ti]); const float rstd = rsqrtf(ss * (1.f / 256.f) + EPSN);
#pragma unroll
            for (int ct = 0; ct < 2; ++ct) { const int ch = head * 64 + ct * 32 + l31; YB[(size_t)(lt0 + ti) * 1024 + ch] = (bf16_t)f2bf(acc[ct][i] * rstd * p.b_norm[l * 1024 + ch]); } }
    }
    __syncthreads();
}
DI void phase_scanC(CParams& p, unsigned char* lds, int l, int hf, int bid, int nb) {
    for (int it = bid; it < 2 * NCH * 4; it += nb) {
#ifndef NO_C_HGRN
        if (it < NCH * 4) scanC_hgrn(p, lds, l, hf, it >> 2, it & 3);
#endif
#ifndef NO_C_SSD
        if (it >= NCH * 4) { const int j = it - NCH * 4; scanC_ssd(p, lds, l, hf, j >> 2, j & 3); }
#endif
    }
}

template <class Epi> DI void run_gemm(unsigned char* lds, const bf16_t* A, const bf16_t* Bt, int N, int K, const Epi& E) {
    int Mo = HT; asm volatile("" : "+s"(N), "+s"(K), "+s"(Mo));
    pg8::Gemm g{A, Bt, Mo, N, K}; pg8::StaticOrder S; S.init(Mo, N, (int)gridDim.x, (int)blockIdx.x);
    pg8::gemm_phase<Epi, pg8::StaticOrder, false>((PG8_LAS unsigned char*)lds, g, S, E, nullptr);
    __syncthreads();
}

DI void run_phase(CParams& p, unsigned char* lds, int ph, int bid, int nb) {
    unsigned char* ws = p.ws;
    if (ph == 0) { phase_init(p, lds, bid, nb); return; }
    if (ph == 89) { phase_final_norm(p, bid, nb); return; }
    const int q = ph - 1; const int lh2 = q / 11, sub = q % 11; const int l = lh2 >> 1, hf = lh2 & 1;
    const float* MODL = (const float*)(ws + WS_MOD) + (size_t)l * 5 * 6144;
#ifndef PH_MASK
#define PH_MASK 0xFFFF
#endif
#define PH_ON(i) ((PH_MASK >> (i)) & 1)
    switch (sub) {
    case 0: if (PH_ON(0)) { if (hf == 0) phase_wconv(p, lds, l, bid, nb); phase_norm(p, l, hf, 0, bid, nb); } break;
    case 1: if (PH_ON(1)) { pg8::EpiBf16<0> E{(bf16_t*)(ws + WS_PROJ), NP, nullptr, 0, 0}; run_gemm(lds, (const bf16_t*)(ws + WS_U), (const bf16_t*)(ws + WS_WIN), NP, 1024, E); } break;
    case 2: if (PH_ON(2)) phase_scanA(p, lds, l, hf, bid, nb); break;
    case 3: if (PH_ON(3)) phase_scanB(p, l, hf, bid, nb); break;
    case 4: if (PH_ON(4)) phase_scanC(p, lds, l, hf, bid, nb); break;
    case 5: if (PH_ON(5)) { pg8::EpiGateF32 E1{(float*)(ws + WS_SA), (const bf16_t*)(ws + WS_PROJ), NP, C_GATE}; run_gemm(lds, (const bf16_t*)(ws + WS_OA), (const bf16_t*)(ws + WS_WBRA), 1024, 512, E1);
              pg8::EpiGateAddBf16 E2{(const float*)(ws + WS_SA), (bf16_t*)(ws + WS_U), (const bf16_t*)(ws + WS_PROJ), NP, C_GATE + 1024}; run_gemm(lds, (const bf16_t*)(ws + WS_YB), (const bf16_t*)(ws + WS_WBRB), 1024, 1024, E2); } break;
    case 6: if (PH_ON(6)) { pg8::EpiResid E{p.out, MODL + 2048, hf * HT}; run_gemm(lds, (const bf16_t*)(ws + WS_U), (const bf16_t*)(ws + WS_WOUT), 1024, 1024, E); } break;
    case 7: if (PH_ON(7)) phase_norm(p, l, hf, 1, bid, nb); break;
    case 8: if (PH_ON(8)) { pg8::EpiBf16<0> E{(bf16_t*)(ws + WS_PROJ), NUP, nullptr, 0, 0}; run_gemm(lds, (const bf16_t*)(ws + WS_U), (const bf16_t*)(ws + WS_WUP), NUP, 1024, E); } break;
    case 9: if (PH_ON(9)) phase_convact(p, l, hf, bid, nb); break;
    case 10: if (PH_ON(10)) { pg8::EpiResid E{p.out, MODL + 5120, hf * HT}; run_gemm(lds, (const bf16_t*)(ws + WS_SA), (const bf16_t*)(ws + WS_WDN), 1024, DFF, E); } break;
    }
}
constexpr int NPHASE = 90;

__global__ void __launch_bounds__(512, 2) mega_fwd(Params p_unused) {
    extern __shared__ __attribute__((aligned(16))) unsigned char lds[];
    const int bid = blockIdx.x, nb = gridDim.x;
    CParams* pk = (CParams*)__builtin_amdgcn_kernarg_segment_ptr();
    const int lo = pk->ph_lo, hi = pk->ph_hi;
    for (int ph = lo; ph < hi; ++ph) {
        CParams* q = pk; asm volatile("" : "+s"(q));
        run_phase(*q, lds, ph, bid, nb);
        if (ph + 1 < hi) cg::this_grid().sync();
    }
}

constexpr int LDS_BYTES = 131072;
extern "C" void kernel_launch(void* const* d_in, const int* in_sizes, int n_in, void* d_out, int out_size, void* d_ws, size_t ws_size, hipStream_t stream) {
    static int grid = 0;
    if (grid == 0) {
        if (n_in != 27 || ws_size < WS_END) { fprintf(stderr, "kernel_launch: unexpected n_in %d / ws_size %zu\n", n_in, ws_size); grid = -1; return; }
        int dev = 0, cus = 0, per_cu = 0;
        hipGetDevice(&dev); hipDeviceGetAttribute(&cus, hipDeviceAttributeMultiprocessorCount, dev);
        if (hipFuncSetAttribute((const void*)mega_fwd, hipFuncAttributeMaxDynamicSharedMemorySize, LDS_BYTES) != hipSuccess) { fprintf(stderr, "hipFuncSetAttribute failed\n"); grid = -1; return; }
        if (hipOccupancyMaxActiveBlocksPerMultiprocessor(&per_cu, (const void*)mega_fwd, 512, LDS_BYTES) != hipSuccess || per_cu < 1) { fprintf(stderr, "occupancy query: %d\n", per_cu); per_cu = 1; }
        (void)hipGetLastError();
        grid = cus * 1;
    }
    if (grid < 0) return;
    Params p{};
    const float** pp = (const float**)&p;
    for (int i = 0; i < 27; ++i) pp[i] = (const float*)d_in[i];
    p.out = (float*)d_out; p.ws = (unsigned char*)d_ws;
#if MULTI
    for (int ph = 0; ph < NPHASE; ++ph) { p.ph_lo = ph; p.ph_hi = ph + 1; hipLaunchKernelGGL(mega_fwd, dim3(grid), dim3(512), LDS_BYTES, stream, p); }
#else
    p.ph_lo = 0; p.ph_hi = NPHASE;
    void* args[] = {&p};
    hipError_t e = hipLaunchCooperativeKernel((const void*)mega_fwd, dim3(grid), dim3(512), args, LDS_BYTES, stream);
    if (e != hipSuccess) fprintf(stderr, "cooperative launch failed: %s (grid %d)\n", hipGetErrorString(e), grid);
#endif
}
```

```cpp
#include <hip/hip_runtime.h>
#include <hip/hip_cooperative_groups.h>
#include <cstdio>
namespace cg = cooperative_groups;
#define MULTI 0
namespace pg8 {
#define PG8_LAS __attribute__((address_space(3)))
typedef unsigned short bf16_t;
typedef short bf16x8 __attribute__((ext_vector_type(8)));
typedef float f32x4 __attribute__((ext_vector_type(4)));
typedef unsigned u32x4 __attribute__((ext_vector_type(4)));
constexpr int BM = 256, BK = 64, HALF = 128, HTB = HALF * BK * 2  , STAGE_BYTES = 8 * HTB, NXCD = 8, WGM = 8;

__host__ __device__ __forceinline__ int lds_byte(int r, int c) { const int st = (r >> 4) * 2 + (c >> 5), rr = r & 15, cc = c & 31, ob = rr * 64 + cc * 2; return st * 1024 + (ob ^ (((ob >> 9) & 1) << 5)); }
__host__ __device__ __forceinline__ void stage_rc(int b, int& R, int& C) { const int st = b / 1024, sb = b % 1024, swz = sb ^ (((sb >> 9) & 1) << 5); R = (st >> 1) * 16 + swz / 64; C = (st & 1) * 32 + (swz % 64) / 2; }
__host__ __device__ __forceinline__ int perm32(int rho) { const int n = rho >> 4, i = rho & 15; return 8 * (i >> 2) + 4 * n + (i & 3); }

struct Unit { int pm, pn; };
struct Gemm { const bf16_t* A; const bf16_t* Bt; int M, N, K; };

struct StaticOrder {
    int nM, nN, nwg, G, c;
    __host__ __device__ void init(int M, int N, int G_, int c_) { nM = M / BM; nN = N / BM; nwg = nM * nN; G = G_; c = c_; }
    __host__ __device__ bool next(int i, Unit& u) const {
        const long L = (long)i * G + c; if (L >= nwg) return false;
        int wgid = (int)L; { const int q = nwg / NXCD, r = nwg % NXCD, xcd = wgid % NXCD, off = wgid / NXCD; wgid = (xcd < r ? xcd * (q + 1) : r * (q + 1) + (xcd - r) * q) + off; }
        const int nig = WGM * nN, gid = wgid / nig, fm = gid * WGM, gsz = (nM - fm) < WGM ? (nM - fm) : WGM;
        u.pm = fm + ((wgid % nig) % gsz); u.pn = (wgid % nig) / gsz; return true;
    }
    __device__ __forceinline__ void a_ready(const Unit&) const {}
    __device__ __forceinline__ void done(const Unit&) const {}
};
__device__ __forceinline__ unsigned cvt_pk_bf16(float lo, float hi) { unsigned r; asm volatile("v_cvt_pk_bf16_f32 %0, %1, %2" : "=v"(r) : "v"(lo), "v"(hi)); return r; }
typedef float f32x2 __attribute__((ext_vector_type(2)));
__device__ __forceinline__ f32x2 gelu_pk(f32x2 v) {
    const f32x2 av = __builtin_elementwise_abs(v), d = av * 0.2316418882f + 1.0f;
    f32x2 t; t.x = __builtin_amdgcn_rcpf(d.x); t.y = __builtin_amdgcn_rcpf(d.y);
    f32x2 q = t * 0.5307027145f + (-0.7265760135f); q = q * t + 0.7107068705f; q = q * t + (-0.142248368f); q = q * t + 0.127414796f; q = q * t;
    const f32x2 s = (v * v) * (-0.72134752044f);
    f32x2 e; e.x = __builtin_amdgcn_exp2f(s.x); e.y = __builtin_amdgcn_exp2f(s.y);
    const f32x2 m = v * (q * e), r = v - m;
    f32x2 o; o.x = v.x < 0.f ? m.x : r.x; o.y = v.y < 0.f ? m.y : r.y; return o;
}
template <int ACT  > struct EpiBf16 {
    static constexpr bool PERM = true, AFTER_DRAIN = false; static constexpr int TMID = -1;
    bf16_t* O; int ldc; const float* bias; int split_cols; size_t split_stride;
    __device__ __forceinline__ void operator()(const f32x4 (&acc)[2][2][4][2], const Unit& u, int wr, int wc, int fr, int fq) const {
        const int row0 = u.pm * BM + wr * 64 + fr; int colt = u.pn * BM; bf16_t* base = O;
        if (split_cols) { const int t = colt / split_cols; base += (size_t)t * split_stride; colt -= t * split_cols; }
        const int col0 = colt + wc * 32 + 8 * fq, bcol0 = u.pn * BM + wc * 32 + 8 * fq;
        f32x4 bv[2][2];
#pragma unroll
        for (int bj = 0; bj < 2; ++bj)
#pragma unroll
            for (int n = 0; n < 2; ++n) bv[bj][n] = bias ? *(const f32x4*)(bias + bcol0 + bj * HALF + 4 * n) : (f32x4){0.f, 0.f, 0.f, 0.f};
#pragma unroll
        for (int ai = 0; ai < 2; ++ai)
#pragma unroll
            for (int m = 0; m < 4; ++m) { bf16_t* rowp = base + (size_t)(row0 + ai * HALF + m * 16) * ldc + col0;
#pragma unroll
                for (int bj = 0; bj < 2; ++bj) { f32x4 v0 = acc[ai][bj][m][0] + bv[bj][0], v1 = acc[ai][bj][m][1] + bv[bj][1];
                    if (ACT == 1) { f32x2 a = gelu_pk((f32x2){v0[0], v0[1]}), b = gelu_pk((f32x2){v0[2], v0[3]}), c = gelu_pk((f32x2){v1[0], v1[1]}), d = gelu_pk((f32x2){v1[2], v1[3]});
                        v0 = (f32x4){a.x, a.y, b.x, b.y}; v1 = (f32x4){c.x, c.y, d.x, d.y}; }
                    if (ACT == 2) {
#pragma unroll
                        for (int j = 0; j < 4; ++j) { v0[j] = 0.5f * v0[j] * (1.0f + erff(v0[j] * 0.70710678f)); v1[j] = 0.5f * v1[j] * (1.0f + erff(v1[j] * 0.70710678f)); } }
                    u32x4 w; w.x = cvt_pk_bf16(v0[0], v0[1]); w.y = cvt_pk_bf16(v0[2], v0[3]); w.z = cvt_pk_bf16(v1[0], v1[1]); w.w = cvt_pk_bf16(v1[2], v1[3]);
                    *(u32x4*)(rowp + bj * HALF) = w; } }
    }
};
__device__ __forceinline__ float epi_bf2f(unsigned short b) { return __uint_as_float(((unsigned)b) << 16); }
__device__ __forceinline__ float epi_sigmoid(float x) { return __builtin_amdgcn_rcpf(1.f + __expf(-x)); }
typedef unsigned u32x2 __attribute__((ext_vector_type(2)));
struct EpiBf16Act {
    static constexpr bool PERM = true, AFTER_DRAIN = false; static constexpr int TMID = -1;
    bf16_t* O; int ldc; int silu_pm_lt, silu_pn_lt, sig_pn_ge;
    __device__ __forceinline__ void operator()(const f32x4 (&acc)[2][2][4][2], const Unit& u, int wr, int wc, int fr, int fq) const {
        const int row0 = u.pm * BM + wr * 64 + fr, col0 = u.pn * BM + wc * 32 + 8 * fq;
        int act = 0; if (u.pm < silu_pm_lt) act = 1; if (u.pn < silu_pn_lt) act = 1; else if (u.pn >= sig_pn_ge) act = 2;
#pragma unroll
        for (int ai = 0; ai < 2; ++ai)
#pragma unroll
            for (int m = 0; m < 4; ++m) { bf16_t* rowp = O + (size_t)(row0 + ai * HALF + m * 16) * ldc + col0;
#pragma unroll
                for (int bj = 0; bj < 2; ++bj) { f32x4 v0 = acc[ai][bj][m][0], v1 = acc[ai][bj][m][1];
                    if (act) {
#pragma unroll
                        for (int j = 0; j < 4; ++j) { const float s0 = __builtin_amdgcn_rcpf(1.f + __expf(-v0[j])), s1 = __builtin_amdgcn_rcpf(1.f + __expf(-v1[j]));
                            v0[j] = (act == 1) ? v0[j] * s0 : s0; v1[j] = (act == 1) ? v1[j] * s1 : s1; } }
                    u32x4 w; w.x = cvt_pk_bf16(v0[0], v0[1]); w.y = cvt_pk_bf16(v0[2], v0[3]); w.z = cvt_pk_bf16(v1[0], v1[1]); w.w = cvt_pk_bf16(v1[2], v1[3]);
                    *(u32x4*)(rowp + bj * HALF) = w; } }
    }
};
struct EpiGateMerge {
    static constexpr bool PERM = false, AFTER_DRAIN = false; static constexpr int TMID = 8;
    bf16_t* O; const bf16_t* G; int ldg; int goffA, goffB;
    __device__ __forceinline__ void mid(f32x4 (&acc)[2][2][4][2], const Unit& u, int wr, int wc, int fr, int fq) const {
        int row0 = u.pm * BM + wr * 64 + fr, col0 = u.pn * BM + wc * 32 + 4 * fq;
        asm volatile("" : "+v"(row0), "+v"(col0));
#pragma unroll
        for (int ai = 0; ai < 2; ++ai)
#pragma unroll
            for (int m = 0; m < 4; ++m) { const int row = row0 + ai * HALF + m * 16; const bf16_t* gp = G + (size_t)row * ldg + col0;
#pragma unroll
                for (int bj = 0; bj < 2; ++bj)
#pragma unroll
                    for (int n = 0; n < 2; ++n) { const u32x2 ga = *(const u32x2*)(gp + goffA + bj * HALF + n * 16), gb = *(const u32x2*)(gp + goffB + bj * HALF + n * 16);
                        const float a0 = __uint_as_float(ga.x << 16), a1 = __uint_as_float(ga.x & 0xffff0000u), a2 = __uint_as_float(ga.y << 16), a3 = __uint_as_float(ga.y & 0xffff0000u);
                        const float b0 = __uint_as_float(gb.x << 16), b1 = __uint_as_float(gb.x & 0xffff0000u), b2 = __uint_as_float(gb.y << 16), b3 = __uint_as_float(gb.y & 0xffff0000u);
                        f32x4 r; r[0] = a0 * __builtin_amdgcn_rcpf(b0); r[1] = a1 * __builtin_amdgcn_rcpf(b1); r[2] = a2 * __builtin_amdgcn_rcpf(b2); r[3] = a3 * __builtin_amdgcn_rcpf(b3);
                        acc[ai][bj][m][n] = acc[ai][bj][m][n] * r; }
                asm volatile("" ::: "memory"); }
    }
    __device__ __forceinline__ void operator()(const f32x4 (&acc)[2][2][4][2], const Unit& u, int wr, int wc, int fr, int fq) const {
        const int row0 = u.pm * BM + wr * 64 + fr, col0 = u.pn * BM + wc * 32 + 4 * fq;
#pragma unroll
        for (int ai = 0; ai < 2; ++ai)
#pragma unroll
            for (int m = 0; m < 4; ++m) { const int row = row0 + ai * HALF + m * 16; bf16_t* op = O + (size_t)row * 1024 + col0; const bf16_t* gp = G + (size_t)row * ldg + goffB + col0;
#pragma unroll
                for (int bj = 0; bj < 2; ++bj)
#pragma unroll
                    for (int n = 0; n < 2; ++n) { const u32x2 gw = *(const u32x2*)(gp + bj * HALF + n * 16); const f32x4 a = acc[ai][bj][m][n]; f32x4 o;
                        o[0] = a[0] * __uint_as_float(gw.x << 16); o[1] = a[1] * __uint_as_float(gw.x & 0xffff0000u);
                        o[2] = a[2] * __uint_as_float(gw.y << 16); o[3] = a[3] * __uint_as_float(gw.y & 0xffff0000u);
                        u32x2 w; w.x = cvt_pk_bf16(o[0], o[1]); w.y = cvt_pk_bf16(o[2], o[3]);
                        *(u32x2*)(op + bj * HALF + n * 16) = w; } }
    }
};
struct EpiResid {
    static constexpr bool PERM = false, AFTER_DRAIN = false; static constexpr int TMID = -1;
    float* X; const float* MODG; int rowbase; const float* Xp; const float* Xs;
    __device__ __forceinline__ void operator()(const f32x4 (&acc)[2][2][4][2], const Unit& u, int wr, int wc, int fr, int fq) const {
        const int row0 = rowbase + u.pm * BM + wr * 64 + fr, col0 = u.pn * BM + wc * 32 + 4 * fq;
        const int tok0 = rowbase + u.pm * BM; const int grp = tok0 < 8192 ? 0 : 1 + ((tok0 - 8192) >> 12);
        const float* src = Xp ? (tok0 < 8192 ? Xp : Xs - (size_t)8192 * 1024) : X;
        const float* gv = MODG + (size_t)grp * 6144 + col0;
        f32x4 g[2][2];
#pragma unroll
        for (int bj = 0; bj < 2; ++bj)
#pragma unroll
            for (int n = 0; n < 2; ++n) g[bj][n] = *(const f32x4*)(gv + bj * HALF + n * 16);
#pragma unroll
        for (int ai = 0; ai < 2; ++ai)
#pragma unroll
            for (int m = 0; m < 4; ++m) { float* rowp = X + (size_t)(row0 + ai * HALF + m * 16) * 1024 + col0; const float* srcp = src + (size_t)(row0 + ai * HALF + m * 16) * 1024 + col0;
#pragma unroll
                for (int bj = 0; bj < 2; ++bj)
#pragma unroll
                    for (int n = 0; n < 2; ++n) { f32x4 x = *(const f32x4*)(srcp + bj * HALF + n * 16); x = x + g[bj][n] * acc[ai][bj][m][n]; *(f32x4*)(rowp + bj * HALF + n * 16) = x; } }
    }
};
template <class Epi, class Sched, bool STAMP = false>
__device__ __forceinline__ void gemm_phase(PG8_LAS unsigned char* lds, const Gemm g, const Sched& S, const Epi& E, unsigned long long* stamps) {
    int tid_l = threadIdx.x; asm volatile("" : "+v"(tid_l)); const int tid = tid_l, wid = __builtin_amdgcn_readfirstlane(tid >> 6), lane = tid & 63, wr = wid >> 2, wc = wid & 3, fr = lane & 15, fq = lane >> 4;
    const int K = g.K, nt = K / BK;
    int ts_lo = 0, ts_hi = 0, nts = 0; const unsigned long long rt_entry = STAMP ? (unsigned long long)wall_clock64() : 0ull;
#define PG8_STAMP() do { if (STAMP && wid == 0 && nts < 64) { const unsigned long long _c = (unsigned long long)clock64(); \
        ts_lo = (lane == nts) ? (int)(unsigned)_c : ts_lo; ts_hi = (lane == nts) ? (int)(unsigned)(_c >> 32) : ts_hi; ++nts; } } while (0)
    PG8_STAMP();
    unsigned voffA[2], voffB[2];
#pragma unroll
    for (int i = 0; i < 2; ++i) { int R, C; stage_rc(tid * 16 + i * 8192, R, C); const int Rb = Epi::PERM ? ((R & ~31) + perm32(R & 31)) : R;
        voffA[i] = (unsigned)(R * K + C) * 2u; voffB[i] = (unsigned)(Rb * K + C) * 2u; }
    const size_t kstep = (size_t)(BK * 2);
    const size_t hstep = (size_t)HALF * K * 2;
    const size_t tstep = 2 * hstep;
    const unsigned ldsw = (unsigned)wid * 1024u;
    const int aoff = lds_byte(wr * 64 + fr, fq * 8), boff = lds_byte(wc * 32 + fr, fq * 8);
#define PG8_SA(b, h) (((b) * 2 + (h)) * HTB)
#define PG8_SB(b, h) ((4 + (b) * 2 + (h)) * HTB)
#define PG8_STAGE(bufoff, gbase, voff) do { _Pragma("unroll") for (int _i = 0; _i < 2; ++_i) \
        __builtin_amdgcn_global_load_lds((const unsigned*)((const char*)(gbase) + (voff)[_i]), (PG8_LAS unsigned*)(lds + (bufoff) + ldsw + _i * 8192), 16, 0, 0); } while (0)
#define PG8_LDA(dst, b, h) do { _Pragma("unroll") for (int m = 0; m < 4; ++m) _Pragma("unroll") for (int k = 0; k < 2; ++k) dst[m][k] = *(const PG8_LAS bf16x8*)(lds + PG8_SA(b, h) + aoff + m * 2048 + k * 1024); } while (0)
#define PG8_LDB(dst, b, h) do { _Pragma("unroll") for (int n = 0; n < 2; ++n) _Pragma("unroll") for (int k = 0; k < 2; ++k) dst[n][k] = *(const PG8_LAS bf16x8*)(lds + PG8_SB(b, h) + boff + n * 2048 + k * 1024); } while (0)
#define PG8_MMA(ai, bj, At, Bt) do { __builtin_amdgcn_s_setprio(1); _Pragma("unroll") for (int m = 0; m < 4; ++m) _Pragma("unroll") for (int n = 0; n < 2; ++n) _Pragma("unroll") for (int k = 0; k < 2; ++k) \
        acc[ai][bj][m][n] = __builtin_amdgcn_mfma_f32_16x16x32_bf16(Bt[n][k], At[m][k], acc[ai][bj][m][n], 0, 0, 0); __builtin_amdgcn_s_setprio(0); } while (0)
#define PG8_WAIT_V(n) asm volatile("s_waitcnt vmcnt(" #n ")" ::: "memory")
#define PG8_WAIT_L(n) asm volatile("s_waitcnt lgkmcnt(" #n ")" ::: "memory")
#define PG8_BAR __builtin_amdgcn_s_barrier()
#define PG8_SCHED __builtin_amdgcn_sched_barrier(0)
    Unit cur, nxt; int ui = 0;
    if (!S.next(0, cur)) return;
    f32x4 acc[2][2][4][2];
#pragma unroll
    for (int a = 0; a < 2; ++a)
#pragma unroll
        for (int b = 0; b < 2; ++b)
#pragma unroll
            for (int m = 0; m < 4; ++m)
#pragma unroll
                for (int n = 0; n < 2; ++n) acc[a][b][m][n] = (f32x4){0.f, 0.f, 0.f, 0.f};
    bf16x8 At[4][2], B0[2][2], B1[2][2];
    const char* cA = (const char*)g.A + (size_t)cur.pm * tstep; const char* cB = (const char*)g.Bt + (size_t)cur.pn * tstep;
    S.a_ready(cur);
    PG8_STAGE(PG8_SB(0, 0), cB, voffB); PG8_STAGE(PG8_SB(0, 1), cB + hstep, voffB); PG8_STAGE(PG8_SA(0, 0), cA, voffA); PG8_STAGE(PG8_SA(0, 1), cA + hstep, voffA);
    if (wr == 1) PG8_BAR;
    PG8_WAIT_V(2); PG8_BAR;
    PG8_STAGE(PG8_SB(1, 0), cB + kstep, voffB); PG8_STAGE(PG8_SA(1, 0), cA + kstep, voffA); PG8_STAGE(PG8_SB(1, 1), cB + hstep + kstep, voffB);
    PG8_WAIT_V(6); PG8_BAR;
    PG8_STAMP();
    for (;;) {
        const bool has_next = S.next(ui + 1, nxt);
        const char* nA = has_next ? (const char*)g.A + (size_t)nxt.pm * tstep : cA; const char* nB = has_next ? (const char*)g.Bt + (size_t)nxt.pn * tstep : cB;
        for (int t = 0; t < nt; t += 2) {
            const bool last = (t == nt - 2);
            const char* a1 = cA + (size_t)(t + 1) * kstep;
            const char* a2 = last ? nA : cA + (size_t)(t + 2) * kstep; const char* b2 = last ? nB : cB + (size_t)(t + 2) * kstep;
            const char* a3 = a2 + kstep; const char* b3 = b2 + kstep;
            if (last && has_next) S.a_ready(nxt);
            if constexpr (Epi::TMID >= 0) { if (t == Epi::TMID) E.mid(acc, cur, wr, wc, fr, fq); }
            PG8_LDB(B0, 0, 0); PG8_LDB(B1, 0, 1); PG8_SCHED; PG8_LDA(At, 0, 0); PG8_STAGE(PG8_SA(1, 1), a1 + hstep, voffA);
            PG8_WAIT_V(8); PG8_WAIT_L(0); PG8_BAR; PG8_MMA(0, 0, At, B0); PG8_MMA(0, 1, At, B1); PG8_BAR; PG8_SCHED;
            PG8_LDA(At, 0, 1); PG8_STAGE(PG8_SB(0, 0), b2, voffB); PG8_STAGE(PG8_SB(0, 1), b2 + hstep, voffB); PG8_STAGE(PG8_SA(0, 0), a2, voffA);
            PG8_WAIT_V(8); PG8_WAIT_L(0); PG8_BAR; PG8_MMA(1, 0, At, B0); PG8_MMA(1, 1, At, B1); PG8_BAR; PG8_SCHED;
            PG8_LDB(B0, 1, 0); PG8_LDB(B1, 1, 1); PG8_SCHED; PG8_LDA(At, 1, 0); PG8_STAGE(PG8_SA(0, 1), a2 + hstep, voffA);
            PG8_WAIT_V(8); PG8_WAIT_L(0); PG8_BAR; PG8_MMA(0, 0, At, B0); PG8_MMA(0, 1, At, B1); PG8_BAR; PG8_SCHED;
            PG8_LDA(At, 1, 1); PG8_STAGE(PG8_SB(1, 0), b3, voffB); PG8_STAGE(PG8_SB(1, 1), b3 + hstep, voffB); PG8_STAGE(PG8_SA(1, 0), a3, voffA);
            PG8_WAIT_V(8); PG8_WAIT_L(0); PG8_BAR; PG8_MMA(1, 0, At, B0); PG8_MMA(1, 1, At, B1); PG8_BAR; PG8_SCHED;
        }
        PG8_STAMP();
        if (wr == 0) PG8_BAR;
        if constexpr (!Epi::AFTER_DRAIN) { E(acc, cur, wr, wc, fr, fq); S.done(cur); }
        PG8_STAMP();
        if (!has_next) break;
#pragma unroll
        for (int a = 0; a < 2; ++a)
#pragma unroll
            for (int b = 0; b < 2; ++b)
#pragma unroll
                for (int m = 0; m < 4; ++m)
#pragma unroll
                    for (int n = 0; n < 2; ++n) acc[a][b][m][n] = (f32x4){0.f, 0.f, 0.f, 0.f};
        cur = nxt; cA = nA; cB = nB; ++ui;
        if (wr == 1) PG8_BAR;
    }
    PG8_WAIT_V(0);
    PG8_BAR;
    if constexpr (Epi::AFTER_DRAIN) { E.fused(acc, cur, wr, wc, fr, fq, lds, wid, lane); S.done(cur); }
    PG8_STAMP();
    if (STAMP && wid == 0) { stamps[lane] = lane < nts ? (((unsigned long long)(unsigned)ts_hi << 32) | (unsigned)ts_lo) : 0ull;
        if (lane == 62) stamps[62] = rt_entry; if (lane == 63) stamps[63] = (unsigned long long)wall_clock64(); }
#undef PG8_STAMP
#undef PG8_SA
#undef PG8_SB
#undef PG8_STAGE
#undef PG8_LDA
#undef PG8_LDB
#undef PG8_MMA
#undef PG8_WAIT_V
#undef PG8_WAIT_L
#undef PG8_BAR
#undef PG8_SCHED
}
}

#ifndef MULTI
#define MULTI 0
#endif
#define DI __device__ __forceinline__
typedef unsigned short bf16_t;
typedef short bf16x8 __attribute__((ext_vector_type(8)));
typedef float f32x4 __attribute__((ext_vector_type(4)));
typedef float f32x16 __attribute__((ext_vector_type(16)));
typedef unsigned u32x4 __attribute__((ext_vector_type(4)));
typedef unsigned u32x2 __attribute__((ext_vector_type(2)));

constexpr int DM = 1024, NLAYER = 4, NP = 7424, NIN = 7200, DFF = 2816, NUP = 5632;
constexpr int TTOK = 24576, HT = 12288, NCH = 192;
constexpr int C_Q = 0, C_V = 512, C_F = 1024, C_GA = 2048, C_Z = 2560, C_XBC = 3584, C_DT = 5120, C_GATE = 5152;
constexpr float EPSN = 1e-6f;
constexpr int NTHR = 512;

constexpr size_t MiB = 1u << 20;
constexpr size_t WS_MOD = 0;
constexpr size_t WS_LB = 512 * 1024;
constexpr size_t WS_DECA = 1 * MiB;
constexpr size_t WS_DECB = 3 * MiB;
constexpr size_t WS_WIN = 4 * MiB;
constexpr size_t WS_WBRA = 19 * MiB;
constexpr size_t WS_WBRB = 20 * MiB;
constexpr size_t WS_WOUT = 22 * MiB;
constexpr size_t WS_WUP = 24 * MiB;
constexpr size_t WS_WDN = 35 * MiB;
constexpr size_t WS_U = 41 * MiB;
constexpr size_t WS_OA = 65 * MiB;
constexpr size_t WS_YB = 77 * MiB;
constexpr size_t WS_SA = 101 * MiB;
constexpr size_t WS_SB = 149 * MiB;
constexpr size_t WS_PROJ = 197 * MiB;
constexpr size_t WS_W2OFS = 368 * MiB;
constexpr size_t WS_END = 410 * MiB;

struct Params {
    const float *x_prompt, *x_sample, *c, *state_hgrn, *state_ssd, *c_ctx, *w_ada, *b_ada, *ln1, *ln2, *ln_f, *w_in, *lb_logits, *a_norm,
        *conv_w, *conv_b, *dt_bias, *a_log, *d_skip, *b_norm, *w_br_a, *w_br_b, *w_out, *w_ff_up, *ff_conv_w, *ff_conv_b, *w_ff_down;
    float* out; unsigned char* ws; int ph_lo, ph_hi;
};
typedef const __attribute__((address_space(4))) Params CParams;
constexpr size_t OUT_SH = (size_t)TTOK * DM;
constexpr size_t OUT_SS = OUT_SH + (size_t)32 * 4 * 2 * 4 * 128 * 128;

DI int get_tid() { int t = threadIdx.x; asm volatile("" : "+v"(t)); return t; }
DI float bf2f(bf16_t b) { return __uint_as_float(((unsigned)b) << 16); }
typedef __bf16 hwbf16x2 __attribute__((ext_vector_type(2)));
typedef float f32x2v __attribute__((ext_vector_type(2)));
DI unsigned pk2(float lo, float hi) { const f32x2v v = {lo, hi}; const hwbf16x2 b = __builtin_convertvector(v, hwbf16x2); return __builtin_bit_cast(unsigned, b); }
DI unsigned f2bf(float f) { return pk2(f, 0.f) & 0xffffu; }
DI void unpack8(const u32x4 r, float* o) { o[0] = __uint_as_float(r.x << 16); o[1] = __uint_as_float(r.x & 0xffff0000u); o[2] = __uint_as_float(r.y << 16); o[3] = __uint_as_float(r.y & 0xffff0000u);
    o[4] = __uint_as_float(r.z << 16); o[5] = __uint_as_float(r.z & 0xffff0000u); o[6] = __uint_as_float(r.w << 16); o[7] = __uint_as_float(r.w & 0xffff0000u); }
DI u32x4 pack8(const float* y) { u32x4 o; o.x = pk2(y[0], y[1]); o.y = pk2(y[2], y[3]); o.z = pk2(y[4], y[5]); o.w = pk2(y[6], y[7]); return o; }
DI float sigm(float x) { return __builtin_amdgcn_rcpf(1.f + __expf(-x)); }
DI float silu(float x) { return x * __builtin_amdgcn_rcpf(1.f + __expf(-x)); }
DI float wave_sum(float v) {
#pragma unroll
    for (int o = 1; o < 64; o <<= 1) v += __shfl_xor(v, o);
    return v;
}
DI f32x16 mfma32(bf16x8 a, bf16x8 b, f32x16 c) { return __builtin_amdgcn_mfma_f32_32x32x16_bf16(a, b, c, 0, 0, 0); }
DI f32x16 zero16() { f32x16 z;
#pragma unroll
    for (int i = 0; i < 16; ++i) z[i] = 0.f; return z; }

struct SeqInfo { int first, nch, latent, batch; };
DI SeqInfo seq_of(int hf, int sq) { SeqInfo s; if (hf == 0) { if (sq < 32) { s.first = 4 * sq; s.nch = 4; s.latent = 0; s.batch = sq; } else { s.first = 128; s.nch = 64; s.latent = 1; s.batch = 0; } }
    else { s.first = 64 * sq; s.nch = 64; s.latent = 1; s.batch = 1 + sq; } return s; }
DI void chunk_halo(int hf, int c, bool& has_prev, bool& has_next) { const bool ctx = (hf == 0 && c < 128); has_prev = ctx && ((c & 3) != 0); has_next = ctx && ((c & 3) != 3); }

DI void phase_init(CParams& p, unsigned char* lds, int bid, int nb) {
    const int tid = get_tid();
    float* MOD = (float*)(p.ws + WS_MOD);
    float* CV = (float*)lds;
    float* RED = (float*)(lds + 20480);
    for (int i = tid; i < 5 * 1024; i += NTHR) { const int g = i >> 10, k = i & 1023; const float v = (g == 0) ? p.c_ctx[k] : p.c[(g - 1) * 1024 + k]; CV[i] = silu(v); }
    __syncthreads();
    for (int item = bid; item < 4 * 48; item += nb) {
        const int l = item / 48, jb = item % 48; const int jj = tid & 31, kp = tid >> 5;
        const float* W = p.w_ada + (size_t)l * 1024 * 6144 + (size_t)(kp * 64) * 6144 + jb * 128 + jj * 4;
        const float fz_ = __uint_as_float((unsigned)(tid >> 31)); f32x4 a0 = {fz_, fz_, fz_, fz_}, a1 = a0, a2 = a0, a3 = a0, a4 = a0;
#pragma unroll 8
        for (int k = 0; k < 64; ++k) { const f32x4 w = *(const f32x4*)(W + (size_t)k * 6144); const int kk = kp * 64 + k;
            a0 += w * CV[kk]; a1 += w * CV[1024 + kk]; a2 += w * CV[2048 + kk]; a3 += w * CV[3072 + kk]; a4 += w * CV[4096 + kk]; }
        float* r = RED + (kp * 5) * 128 + jj * 4;
        *(f32x4*)(r) = a0; *(f32x4*)(r + 128) = a1; *(f32x4*)(r + 256) = a2; *(f32x4*)(r + 384) = a3; *(f32x4*)(r + 512) = a4;
        __syncthreads();
        for (int o = tid; o < 640; o += NTHR) { const int g = o >> 7, col = o & 127; float s = p.b_ada[l * 6144 + jb * 128 + col];
#pragma unroll
            for (int q = 0; q < 16; ++q) s += RED[(q * 5 + g) * 128 + col];
            MOD[(size_t)(l * 5 + g) * 6144 + jb * 128 + col] = s; }
        __syncthreads();
    }
    if (bid == nb - 1) {
        float* LB = (float*)(p.ws + WS_LB);
        for (int i = tid; i < 1024; i += NTHR) { float v[4], mx = -1e30f;
#pragma unroll
            for (int l = 0; l < 4; ++l) { v[l] = p.lb_logits[l * 1024 + i]; mx = fmaxf(mx, v[l]); }
            float s = 0.f;
#pragma unroll
            for (int l = 0; l < 4; ++l) { v[l] = __expf(v[l] - mx); s += v[l]; }
            const float inv = 1.f / s; float cum = 0.f; LB[i] = 0.f;
#pragma unroll
            for (int l = 1; l < 4; ++l) { cum += v[l] * inv; LB[l * 1024 + i] = fmaxf(cum, 0.f); } }
    }
}

template <bool REMAP> DI void transpose_item(const float* W, int K, int N, bf16_t* WT, float* scr, int item, int lane, int ldk = 0, int koff = 0) {
    if (ldk == 0) ldk = K;
    const int nblk = N / 32, kb = item / nblk, nbk = item % nblk, k0 = 64 * kb, n0 = 32 * nbk;
    const int r0 = !REMAP ? n0 : (n0 < 2048 ? n0 : (n0 < 3584 ? 3840 + (n0 - 2048) : (n0 < 5152 ? 2048 + (n0 - 3584) : 3840 + 1536 + (n0 - 5152))));
#pragma unroll 8
    for (int i = 0; i < 32; ++i) { const int kk = 2 * i + (lane >> 5); scr[kk * 33 + (lane & 31)] = W[(size_t)(k0 + kk) * N + n0 + (lane & 31)]; }
    asm volatile("s_waitcnt lgkmcnt(0)" ::: "memory");
    const int c = lane & 7;
#pragma unroll
    for (int j = 0; j < 4; ++j) { const int n = (lane >> 3) + 8 * j; const float* s = scr + (8 * c) * 33 + n;
        u32x4 o; o.x = pk2(s[0 * 33], s[1 * 33]); o.y = pk2(s[2 * 33], s[3 * 33]); o.z = pk2(s[4 * 33], s[5 * 33]); o.w = pk2(s[6 * 33], s[7 * 33]);
        *(u32x4*)(WT + (size_t)(r0 + n) * ldk + koff + k0 + 8 * c) = o; }
    asm volatile("s_waitcnt lgkmcnt(0)" ::: "memory");
}
constexpr int WC_IN = 16 * 225, WC_A = 8 * 32, WC_B = 16 * 32, WC_O = 16 * 32, WC_U = 16 * 176, WC_D = 44 * 32;
constexpr int WC_NIT = WC_IN + WC_A + WC_B + WC_O + WC_U + WC_D;
DI void phase_wconv(CParams& p, unsigned char* lds, int l, int vb, int nvb, int it_lo, int it_hi) {
    const int tid = get_tid(), lane = tid & 63, wave = __builtin_amdgcn_readfirstlane(tid >> 6);
    float* scr = (float*)(lds + wave * 8704);
    const int gw = vb * 8 + wave, NGW = nvb * 8;
    unsigned char* ws = p.ws + ((l & 1) ? WS_W2OFS : 0);
    for (int it = it_lo + gw; it < it_hi; it += NGW) {
        int r = it;
        if (r < WC_IN) { transpose_item<true>(p.w_in + (size_t)l * 1024 * NIN, 1024, NIN, (bf16_t*)(ws + WS_WIN), scr, r, lane); continue; } r -= WC_IN;
        if (r < WC_A) { transpose_item<false>(p.w_br_a + (size_t)l * 512 * 1024, 512, 1024, (bf16_t*)(ws + WS_WBRA), scr, r, lane, 1536, 0); continue; } r -= WC_A;
        if (r < WC_B) { transpose_item<false>(p.w_br_b + (size_t)l * 1024 * 1024, 1024, 1024, (bf16_t*)(ws + WS_WBRA), scr, r, lane, 1536, 512); continue; } r -= WC_B;
        if (r < WC_O) { transpose_item<false>(p.w_out + (size_t)l * 1024 * 1024, 1024, 1024, (bf16_t*)(ws + WS_WOUT), scr, r, lane); continue; } r -= WC_O;
        if (r < WC_U) { transpose_item<false>(p.w_ff_up + (size_t)l * 1024 * NUP, 1024, NUP, (bf16_t*)(ws + WS_WUP), scr, r, lane); continue; } r -= WC_U;
        transpose_item<false>(p.w_ff_down + (size_t)l * DFF * 1024, DFF, 1024, (bf16_t*)(ws + WS_WDN), scr, r, lane);
    }
    if (it_lo == 0) {
        u32x4* z = (u32x4*)((bf16_t*)(ws + WS_WIN) + (size_t)3616 * 1024); const int nz = (3840 - 3616) * 1024 / 8;
        const unsigned uz_ = (unsigned)(tid >> 31);
        for (int i = vb * NTHR + tid; i < nz; i += nvb * NTHR) z[i] = (u32x4){uz_, uz_, uz_, uz_};
    }
    __syncthreads();
}
DI void wconv_side(CParams& p, unsigned char* lds, int l, int hf, int bid, int nb, int it_lo, int it_hi) {
    if (hf != 1 || l >= 3) return;
    if (nb > 192) { if (bid >= 192) phase_wconv(p, lds, l + 1, bid - 192, nb - 192, it_lo, it_hi); }
    else phase_wconv(p, lds, l + 1, bid, nb, it_lo, it_hi);
}

DI void phase_norm(CParams& p, int l, int hf, int which, int bid, int nb) {
    const int tid = get_tid(), lane = tid & 63, wave = __builtin_amdgcn_readfirstlane(tid >> 6);
    const float* MOD = (const float*)(p.ws + WS_MOD);
    bf16_t* U = (bf16_t*)(p.ws + WS_U);
    const float* ln = (which == 0 ? p.ln1 : p.ln2) + l * 1024;
    for (int r = bid * 8 + wave; r < HT; r += nb * 8) {
        const int tok = hf * HT + r; const int grp = tok < 8192 ? 0 : 1 + ((tok - 8192) >> 12);
        const float* md = MOD + (size_t)(l * 5 + grp) * 6144 + which * 3072;
        const float* xsrc = (l == 0 && which == 0) ? (tok < 8192 ? p.x_prompt + (size_t)tok * 1024 : p.x_sample + (size_t)(tok - 8192) * 1024) : p.out + (size_t)tok * 1024;
        const f32x4* xr = (const f32x4*)xsrc + lane;
        f32x4 v[4]; float s = 0.f;
#pragma unroll
        for (int j = 0; j < 4; ++j) { v[j] = xr[64 * j]; s += (v[j].x * v[j].x + v[j].y * v[j].y) + (v[j].z * v[j].z + v[j].w * v[j].w); }
        const float rstd = __builtin_amdgcn_rsqf(wave_sum(s) * (1.f / 1024.f) + EPSN);
        unsigned long long* o8 = (unsigned long long*)(U + (size_t)r * 1024) + lane;
#pragma unroll
        for (int j = 0; j < 4; ++j) { const int col = 4 * (64 * j + lane);
            const f32x4 g = *(const f32x4*)(ln + col), sh = *(const f32x4*)(md + col), sc = *(const f32x4*)(md + 1024 + col);
            const f32x4 y = v[j] * rstd * g * (sc + 1.f) + sh;
            o8[64 * j] = (unsigned long long)pk2(y.x, y.y) | ((unsigned long long)pk2(y.z, y.w) << 32); }
    }
}
DI void phase_final_norm(CParams& p, int bid, int nb) {
    const int tid = get_tid(), lane = tid & 63, wave = __builtin_amdgcn_readfirstlane(tid >> 6);
    for (int r = bid * 8 + wave; r < TTOK; r += nb * 8) {
        f32x4* xr = (f32x4*)(p.out + (size_t)r * 1024) + lane;
        f32x4 v[4]; float s = 0.f;
#pragma unroll
        for (int j = 0; j < 4; ++j) { v[j] = xr[64 * j]; s += (v[j].x * v[j].x + v[j].y * v[j].y) + (v[j].z * v[j].z + v[j].w * v[j].w); }
        const float rstd = __builtin_amdgcn_rsqf(wave_sum(s) * (1.f / 1024.f) + EPSN);
#pragma unroll
        for (int j = 0; j < 4; ++j) { const int col = 4 * (64 * j + lane); const f32x4 g = *(const f32x4*)(p.ln_f + col); xr[64 * j] = v[j] * rstd * g; }
    }
}

DI void phase_convact(CParams& p, int l, int hf, int bid, int nb) {
    const bf16_t* H = (const bf16_t*)(p.ws + WS_PROJ); bf16_t* ACT = (bf16_t*)(p.ws + WS_SA);
    const float* cw = p.ff_conv_w + (size_t)l * 3 * NUP; const float* cb = p.ff_conv_b + (size_t)l * NUP;
    const int tid = get_tid();
    constexpr int NRUN = HT / 32, NITEM = 352 * NRUN, PER_BLK = (NITEM + 255) / 256;
    for (int li = tid; li < PER_BLK; li += NTHR) { const int it = bid * PER_BLK + li; if (it >= NITEM) break;
        const int cg8 = (it % 352) * 8, t0 = (it / 352) * 32;
        const bool latent = (hf == 1) || (t0 >= 8192); const int per = latent ? 64 : 256;
        const bool hp = (t0 & (per - 1)) != 0, hn = ((t0 + 31) & (per - 1)) != per - 1;
        float w[2][3][8], bs[2][8];
#pragma unroll
        for (int hh = 0; hh < 2; ++hh) { const int col = hh * DFF + cg8;
#pragma unroll
            for (int k = 0; k < 3; ++k) { const f32x4 a = *(const f32x4*)(cw + k * NUP + col), b = *(const f32x4*)(cw + k * NUP + col + 4);
#pragma unroll
                for (int j = 0; j < 4; ++j) { w[hh][k][j] = a[j]; w[hh][k][4 + j] = b[j]; } }
            const f32x4 a = *(const f32x4*)(cb + col), b = *(const f32x4*)(cb + col + 4);
#pragma unroll
            for (int j = 0; j < 4; ++j) { bs[hh][j] = a[j]; bs[hh][4 + j] = b[j]; } }
        const bf16_t* ha = H + (size_t)t0 * NUP + cg8; const bf16_t* hb = ha + DFF;
        const unsigned uz_ = (unsigned)(tid >> 31); const u32x4 z4 = {uz_, uz_, uz_, uz_};
        u32x4 am = hp ? *(const u32x4*)(ha - NUP) : z4, bm = hp ? *(const u32x4*)(hb - NUP) : z4;
        u32x4 a0 = *(const u32x4*)ha, b0 = *(const u32x4*)hb;
#pragma unroll 4
        for (int t = 0; t < 32; ++t) {
            const bool more = (t < 31) || hn;
            const u32x4 ap = more ? *(const u32x4*)(ha + (size_t)(t + 1) * NUP) : z4, bp = more ? *(const u32x4*)(hb + (size_t)(t + 1) * NUP) : z4;
            float xa[3][8], xb[3][8]; unpack8(am, xa[0]); unpack8(a0, xa[1]); unpack8(ap, xa[2]); unpack8(bm, xb[0]); unpack8(b0, xb[1]); unpack8(bp, xb[2]);
            float r[8];
#pragma unroll
            for (int j = 0; j < 8; ++j) { const float va = bs[0][j] + w[0][0][j] * xa[0][j] + w[0][1][j] * xa[1][j] + w[0][2][j] * xa[2][j];
                const float vb = bs[1][j] + w[1][0][j] * xb[0][j] + w[1][1][j] * xb[1][j] + w[1][2][j] * xb[2][j]; r[j] = silu(va) * vb; }
            *(u32x4*)(ACT + (size_t)(t0 + t) * DFF + cg8) = pack8(r);
            am = a0; a0 = ap; bm = b0; b0 = bp;
        }
    }
}

constexpr int TQ = 0, TV = 512, TF = 1024, TX = 2048, TDT = 3584, NTROW = 3840;
constexpr int G_GA = 0, G_Z = 512, G_GATE = 1536, NG = 3584;
constexpr size_t WS_PROJG = WS_PROJ + (size_t)NTROW * HT * 2;
DI void hgrn_gates(const u32x4 (&raw)[4], float lb, float* SUMS, int d, int sh, int k, float (&f)[32], float& PA, float& PB) {
    const float oml = 1.f - lb; float loc = 1.f;
#pragma unroll
    for (int j = 0; j < 4; ++j) unpack8(raw[j], &f[8 * j]);
#pragma unroll
    for (int j = 0; j < 32; ++j) { f[j] = fmaxf(lb + oml * sigm(f[j]), 1e-30f); loc *= f[j]; }
    SUMS[(d * 2 + sh) * 128 + k] = loc;
    __syncthreads();
    PA = SUMS[(d * 2) * 128 + k]; PB = SUMS[(d * 2 + 1) * 128 + k];
}
DI void stage_vt(const bf16_t* PROJT, int lt0, int h, bf16_t* VT, int tid) {
#pragma unroll
    for (int r = 0; r < 2; ++r) { const int idx = tid + 512 * r, v = idx >> 3, o = idx & 7;
        *(u32x4*)(VT + v * 72 + o * 8) = *(const u32x4*)(PROJT + (size_t)(TV + h * 128 + v) * HT + lt0 + o * 8); }
}

DI void scanA_hgrn(CParams& p, unsigned char* lds, int l, int hf, int c, int h) {
    const int tid = get_tid(), lane = tid & 63, wave = __builtin_amdgcn_readfirstlane(tid >> 6), l31 = lane & 31, lh = lane >> 5;
    const bf16_t* PROJT = (const bf16_t*)(p.ws + WS_PROJ);
    bf16_t* KH = (bf16_t*)lds;
    bf16_t* VT = (bf16_t*)(lds + 36864);
    float* SUMS = (float*)(lds + 55296);
    const int lt0 = c * 64;
    {
        const int d = tid >> 8, sh = (tid >> 7) & 1, k = tid & 127;
        const bf16_t* fp = PROJT + (size_t)(TF + d * 512 + h * 128 + k) * HT + lt0 + sh * 32;
        u32x4 raw[4];
#pragma unroll
        for (int j = 0; j < 4; ++j) raw[j] = *(const u32x4*)(fp + 8 * j);
        const float lb = ((const float*)(p.ws + WS_LB))[(l * 2 + d) * 512 + h * 128 + k];
        stage_vt(PROJT, lt0, h, VT, tid);
        float f[32], PA, PB; hgrn_gates(raw, lb, SUMS, d, sh, k, f, PA, PB);
        float val[32];
        if (d == 0) { float suf = sh ? 1.f : PB;
#pragma unroll
            for (int j = 31; j >= 0; --j) { val[j] = (1.f - f[j]) * suf; suf *= f[j]; } }
        else { float pre = sh ? PA : 1.f;
#pragma unroll
            for (int j = 0; j < 32; ++j) { val[j] = (1.f - f[j]) * pre; pre *= f[j]; } }
#pragma unroll
        for (int s8 = 0; s8 < 4; ++s8) *(u32x4*)(KH + (d * 128 + k) * 72 + sh * 32 + s8 * 8) = pack8(&val[s8 * 8]);
        if (sh == 0) { float* DEC = (float*)(p.ws + WS_DECA) + (size_t)((c * 4 + h) * 2 + d) * 256; DEC[k] = PA * PB; DEC[128 + k] = (d == 0) ? PA : PB; }
    }
    __syncthreads();
    {
        const int d = wave >> 2, vq = wave & 3;
        f32x16 acc[4];
#pragma unroll
        for (int i = 0; i < 4; ++i) acc[i] = zero16();
#pragma unroll
        for (int ks = 0; ks < 4; ++ks) { const bf16x8 b = *(const bf16x8*)(VT + (vq * 32 + l31) * 72 + ks * 16 + 8 * lh);
#pragma unroll
            for (int kb = 0; kb < 4; ++kb) { const bf16x8 a = *(const bf16x8*)(KH + (d * 128 + kb * 32 + l31) * 72 + ks * 16 + 8 * lh); acc[kb] = mfma32(a, b, acc[kb]); } }
        bf16_t* S = (bf16_t*)(p.ws + WS_SA) + (size_t)((c * 4 + h) * 2 + d) * 16384 + (size_t)(vq * 32 + l31) * 128;
#pragma unroll
        for (int kb = 0; kb < 4; ++kb)
#pragma unroll
            for (int g = 0; g < 4; ++g) { u32x2 w; w.x = pk2(acc[kb][4 * g], acc[kb][4 * g + 1]); w.y = pk2(acc[kb][4 * g + 2], acc[kb][4 * g + 3]);
                *(u32x2*)(S + kb * 32 + 8 * g + 4 * lh) = w; }
    }
    __syncthreads();
}

DI void ssd_dt(CParams& p, const bf16_t* PROJT, int l, int lt0, int head, int d, int lane, float& dt, float& a, float& ac, float& total) {
    const float raw = bf2f(PROJT[(size_t)(TDT + d * 16 + head) * HT + lt0 + lane]) + p.dt_bias[(l * 2 + d) * 16 + head];
    dt = raw > 20.f ? raw : log1pf(__expf(raw));
    a = -__expf(p.a_log[(l * 2 + d) * 16 + head]) * dt;
    ac = a;
#pragma unroll
    for (int o = 1; o < 64; o <<= 1) { const float t = __shfl_up(ac, o); if (lane >= o) ac += t; }
    total = __shfl(ac, 63);
}
constexpr int LDS_CW = 122880;
DI int cw_xcol(int g, int cl) { return cl < 256 ? g * 256 + cl : (cl < 320 ? 1024 + g * 64 + (cl - 256) : 1280 + g * 64 + (cl - 320)); }
DI void cw_fill(CParams& p, unsigned char* lds, int l, int g, int tid) {
    if (tid < 384) { const int xcol = cw_xcol(g, tid); f32x4 w; w[0] = p.conv_w[(l * 3 + 0) * 1536 + xcol]; w[1] = p.conv_w[(l * 3 + 1) * 1536 + xcol]; w[2] = p.conv_w[(l * 3 + 2) * 1536 + xcol]; w[3] = p.conv_b[l * 1536 + xcol];
        *(f32x4*)(lds + LDS_CW + tid * 16) = w; }
}
struct Conv8In { u32x4 cur; float xm, xn; };
DI Conv8In conv8_load(const bf16_t* PROJT, int lt0, int sg, int xcol, bool has_prev, bool has_next) {
    Conv8In r; const bf16_t* xp = PROJT + (size_t)(TX + xcol) * HT + lt0 + sg * 8;
    r.cur = *(const u32x4*)xp; r.xm = 0.f; r.xn = 0.f;
    if (sg == 0 && has_prev) r.xm = bf2f(xp[-1]);
    if (sg == 7 && has_next) r.xn = bf2f(xp[8]);
    return r;
}
DI void conv8_math(const Conv8In& r, int sg, const unsigned char* lds, int cl, float* y) {
    const unsigned pw = __shfl_up(r.cur.w, 1), nx = __shfl_down(r.cur.x, 1);
    const float xm = (sg == 0) ? r.xm : __uint_as_float(pw & 0xffff0000u);
    const float xn = (sg == 7) ? r.xn : __uint_as_float(nx << 16);
    const f32x4 w = *(const f32x4*)(lds + LDS_CW + cl * 16);
    float x[10]; x[0] = xm; unpack8(r.cur, &x[1]); x[9] = xn;
#pragma unroll
    for (int j = 0; j < 8; ++j) y[j] = silu(w[3] + w[0] * x[j] + w[1] * x[j + 1] + w[2] * x[j + 2]);
}

DI void scanA_ssd(CParams& p, unsigned char* lds, int l, int hf, int c, int g) {
    const int tid = get_tid(), lane = tid & 63, wave = __builtin_amdgcn_readfirstlane(tid >> 6), l31 = lane & 31, lh = lane >> 5;
    const bf16_t* PROJT = (const bf16_t*)(p.ws + WS_PROJ);
    bf16_t* XT = (bf16_t*)lds;
    bf16_t* BT = (bf16_t*)(lds + 36864);
    float* WS_ = (float*)(lds + 46080);
    const int lt0 = c * 64; bool hp, hn; chunk_halo(hf, c, hp, hn);
    Conv8In cin[5];
#pragma unroll
    for (int r = 0; r < 5; ++r) { const int it = tid + r * NTHR, cl = it >> 3, sg = it & 7; const int xcol = cl < 256 ? g * 256 + cl : 1024 + g * 64 + (cl - 256); cin[r] = conv8_load(PROJT, lt0, sg, xcol, hp, hn); }
    {
        const int hh = wave >> 1, d = wave & 1, head = g * 4 + hh; float dt, a, ac, total; ssd_dt(p, PROJT, l, lt0, head, d, lane, dt, a, ac, total);
        WS_[wave * 64 + lane] = ((d == 0) ? __expf(total - ac) : __expf(ac - a)) * dt;
        if (lane == 0) ((float*)(p.ws + WS_DECB))[(c * 16 + head) * 2 + d] = __expf(total);
    }
#pragma unroll
    for (int r = 0; r < 5; ++r) { const int it = tid + r * NTHR, cl = it >> 3, sg = it & 7; float y[8]; conv8_math(cin[r], sg, lds, cl, y);
        *(u32x4*)((cl < 256 ? XT + cl * 72 : BT + (cl - 256) * 72) + sg * 8) = pack8(y); }
    __syncthreads();
    {
        const int hh = wave >> 1, d = wave & 1, head = g * 4 + hh;
        f32x16 acc[2][2];
#pragma unroll
        for (int i = 0; i < 2; ++i)
#pragma unroll
            for (int j = 0; j < 2; ++j) acc[i][j] = zero16();
#pragma unroll
        for (int ks = 0; ks < 4; ++ks) { const f32x4 wa = *(const f32x4*)(WS_ + wave * 64 + ks * 16 + 8 * lh), wb = *(const f32x4*)(WS_ + wave * 64 + ks * 16 + 8 * lh + 4);
            bf16x8 bs[2];
#pragma unroll
            for (int ct = 0; ct < 2; ++ct) { const u32x4 r = *(const u32x4*)(XT + (hh * 64 + ct * 32 + l31) * 72 + ks * 16 + 8 * lh); u32x4 o;
                o.x = pk2(__uint_as_float(r.x << 16) * wa[0], __uint_as_float(r.x & 0xffff0000u) * wa[1]); o.y = pk2(__uint_as_float(r.y << 16) * wa[2], __uint_as_float(r.y & 0xffff0000u) * wa[3]);
                o.z = pk2(__uint_as_float(r.z << 16) * wb[0], __uint_as_float(r.z & 0xffff0000u) * wb[1]); o.w = pk2(__uint_as_float(r.w << 16) * wb[2], __uint_as_float(r.w & 0xffff0000u) * wb[3]);
                bs[ct] = __builtin_bit_cast(bf16x8, o); }
#pragma unroll
            for (int rt = 0; rt < 2; ++rt) { const bf16x8 a = *(const bf16x8*)(BT + (rt * 32 + l31) * 72 + ks * 16 + 8 * lh);
#pragma unroll
                for (int ct = 0; ct < 2; ++ct) acc[rt][ct] = mfma32(a, bs[ct], acc[rt][ct]); } }
        bf16_t* S = (bf16_t*)(p.ws + WS_SB) + (size_t)((c * 16 + head) * 2 + d) * 4096;
#pragma unroll
        for (int rt = 0; rt < 2; ++rt)
#pragma unroll
            for (int ct = 0; ct < 2; ++ct)
#pragma unroll
                for (int q = 0; q < 4; ++q) { u32x2 w; w.x = pk2(acc[rt][ct][4 * q], acc[rt][ct][4 * q + 1]); w.y = pk2(acc[rt][ct][4 * q + 2], acc[rt][ct][4 * q + 3]);
                    *(u32x2*)(S + (ct * 32 + l31) * 64 + rt * 32 + 8 * q + 4 * lh) = w; }
    }
    __syncthreads();
}
DI void phase_scanA(CParams& p, unsigned char* lds, int l, int hf, int bid, int nb, int rmode = 0) {
    int cwg = -1; const int tid0 = get_tid();
    for (int it = bid; it < 2 * NCH * 4; it += nb) { if (rmode == 1 && it < NCH * 4) continue; if (rmode == 2 && it >= NCH * 4) continue; if (it < NCH * 4) scanA_hgrn(p, lds, l, hf, it >> 2, it & 3);
        else { const int j = it - NCH * 4, g = j & 3; if (g != cwg) { __syncthreads(); cw_fill(p, lds, l, g, tid0); __syncthreads(); cwg = g; } scanA_ssd(p, lds, l, hf, j >> 2, g); } }
}

template <int NBAT> DI void scanB_hgrn_run(bf16_t* SA, const float* DECA, const SeqInfo& si, int h, int d, int v, int k4, float (&S)[4]) {
    for (int i0 = 0; i0 < si.nch; i0 += NBAT) { u32x2 raw[NBAT]; f32x4 dec[NBAT], em[NBAT]; bf16_t* sp[NBAT];
#pragma unroll
        for (int j = 0; j < NBAT; ++j) { const int i = i0 + j; const int c = si.first + (d == 0 ? i : si.nch - 1 - i); const size_t base = (size_t)((c * 4 + h) * 2 + d);
            sp[j] = SA + base * 16384 + v * 128 + k4; raw[j] = *(const u32x2*)sp[j]; dec[j] = *(const f32x4*)(DECA + base * 256 + k4); em[j] = *(const f32x4*)(DECA + base * 256 + 128 + k4); }
#pragma unroll
        for (int j = 0; j < NBAT; ++j) { u32x2 w; w.x = pk2(S[0] * em[j][0], S[1] * em[j][1]); w.y = pk2(S[2] * em[j][2], S[3] * em[j][3]); *(u32x2*)sp[j] = w;
            S[0] = dec[j][0] * S[0] + __uint_as_float(raw[j].x << 16); S[1] = dec[j][1] * S[1] + __uint_as_float(raw[j].x & 0xffff0000u);
            S[2] = dec[j][2] * S[2] + __uint_as_float(raw[j].y << 16); S[3] = dec[j][3] * S[3] + __uint_as_float(raw[j].y & 0xffff0000u); } }
}
template <int NBAT> DI void scanB_ssd_run(bf16_t* SB, const float* DECB, const SeqInfo& si, int head, int d, int pp, int n4, f32x4& S) {
    for (int i0 = 0; i0 < si.nch; i0 += NBAT) { u32x2 raw[NBAT]; float dec[NBAT]; bf16_t* sp[NBAT];
#pragma unroll
        for (int j = 0; j < NBAT; ++j) { const int i = i0 + j; const int c = si.first + (d == 0 ? i : si.nch - 1 - i); const size_t base = (size_t)((c * 16 + head) * 2 + d);
            sp[j] = SB + base * 4096 + pp * 64 + n4; raw[j] = *(const u32x2*)sp[j]; dec[j] = DECB[base]; }
#pragma unroll
        for (int j = 0; j < NBAT; ++j) { u32x2 w; w.x = pk2(S[0], S[1]); w.y = pk2(S[2], S[3]); *(u32x2*)sp[j] = w;
            S[0] = dec[j] * S[0] + __uint_as_float(raw[j].x << 16); S[1] = dec[j] * S[1] + __uint_as_float(raw[j].x & 0xffff0000u);
            S[2] = dec[j] * S[2] + __uint_as_float(raw[j].y << 16); S[3] = dec[j] * S[3] + __uint_as_float(raw[j].y & 0xffff0000u); } }
}
DI void phase_scanB(CParams& p, int l, int hf, int bid, int nb) {
    const int nseq = hf == 0 ? 33 : 3; const int total = nseq << 15;
    const int gt = bid * NTHR + get_tid(), gs = nb * NTHR;
    bf16_t* SA = (bf16_t*)(p.ws + WS_SA); const float* DECA = (const float*)(p.ws + WS_DECA);
    for (int it = gt; it < total; it += gs) {
        const int q = it & 4095, combo = (it >> 12) & 7, sq = it >> 15; const int h = combo >> 1, d = combo & 1; const int v = q >> 5, k4 = (q & 31) * 4;
        const SeqInfo si = seq_of(hf, sq);
        const float fz_ = __uint_as_float((unsigned)(gt >> 31)); float S[4] = {fz_, fz_, fz_, fz_};
        const size_t sidx = ((size_t)(((si.batch * 4 + l) * 2 + d) * 4 + h) * 128 + k4) * 128 + v;
        if (si.latent) {
#pragma unroll
            for (int j = 0; j < 4; ++j) S[j] = p.state_hgrn[sidx + (size_t)j * 128];
            scanB_hgrn_run<8>(SA, DECA, si, h, d, v, k4, S);
        } else {
            scanB_hgrn_run<4>(SA, DECA, si, h, d, v, k4, S);
#pragma unroll
            for (int j = 0; j < 4; ++j) p.out[OUT_SH + sidx + (size_t)j * 128] = S[j]; }
    }
    bf16_t* SB = (bf16_t*)(p.ws + WS_SB); const float* DECB = (const float*)(p.ws + WS_DECB);
    for (int it = gt; it < total; it += gs) {
        const int q = it & 1023, combo = (it >> 10) & 31, sq = it >> 15; const int head = combo >> 1, d = combo & 1; const int pp = q >> 4, n4 = (q & 15) * 4;
        const SeqInfo si = seq_of(hf, sq);
        const float fz_ = __uint_as_float((unsigned)(gt >> 31)); f32x4 S = {fz_, fz_, fz_, fz_};
        const size_t sidx = ((size_t)(((si.batch * 4 + l) * 2 + d) * 16 + head) * 64 + pp) * 64 + n4;
        if (si.latent) { S = *(const f32x4*)(p.state_ssd + sidx); scanB_ssd_run<8>(SB, DECB, si, head, d, pp, n4, S); }
        else { scanB_ssd_run<4>(SB, DECB, si, head, d, pp, n4, S); *(f32x4*)(p.out + OUT_SS + sidx) = S; }
    }
}

DI void scanC_hgrn(CParams& p, unsigned char* lds, int l, int hf, int c, int h) {
    const int tid = get_tid(), lane = tid & 63, wave = __builtin_amdgcn_readfirstlane(tid >> 6), l31 = lane & 31, lh = lane >> 5;
    const bf16_t* PROJT = (const bf16_t*)(p.ws + WS_PROJ);
    const bf16_t* PROJG = (const bf16_t*)(p.ws + WS_PROJG);
    bf16_t* QT = (bf16_t*)lds;
    bf16_t* KT = (bf16_t*)(lds + 34816);
    bf16_t* VT = (bf16_t*)(lds + 69632);
    bf16_t* PP = (bf16_t*)(lds + 88064);
    float* OO = (float*)(lds + 34816);
    float* SUMS = (float*)(lds + 106496);
    const int lt0 = c * 64;
    const int th = wave & 1, vq = wave >> 1;
    bf16x8 sfr[2][8];
    const int nt = tid >> 3, npart = tid & 7, nch0 = h * 128 + npart * 16;
    const bf16_t* gp = PROJG + (size_t)(lt0 + nt) * NG + G_GA + nch0; const u32x4 g0 = *(const u32x4*)gp, g1 = *(const u32x4*)(gp + 8);
    {
        const int d = tid >> 8, sh = (tid >> 7) & 1, k = tid & 127;
        const bf16_t* fp = PROJT + (size_t)(TF + d * 512 + h * 128 + k) * HT + lt0 + sh * 32;
        const bf16_t* qp = PROJT + (size_t)(TQ + h * 128 + k) * HT + lt0 + sh * 32;
        u32x4 raw[4], qraw[4];
#pragma unroll
        for (int j = 0; j < 4; ++j) { raw[j] = *(const u32x4*)(fp + 8 * j); qraw[j] = *(const u32x4*)(qp + 8 * j); }
        const float lb = ((const float*)(p.ws + WS_LB))[(l * 2 + d) * 512 + h * 128 + k];
        stage_vt(PROJT, lt0, h, VT, tid);
        float f[32], PA, PB; hgrn_gates(raw, lb, SUMS, d, sh, k, f, PA, PB);
        {
            const bf16_t* SA = (const bf16_t*)(p.ws + WS_SA);
#pragma unroll
            for (int dd = 0; dd < 2; ++dd)
#pragma unroll
                for (int ks = 0; ks < 8; ++ks) sfr[dd][ks] = *(const bf16x8*)(SA + (size_t)((c * 4 + h) * 2 + dd) * 16384 + (size_t)(vq * 32 + l31) * 128 + ks * 16 + 8 * lh);
        }
        float qv[32];
#pragma unroll
        for (int j8 = 0; j8 < 4; ++j8) unpack8(qraw[j8], &qv[8 * j8]);
        const float BIG = 5.5e34f;
        bf16_t* qd = QT + (d * 64 + sh * 32) * 136 + k; bf16_t* kd = KT + (d * 64 + sh * 32) * 136 + k;
        if (d == 0) {
            if (sh == 0) { float R = 1.f;
#pragma unroll
                for (int j = 31; j >= 0; --j) { qd[j * 136] = (bf16_t)f2bf(qv[j] * fminf(__builtin_amdgcn_rcpf(R), BIG)); kd[j * 136] = (bf16_t)f2bf((1.f - f[j]) * R); R *= f[j]; } }
            else { float P = 1.f;
#pragma unroll
                for (int j = 0; j < 32; ++j) { P *= f[j]; qd[j * 136] = (bf16_t)f2bf(qv[j] * P); kd[j * 136] = (bf16_t)f2bf((1.f - f[j]) * fminf(__builtin_amdgcn_rcpf(P), BIG)); } }
        } else {
            if (sh == 0) { float E = 1.f;
#pragma unroll
                for (int j = 31; j >= 0; --j) { E *= f[j]; qd[j * 136] = (bf16_t)f2bf(qv[j] * E); kd[j * 136] = (bf16_t)f2bf((1.f - f[j]) * fminf(__builtin_amdgcn_rcpf(E), BIG)); } }
            else { float G = 1.f;
#pragma unroll
                for (int j = 0; j < 32; ++j) { qd[j * 136] = (bf16_t)f2bf(qv[j] * fminf(__builtin_amdgcn_rcpf(G), BIG)); kd[j * 136] = (bf16_t)f2bf((1.f - f[j]) * G); G *= f[j]; } }
        }
    }
    __syncthreads();
    {
        const int d = wave >> 2, tr = (wave >> 1) & 1, tc = wave & 1; f32x16 acc = zero16();
#pragma unroll
        for (int ks = 0; ks < 8; ++ks) { const bf16x8 a = *(const bf16x8*)(QT + (d * 64 + tr * 32 + l31) * 136 + ks * 16 + 8 * lh), b = *(const bf16x8*)(KT + (d * 64 + tc * 32 + l31) * 136 + ks * 16 + 8 * lh); acc = mfma32(a, b, acc); }
        const int s = tc * 32 + l31;
#pragma unroll
        for (int i = 0; i < 16; ++i) { const int t = tr * 32 + 8 * (i >> 2) + 4 * lh + (i & 3); const bool keep = (d == 0) ? (t >= s) : (t <= s); PP[(d * 64 + t) * 72 + s] = (bf16_t)f2bf(keep ? acc[i] : 0.f); }
    }
    __syncthreads();
    {
        f32x16 acc = zero16();
#pragma unroll
        for (int d = 0; d < 2; ++d) {
#pragma unroll
            for (int ks = 0; ks < 4; ++ks) { const bf16x8 a = *(const bf16x8*)(PP + (d * 64 + th * 32 + l31) * 72 + ks * 16 + 8 * lh), b = *(const bf16x8*)(VT + (vq * 32 + l31) * 72 + ks * 16 + 8 * lh); acc = mfma32(a, b, acc); }
#pragma unroll
            for (int ks = 0; ks < 8; ++ks) { const bf16x8 a = *(const bf16x8*)(QT + (d * 64 + th * 32 + l31) * 136 + ks * 16 + 8 * lh); acc = mfma32(a, sfr[d][ks], acc); }
        }
#pragma unroll
        for (int i = 0; i < 16; ++i) { const int t = th * 32 + 8 * (i >> 2) + 4 * lh + (i & 3); OO[t * 132 + vq * 32 + l31] = acc[i]; }
    }
    __syncthreads();
    {
        const float* orow = OO + nt * 132 + npart * 16; float x[16]; float ss = 0.f;
#pragma unroll
        for (int j = 0; j < 4; ++j) { const f32x4 v4 = *(const f32x4*)(orow + 4 * j); x[4 * j] = v4[0]; x[4 * j + 1] = v4[1]; x[4 * j + 2] = v4[2]; x[4 * j + 3] = v4[3]; ss += (v4[0] * v4[0] + v4[1] * v4[1]) + (v4[2] * v4[2] + v4[3] * v4[3]); }
        ss += __shfl_xor(ss, 1); ss += __shfl_xor(ss, 2); ss += __shfl_xor(ss, 4);
        const float rstd = __builtin_amdgcn_rsqf(ss * (1.f / 128.f) + EPSN);
        const float* gn = p.a_norm + l * 512 + nch0;
        unsigned o[8];
#pragma unroll
        for (int q = 0; q < 8; ++q) { const unsigned gw = q < 4 ? g0[q & 3] : g1[q & 3];
            const float y0 = x[2 * q] * rstd * gn[2 * q] * __uint_as_float(gw << 16), y1 = x[2 * q + 1] * rstd * gn[2 * q + 1] * __uint_as_float(gw & 0xffff0000u); o[q] = pk2(y0, y1); }
        bf16_t* op = (bf16_t*)(p.ws + WS_OA) + (size_t)(lt0 + nt) * 1536 + nch0;
        *(u32x4*)op = (u32x4){o[0], o[1], o[2], o[3]}; *(u32x4*)(op + 8) = (u32x4){o[4], o[5], o[6], o[7]};
    }
    __syncthreads();
}

DI void scanC_ssd(CParams& p, unsigned char* lds, int l, int hf, int c, int g, int rmode = 0) {
    const int tid = get_tid(), lane = tid & 63, wave = __builtin_amdgcn_readfirstlane(tid >> 6), l31 = lane & 31, lh = lane >> 5;
    const bf16_t* PROJT = (const bf16_t*)(p.ws + WS_PROJ);
    const bf16_t* PROJG = (const bf16_t*)(p.ws + WS_PROJG);
    bf16_t* XT = (bf16_t*)lds;
    bf16_t* BM = (bf16_t*)(lds + 36864);
    bf16_t* CM = (bf16_t*)(lds + 46080);
    float* CB = (float*)(lds + 55296);
    float* ACUM = (float*)(lds + 72704);
    float* DTS = (float*)(lds + 74752);
    float* SSQ = (float*)(lds + 76800);
    float* EAC = (float*)(lds + 77824);
    const int lt0 = c * 64; bool hp, hn; chunk_halo(hf, c, hp, hn);
    const int hh = wave >> 1, th = wave & 1, head = g * 4 + hh;
    bf16x8 sfr[2][4];
    const bf16_t* SBp = (const bf16_t*)(p.ws + WS_SB) + (size_t)((c * 16 + head) * 2) * 4096 + l31 * 64 + 8 * lh;
#pragma unroll
    for (int ct = 0; ct < 2; ++ct)
#pragma unroll
        for (int ks = 0; ks < 4; ++ks) sfr[ct][ks] = *(const bf16x8*)(SBp + ct * 2048 + ks * 16);
    const int zt = tid >> 3, zpart = tid & 7;
    u32x4 zreg[4];
#pragma unroll
    for (int j = 0; j < 4; ++j) zreg[j] = *(const u32x4*)(PROJG + (size_t)(lt0 + zt) * NG + G_Z + g * 256 + zpart * 32 + 8 * j);
    bf16_t* ZT = (bf16_t*)(lds + 36864);
    bf16_t* YT = (bf16_t*)lds;
    Conv8In cin[6];
#ifdef PROBE_SSD
    if (rmode != 5)
#endif
    {
#pragma unroll
    for (int r = 0; r < 4; ++r) { const int it = tid + r * NTHR, cl = it >> 3, sg = it & 7; cin[r] = conv8_load(PROJT, lt0, sg, g * 256 + cl, hp, hn); }
#pragma unroll
    for (int r = 0; r < 2; ++r) { const int it = tid + r * NTHR, nn = it >> 3, sg = it & 7; const int isC = nn >> 6, n = nn & 63; cin[4 + r] = conv8_load(PROJT, lt0, sg, 1024 + isC * 256 + g * 64 + n, hp, hn); }
    }
    {
        const int d = wave & 1; float dt, a, ac, total; ssd_dt(p, PROJT, l, lt0, head, d, lane, dt, a, ac, total);
        const float av = (d == 0) ? ac : (total - ac + a); ACUM[wave * 64 + lane] = av; DTS[wave * 64 + lane] = dt; EAC[wave * 64 + lane] = __expf(av);
    }
#ifdef PROBE_SSD
    if (rmode != 5)
#endif
    {
#pragma unroll
    for (int r = 0; r < 4; ++r) { const int it = tid + r * NTHR, cl = it >> 3, sg = it & 7; float y[8]; conv8_math(cin[r], sg, lds, cl, y); *(u32x4*)(XT + cl * 72 + sg * 8) = pack8(y); }
#pragma unroll
    for (int r = 0; r < 2; ++r) { const int it = tid + r * NTHR, nn = it >> 3, sg = it & 7; const int isC = nn >> 6, n = nn & 63; float y[8]; conv8_math(cin[4 + r], sg, lds, 256 + nn, y);
        bf16_t* dst = (isC ? CM : BM) + (sg * 8) * 72 + n;
#pragma unroll
        for (int j = 0; j < 8; ++j) dst[j * 72] = (bf16_t)f2bf(y[j]); }
    }
    __syncthreads();
    if (wave < 4) { const int tr = wave >> 1, tc = wave & 1; f32x16 acc = zero16();
#pragma unroll
        for (int ks = 0; ks < 4; ++ks) { const bf16x8 a = *(const bf16x8*)(CM + (tr * 32 + l31) * 72 + ks * 16 + 8 * lh), b = *(const bf16x8*)(BM + (tc * 32 + l31) * 72 + ks * 16 + 8 * lh); acc = mfma32(a, b, acc); }
#pragma unroll
        for (int i = 0; i < 16; ++i) { const int t = tr * 32 + 8 * (i >> 2) + 4 * lh + (i & 3); CB[t * 68 + tc * 32 + l31] = acc[i]; }
    }
    __syncthreads();
    f32x16 acc[2]; acc[0] = zero16(); acc[1] = zero16();
    {
        const int t = th * 32 + l31;
#pragma unroll 1
        for (int d = 0; d < 2; ++d) { const int combo = hh * 2 + d;
#ifdef PROBE_SSD
            if (rmode == 4) break;
#endif
            bf16x8 nxt[2][4];
            if (d == 0) {
#pragma unroll
            for (int ct = 0; ct < 2; ++ct)
#pragma unroll
                for (int ks = 0; ks < 4; ++ks) nxt[ct][ks] = *(const bf16x8*)(SBp + 4096 + ct * 2048 + ks * 16);
            }
            const float at = ACUM[combo * 64 + t];
#pragma unroll
            for (int ks = 0; ks < 4; ++ks) { if ((d == 0 && th == 0 && ks >= 2) || (d == 1 && th == 1 && ks < 2)) continue;
                const int s0 = ks * 16 + 8 * lh; float m[8];
                const f32x4 c0 = *(const f32x4*)(CB + t * 68 + s0), c1 = *(const f32x4*)(CB + t * 68 + s0 + 4);
                const f32x4 a0 = *(const f32x4*)(ACUM + combo * 64 + s0), a1 = *(const f32x4*)(ACUM + combo * 64 + s0 + 4);
                const f32x4 d0 = *(const f32x4*)(DTS + combo * 64 + s0), d1 = *(const f32x4*)(DTS + combo * 64 + s0 + 4);
#pragma unroll
                for (int j = 0; j < 8; ++j) { const int s = s0 + j; const bool keep = (d == 0) ? (t >= s) : (t <= s); const float cbv = j < 4 ? c0[j & 3] : c1[j & 3], as = j < 4 ? a0[j & 3] : a1[j & 3], ds = j < 4 ? d0[j & 3] : d1[j & 3];
                    m[j] = keep ? cbv * __expf(fminf(at - as, 0.f)) * ds : 0.f; }
                u32x4 o; o.x = pk2(m[0], m[1]); o.y = pk2(m[2], m[3]); o.z = pk2(m[4], m[5]); o.w = pk2(m[6], m[7]); const bf16x8 a = __builtin_bit_cast(bf16x8, o);
#pragma unroll
                for (int ct = 0; ct < 2; ++ct) { const bf16x8 b = *(const bf16x8*)(XT + (hh * 64 + ct * 32 + l31) * 72 + s0); acc[ct] = mfma32(a, b, acc[ct]); } }
            f32x16 acc2[2]; acc2[0] = zero16(); acc2[1] = zero16();
#pragma unroll
            for (int ks = 0; ks < 4; ++ks) { const bf16x8 a = *(const bf16x8*)(CM + (th * 32 + l31) * 72 + ks * 16 + 8 * lh);
#pragma unroll
                for (int ct = 0; ct < 2; ++ct) acc2[ct] = mfma32(a, sfr[ct][ks], acc2[ct]); }
#pragma unroll
            for (int i = 0; i < 16; ++i) { const int ti = th * 32 + 8 * (i >> 2) + 4 * lh + (i & 3); const float sc = EAC[combo * 64 + ti]; acc[0][i] += sc * acc2[0][i]; acc[1][i] += sc * acc2[1][i]; }
#pragma unroll
            for (int ct = 0; ct < 2; ++ct)
#pragma unroll
                for (int ks = 0; ks < 4; ++ks) sfr[ct][ks] = nxt[ct][ks];
        }
    }
    __syncthreads();
#pragma unroll
    for (int j = 0; j < 4; ++j) *(u32x4*)(ZT + zt * 264 + zpart * 32 + 8 * j) = zreg[j];
    __syncthreads();
    {
        const float dsk = p.d_skip[l * 16 + head];
#pragma unroll
        for (int i = 0; i < 16; ++i) { const int ti = th * 32 + 8 * (i >> 2) + 4 * lh + (i & 3); float part = 0.f;
#pragma unroll
            for (int ct = 0; ct < 2; ++ct) { const int pc = ct * 32 + l31; const float xv = bf2f(XT[(hh * 64 + pc) * 72 + ti]); const float z = bf2f(ZT[ti * 264 + hh * 64 + pc]);
                const float y = (acc[ct][i] + dsk * xv) * z;   acc[ct][i] = y; part += y * y; }
            part += __shfl_xor(part, 1); part += __shfl_xor(part, 2); part += __shfl_xor(part, 4); part += __shfl_xor(part, 8); part += __shfl_xor(part, 16);
            if (l31 == 0) SSQ[hh * 64 + ti] = part; }
    }
    __syncthreads();
    {
#pragma unroll
        for (int i = 0; i < 16; ++i) { const int ti = th * 32 + 8 * (i >> 2) + 4 * lh + (i & 3); const float ss = (SSQ[ti] + SSQ[64 + ti]) + (SSQ[128 + ti] + SSQ[192 + ti]); const float rstd = __builtin_amdgcn_rsqf(ss * (1.f / 256.f) + EPSN);
#pragma unroll
            for (int ct = 0; ct < 2; ++ct) { const int chl = hh * 64 + ct * 32 + l31; YT[ti * 264 + chl] = (bf16_t)f2bf(acc[ct][i] * rstd * p.b_norm[l * 1024 + g * 256 + chl]); } }
    }
    __syncthreads();
    {
        bf16_t* YB = (bf16_t*)(p.ws + WS_OA) + (size_t)(lt0 + zt) * 1536 + 512 + g * 256 + zpart * 32;
#pragma unroll
        for (int j = 0; j < 4; ++j) {
#ifdef PROBE_SSD
            if (rmode >= 3) break;
#endif
            *(u32x4*)(YB + 8 * j) = *(const u32x4*)(YT + zt * 264 + zpart * 32 + 8 * j); }
    }
    __syncthreads();
}
DI void phase_scanC(CParams& p, unsigned char* lds, int l, int hf, int bid, int nb, int rmode = 0) {
    int cwg = -1; const int tid0 = get_tid();
    for (int it = bid; it < 2 * NCH * 4; it += nb) {
        if ((rmode == 1 || rmode >= 3) && it < NCH * 4) continue; if (rmode == 2 && it >= NCH * 4) continue;
#ifndef NO_C_HGRN
        if (it < NCH * 4) scanC_hgrn(p, lds, l, hf, it >> 2, it & 3);
#endif
#ifndef NO_C_SSD
        if (it >= NCH * 4) { const int j = it - NCH * 4, g = j & 3; if (g != cwg) { __syncthreads(); cw_fill(p, lds, l, g, tid0); __syncthreads(); cwg = g; } scanC_ssd(p, lds, l, hf, j >> 2, g, rmode); }
#endif
    }
}

template <class Epi> DI void run_gemm(unsigned char* lds, const bf16_t* A, const bf16_t* Bt, int M, int N, int K, const Epi& E, int bid, int nb) {
    asm volatile("" : "+s"(N), "+s"(K), "+s"(M));
    pg8::Gemm g{A, Bt, M, N, K}; pg8::StaticOrder S; S.init(M, N, nb, bid);
    pg8::gemm_phase<Epi, pg8::StaticOrder, false>((PG8_LAS unsigned char*)lds, g, S, E, nullptr);
    __syncthreads();
}

DI void run_phase(CParams& p, unsigned char* lds, int ph, int bid, int nb, int rmode = 0) {
    unsigned char* ws = p.ws;
    if (ph == 0) { phase_init(p, lds, bid, nb); __syncthreads(); phase_wconv(p, lds, 0, bid, nb, 0, WC_NIT); return; }
    if (ph == 89) { phase_final_norm(p, bid, nb); return; }
    const int q = ph - 1; const int lh2 = q / 11, sub = q % 11; const int l = lh2 >> 1, hf = lh2 & 1;
    const float* MODL = (const float*)(ws + WS_MOD) + (size_t)l * 5 * 6144;
    const unsigned char* wl = ws + ((l & 1) ? WS_W2OFS : 0);
#ifndef PH_MASK
#define PH_MASK 0xFFFF
#endif
#define PH_ON(i) ((PH_MASK >> (i)) & 1)
    switch (sub) {
    case 0: if (PH_ON(0)) { if (hf == 0 && l == 0) phase_norm(p, 0, 0, 0, bid, nb); } break;
    case 1: if (PH_ON(1)) { pg8::EpiBf16Act E1{(bf16_t*)(ws + WS_PROJ), HT, 2, 0, 9999}; run_gemm(lds, (const bf16_t*)(wl + WS_WIN), (const bf16_t*)(ws + WS_U), NTROW, HT, 1024, E1, bid, nb);
              pg8::EpiBf16Act E2{(bf16_t*)(ws + WS_PROJG), NG, 0, 6, 6}; run_gemm(lds, (const bf16_t*)(ws + WS_U), (const bf16_t*)(wl + WS_WIN) + (size_t)NTROW * 1024, HT, NG, 1024, E2, bid, nb); } break;
    case 2: if (PH_ON(2)) phase_scanA(p, lds, l, hf, bid, nb, rmode); break;
    case 3: if (PH_ON(3)) phase_scanB(p, l, hf, bid, nb); break;
    case 4: if (PH_ON(4)) phase_scanC(p, lds, l, hf, bid, nb, rmode); break;
    case 5: if (PH_ON(5)) { wconv_side(p, lds, l, hf, bid, nb, 0, 3700); pg8::EpiGateMerge E{(bf16_t*)(ws + WS_U), (const bf16_t*)(ws + WS_PROJG), NG, G_GATE, G_GATE + 1024};
              run_gemm(lds, (const bf16_t*)(ws + WS_OA), (const bf16_t*)(wl + WS_WBRA), HT, 1024, 1536, E, bid, nb); } break;
    case 6: if (PH_ON(6)) { wconv_side(p, lds, l, hf, bid, nb, 3700, 5400); pg8::EpiResid E{p.out, MODL + 2048, hf * HT, l == 0 ? p.x_prompt : nullptr, l == 0 ? p.x_sample : nullptr}; run_gemm(lds, (const bf16_t*)(ws + WS_U), (const bf16_t*)(wl + WS_WOUT), HT, 1024, 1024, E, bid, nb); } break;
    case 7: if (PH_ON(7)) phase_norm(p, l, hf, 1, bid, nb); break;
    case 8: if (PH_ON(8)) { pg8::EpiBf16<0> E{(bf16_t*)(ws + WS_PROJ), NUP, nullptr, 0, 0}; run_gemm(lds, (const bf16_t*)(ws + WS_U), (const bf16_t*)(wl + WS_WUP), HT, NUP, 1024, E, bid, nb); } break;
    case 9: if (PH_ON(9)) phase_convact(p, l, hf, bid, nb); break;
    case 10: if (PH_ON(10)) { wconv_side(p, lds, l, hf, bid, nb, 5400, WC_NIT); pg8::EpiResid E{p.out, MODL + 5120, hf * HT, nullptr, nullptr}; run_gemm(lds, (const bf16_t*)(ws + WS_SA), (const bf16_t*)(wl + WS_WDN), HT, 1024, DFF, E, bid, nb);
               if (lh2 < 7) phase_norm(p, (lh2 + 1) >> 1, (lh2 + 1) & 1, 0, bid, nb); } break;
    }
}
constexpr int NPHASE = 90;

#define LAS __attribute__((address_space(3)))
#define XB_TMO      128
#define XB_XCNT(j)  (256  + 64 * (j))
#define XB_XSUB(j)  (1280 + 64 * (j))
#define XB_XGEN(j)  (2304 + 64 * (j))
#define XB_TOP      3328
#define XB_TOPGEN   3392
#define XCD_BAR_WORDS 3456
#define XB_SPIN_CAP (1u << 18)

__device__ __forceinline__ unsigned xb_ld(unsigned* p)              { return __hip_atomic_load(p, __ATOMIC_RELAXED, __HIP_MEMORY_SCOPE_AGENT); }
__device__ __forceinline__ unsigned xb_add(unsigned* p, unsigned v) { return __hip_atomic_fetch_add(p, v, __ATOMIC_RELAXED, __HIP_MEMORY_SCOPE_AGENT); }
__device__ __forceinline__ unsigned xb_xcc_id() { return (unsigned)__builtin_amdgcn_s_getreg((3 << 11) | 20) & 0xFu; }
#define XB_SPIN(cond, bar) do { unsigned _sp = 0; while (cond) { __builtin_amdgcn_s_sleep(1); \
    if ((++_sp & 255u) == 0u) { if (xb_ld(&(bar)[XB_TMO])) break; if (_sp > XB_SPIN_CAP) { atomicAdd(&(bar)[XB_TMO], 1u); break; } } } } while (0)

struct XcdBarrier {
    unsigned* bar; unsigned x;
    volatile LAS unsigned* st;
};

__device__ __forceinline__ XcdBarrier xcd_barrier_post(unsigned* bar, volatile LAS unsigned* st) {
    XcdBarrier b; b.bar = bar; b.x = xb_xcc_id(); b.st = st;
    if (threadIdx.x == 0) (void)xb_add(&bar[XB_XCNT(b.x)], 1u);
    return b;
}
__device__ __forceinline__ void xcd_barrier_complete(unsigned* bar, unsigned x, unsigned& nloc, unsigned& nx) {
    const unsigned G = gridDim.x * gridDim.y * gridDim.z;
    unsigned sum, cnt, mine, sp = 0u;
    for (;;) {
        sum = 0u; cnt = 0u; mine = 0u;
#pragma unroll
        for (unsigned j = 0; j < 16; ++j) { const unsigned c = xb_ld(&bar[XB_XCNT(j)]); sum += c; cnt += (c > 0u) ? 1u : 0u; mine = (j == x) ? c : mine; }
        if (sum == G) break;
        __builtin_amdgcn_s_sleep(1);
        if ((++sp & 255u) == 0u) { if (xb_ld(&bar[XB_TMO])) break; if (sp > XB_SPIN_CAP) { atomicAdd(&bar[XB_TMO], 1u); break; } }
    }
    nloc = mine > 0u ? mine : 1u; nx = cnt > 0u ? cnt : 1u;
}

__device__ __forceinline__ void xcd_barrier(const XcdBarrier& b) {
    asm volatile("s_waitcnt vmcnt(0)" ::: "memory");
    __syncthreads();
    if (threadIdx.x == 0) {
        unsigned* bar = b.bar;
        __builtin_amdgcn_s_waitcnt(0);
        unsigned nloc = b.st[0], nx = b.st[1];
        if (nloc == 0u) { xcd_barrier_complete(bar, b.x, nloc, nx); b.st[0] = nloc; b.st[1] = nx; }
        const unsigned old = xb_add(&bar[XB_XSUB(b.x)], 1u);
        const unsigned gen = old / nloc;
        if (old + 1u == (gen + 1u) * nloc) {
            __builtin_amdgcn_fence(__ATOMIC_RELEASE, "agent");
            asm volatile("s_waitcnt vmcnt(0)" ::: "memory");
            const unsigned og = xb_add(&bar[XB_TOP], 1u);
            const unsigned tg = og / nx;
            if (og + 1u == (tg + 1u) * nx) xb_add(&bar[XB_TOPGEN], 1u);
            else XB_SPIN(xb_ld(&bar[XB_TOPGEN]) == tg, bar);
            __builtin_amdgcn_fence(__ATOMIC_ACQUIRE, "agent");
            xb_add(&bar[XB_XGEN(b.x)], 1u);
            asm volatile("s_waitcnt vmcnt(0)" ::: "memory");
        } else {
            XB_SPIN(xb_ld(&bar[XB_XGEN(b.x)]) == gen, bar);
            __builtin_amdgcn_fence(__ATOMIC_ACQUIRE, "agent");
            asm volatile("s_waitcnt vmcnt(0)" ::: "memory");
        }
    }
    __syncthreads();
}

constexpr size_t WS_BAR = 3 * MiB + 512 * 1024;
__global__ void __launch_bounds__(512, 2) mega_fwd(Params p_unused) {
    extern __shared__ __attribute__((aligned(16))) unsigned char lds[];
    const int bid = blockIdx.x, nb = gridDim.x;
    CParams* pk = (CParams*)__builtin_amdgcn_kernarg_segment_ptr();
    volatile LAS unsigned* st = (volatile LAS unsigned*)((LAS unsigned char*)lds + 131072);
    if (threadIdx.x == 0) { st[0] = 0u; st[1] = 0u; }
    __syncthreads();
    unsigned* barw = (unsigned*)(pk->ws + WS_BAR);
    if (bid == 0) { for (int i = threadIdx.x; i < XCD_BAR_WORDS; i += NTHR) barw[i] = 0u; }
    {
        CParams* q = pk; asm volatile("" : "+s"(q));
        run_phase(*q, lds, 0, bid, nb);
    }
    cg::this_grid().sync();
    (void)xcd_barrier_post(barw, st);
    for (int ph = 1; ph < NPHASE; ++ph) {
        if (ph > 1 && ph < 89 && (ph - 1) % 11 == 0) continue;
        CParams* q = pk; int z_ = 0, b_ = bid, n_ = nb; asm volatile("" : "+s"(q), "+s"(z_), "+s"(b_), "+s"(n_));
        run_phase(*q, lds + z_, ph, b_, n_);
#ifndef RPT_MODE
#define RPT_MODE 0
#endif
#ifdef RPT_MASK
        if (ph < 89 && ((RPT_MASK >> ((ph - 1) % 11)) & 1)) { { XcdBarrier xb; xb.bar = (unsigned*)(q->ws + WS_BAR); xb.x = xb_xcc_id(); xb.st = st; xcd_barrier(xb); }
            CParams* q2 = pk; int z2_ = 0, b2_ = bid, n2_ = nb; asm volatile("" : "+s"(q2), "+s"(z2_), "+s"(b2_), "+s"(n2_)); run_phase(*q2, lds + z2_, ph, b2_, n2_, RPT_MODE); }
#endif
#ifdef RPT_AB
        if (ph < 89 && ((ph - 1) % 11) == 3) { for (int rr = 0; rr < 2; ++rr) { { XcdBarrier xb; xb.bar = (unsigned*)(q->ws + WS_BAR); xb.x = xb_xcc_id(); xb.st = st; xcd_barrier(xb); }
            CParams* q2 = pk; int z2_ = 0, b2_ = bid, n2_ = nb; asm volatile("" : "+s"(q2), "+s"(z2_), "+s"(b2_), "+s"(n2_)); run_phase(*q2, lds + z2_, ph - 1 + rr, b2_, n2_, 0); } }
#endif
        if (ph + 1 < NPHASE) { XcdBarrier xb; xb.bar = (unsigned*)(q->ws + WS_BAR); xb.x = xb_xcc_id(); xb.st = st; xcd_barrier(xb); }
    }
}

constexpr int LDS_BYTES = 131072 + 256;
extern "C" void kernel_launch(void* const* d_in, const int* in_sizes, int n_in, void* d_out, int out_size, void* d_ws, size_t ws_size, hipStream_t stream) {
    static int grid = 0;
    if (grid == 0) {
        if (n_in != 27 || ws_size < WS_END) { fprintf(stderr, "kernel_launch: unexpected n_in %d / ws_size %zu\n", n_in, ws_size); grid = -1; return; }
        int dev = 0, cus = 0, per_cu = 0;
        hipGetDevice(&dev); hipDeviceGetAttribute(&cus, hipDeviceAttributeMultiprocessorCount, dev);
        if (hipFuncSetAttribute((const void*)mega_fwd, hipFuncAttributeMaxDynamicSharedMemorySize, LDS_BYTES) != hipSuccess) { fprintf(stderr, "hipFuncSetAttribute failed\n"); grid = -1; return; }
        if (hipOccupancyMaxActiveBlocksPerMultiprocessor(&per_cu, (const void*)mega_fwd, 512, LDS_BYTES) != hipSuccess || per_cu < 1) { fprintf(stderr, "occupancy query: %d\n", per_cu); per_cu = 1; }
        (void)hipGetLastError();
        grid = cus * 1;
    }
    if (grid < 0) return;
    Params p{};
    const float** pp = (const float**)&p;
    for (int i = 0; i < 27; ++i) pp[i] = (const float*)d_in[i];
    p.out = (float*)d_out; p.ws = (unsigned char*)d_ws;
    p.ph_lo = 0; p.ph_hi = NPHASE;
    void* args[] = {&p};
    hipError_t e = hipLaunchCooperativeKernel((const void*)mega_fwd, dim3(grid), dim3(512), args, LDS_BYTES, stream);
    if (e != hipSuccess) fprintf(stderr, "cooperative launch failed: %s (grid %d)\n", hipGetErrorString(e), grid);
}
```

```cpp
#include <hip/hip_runtime.h>
#include <hip/hip_cooperative_groups.h>
#include <cstdio>
namespace cg = cooperative_groups;
#define MULTI 0
namespace pg8 {
#define PG8_LAS __attribute__((address_space(3)))
typedef unsigned short bf16_t;
typedef short bf16x8 __attribute__((ext_vector_type(8)));
typedef float f32x4 __attribute__((ext_vector_type(4)));
typedef unsigned u32x4 __attribute__((ext_vector_type(4)));
constexpr int BM = 256, BK = 64, HALF = 128, HTB = HALF * BK * 2  , STAGE_BYTES = 8 * HTB, NXCD = 8, WGM = 8;

__host__ __device__ __forceinline__ int lds_byte(int r, int c) { const int st = (r >> 4) * 2 + (c >> 5), rr = r & 15, cc = c & 31, ob = rr * 64 + cc * 2; return st * 1024 + (ob ^ (((ob >> 9) & 1) << 5)); }
__host__ __device__ __forceinline__ void stage_rc(int b, int& R, int& C) { const int st = b / 1024, sb = b % 1024, swz = sb ^ (((sb >> 9) & 1) << 5); R = (st >> 1) * 16 + swz / 64; C = (st & 1) * 32 + (swz % 64) / 2; }
__host__ __device__ __forceinline__ int perm32(int rho) { const int n = rho >> 4, i = rho & 15; return 8 * (i >> 2) + 4 * n + (i & 3); }

struct Unit { int pm, pn; };
struct Gemm { const bf16_t* A; const bf16_t* Bt; int M, N, K; };

struct StaticOrder {
    int nM, nN, nwg, G, c;
    __host__ __device__ void init(int M, int N, int G_, int c_) { nM = M / BM; nN = N / BM; nwg = nM * nN; G = G_; c = c_; }
    __host__ __device__ bool next(int i, Unit& u) const {
        const long L = (long)i * G + c; if (L >= nwg) return false;
        int wgid = (int)L; { const int q = nwg / NXCD, r = nwg % NXCD, xcd = wgid % NXCD, off = wgid / NXCD; wgid = (xcd < r ? xcd * (q + 1) : r * (q + 1) + (xcd - r) * q) + off; }
        const int nig = WGM * nN, gid = wgid / nig, fm = gid * WGM, gsz = (nM - fm) < WGM ? (nM - fm) : WGM;
        u.pm = fm + ((wgid % nig) % gsz); u.pn = (wgid % nig) / gsz; return true;
    }
    __device__ __forceinline__ void a_ready(const Unit&) const {}
    __device__ __forceinline__ void done(const Unit&) const {}
};
__device__ __forceinline__ unsigned cvt_pk_bf16(float lo, float hi) { unsigned r; asm volatile("v_cvt_pk_bf16_f32 %0, %1, %2" : "=v"(r) : "v"(lo), "v"(hi)); return r; }
typedef float f32x2 __attribute__((ext_vector_type(2)));
__device__ __forceinline__ f32x2 gelu_pk(f32x2 v) {
    const f32x2 av = __builtin_elementwise_abs(v), d = av * 0.2316418882f + 1.0f;
    f32x2 t; t.x = __builtin_amdgcn_rcpf(d.x); t.y = __builtin_amdgcn_rcpf(d.y);
    f32x2 q = t * 0.5307027145f + (-0.7265760135f); q = q * t + 0.7107068705f; q = q * t + (-0.142248368f); q = q * t + 0.127414796f; q = q * t;
    const f32x2 s = (v * v) * (-0.72134752044f);
    f32x2 e; e.x = __builtin_amdgcn_exp2f(s.x); e.y = __builtin_amdgcn_exp2f(s.y);
    const f32x2 m = v * (q * e), r = v - m;
    f32x2 o; o.x = v.x < 0.f ? m.x : r.x; o.y = v.y < 0.f ? m.y : r.y; return o;
}
template <int ACT  > struct EpiBf16 {
    static constexpr bool PERM = true, AFTER_DRAIN = false; static constexpr int TMID = -1;
    bf16_t* O; int ldc; const float* bias; int split_cols; size_t split_stride;
    __device__ __forceinline__ void operator()(const f32x4 (&acc)[2][2][4][2], const Unit& u, int wr, int wc, int fr, int fq) const {
        const int row0 = u.pm * BM + wr * 64 + fr; int colt = u.pn * BM; bf16_t* base = O;
        if (split_cols) { const int t = colt / split_cols; base += (size_t)t * split_stride; colt -= t * split_cols; }
        const int col0 = colt + wc * 32 + 8 * fq, bcol0 = u.pn * BM + wc * 32 + 8 * fq;
        f32x4 bv[2][2];
#pragma unroll
        for (int bj = 0; bj < 2; ++bj)
#pragma unroll
            for (int n = 0; n < 2; ++n) bv[bj][n] = bias ? *(const f32x4*)(bias + bcol0 + bj * HALF + 4 * n) : (f32x4){0.f, 0.f, 0.f, 0.f};
#pragma unroll
        for (int ai = 0; ai < 2; ++ai)
#pragma unroll
            for (int m = 0; m < 4; ++m) { bf16_t* rowp = base + (size_t)(row0 + ai * HALF + m * 16) * ldc + col0;
#pragma unroll
                for (int bj = 0; bj < 2; ++bj) { f32x4 v0 = acc[ai][bj][m][0] + bv[bj][0], v1 = acc[ai][bj][m][1] + bv[bj][1];
                    if (ACT == 1) { f32x2 a = gelu_pk((f32x2){v0[0], v0[1]}), b = gelu_pk((f32x2){v0[2], v0[3]}), c = gelu_pk((f32x2){v1[0], v1[1]}), d = gelu_pk((f32x2){v1[2], v1[3]});
                        v0 = (f32x4){a.x, a.y, b.x, b.y}; v1 = (f32x4){c.x, c.y, d.x, d.y}; }
                    if (ACT == 2) {
#pragma unroll
                        for (int j = 0; j < 4; ++j) { v0[j] = 0.5f * v0[j] * (1.0f + erff(v0[j] * 0.70710678f)); v1[j] = 0.5f * v1[j] * (1.0f + erff(v1[j] * 0.70710678f)); } }
                    u32x4 w; w.x = cvt_pk_bf16(v0[0], v0[1]); w.y = cvt_pk_bf16(v0[2], v0[3]); w.z = cvt_pk_bf16(v1[0], v1[1]); w.w = cvt_pk_bf16(v1[2], v1[3]);
                    *(u32x4*)(rowp + bj * HALF) = w; } }
    }
};
__device__ __forceinline__ float epi_bf2f(unsigned short b) { return __uint_as_float(((unsigned)b) << 16); }
__device__ __forceinline__ float epi_sigmoid(float x) { return __builtin_amdgcn_rcpf(1.f + __expf(-x)); }
typedef unsigned u32x2 __attribute__((ext_vector_type(2)));
struct EpiBf16Act {
    static constexpr bool PERM = true, AFTER_DRAIN = false; static constexpr int TMID = -1;
    bf16_t* O; int ldc; int silu_pm_lt, silu_pn_lt, sig_pn_ge;
    __device__ __forceinline__ void operator()(const f32x4 (&acc)[2][2][4][2], const Unit& u, int wr, int wc, int fr, int fq) const {
        const int row0 = u.pm * BM + wr * 64 + fr, col0 = u.pn * BM + wc * 32 + 8 * fq;
        int act = 0; if (u.pm < silu_pm_lt) act = 1; if (u.pn < silu_pn_lt) act = 1; else if (u.pn >= sig_pn_ge) act = 2;
#pragma unroll
        for (int ai = 0; ai < 2; ++ai)
#pragma unroll
            for (int m = 0; m < 4; ++m) { bf16_t* rowp = O + (size_t)(row0 + ai * HALF + m * 16) * ldc + col0;
#pragma unroll
                for (int bj = 0; bj < 2; ++bj) { f32x4 v0 = acc[ai][bj][m][0], v1 = acc[ai][bj][m][1];
                    if (act) {
#pragma unroll
                        for (int j = 0; j < 4; ++j) { const float s0 = __builtin_amdgcn_rcpf(1.f + __expf(-v0[j])), s1 = __builtin_amdgcn_rcpf(1.f + __expf(-v1[j]));
                            v0[j] = (act == 1) ? v0[j] * s0 : s0; v1[j] = (act == 1) ? v1[j] * s1 : s1; } }
                    u32x4 w; w.x = cvt_pk_bf16(v0[0], v0[1]); w.y = cvt_pk_bf16(v0[2], v0[3]); w.z = cvt_pk_bf16(v1[0], v1[1]); w.w = cvt_pk_bf16(v1[2], v1[3]);
                    *(u32x4*)(rowp + bj * HALF) = w; } }
    }
};
struct EpiGateMerge {
    static constexpr bool PERM = false, AFTER_DRAIN = false; static constexpr int TMID = 8;
    bf16_t* O; const bf16_t* G; int ldg; int goffA, goffB;
    __device__ __forceinline__ void mid(f32x4 (&acc)[2][2][4][2], const Unit& u, int wr, int wc, int fr, int fq) const {
        int row0 = u.pm * BM + wr * 64 + fr, col0 = u.pn * BM + wc * 32 + 4 * fq;
        asm volatile("" : "+v"(row0), "+v"(col0));
#pragma unroll
        for (int ai = 0; ai < 2; ++ai)
#pragma unroll
            for (int m = 0; m < 4; ++m) { const int row = row0 + ai * HALF + m * 16; const bf16_t* gp = G + (size_t)row * ldg + col0;
#pragma unroll
                for (int bj = 0; bj < 2; ++bj)
#pragma unroll
                    for (int n = 0; n < 2; ++n) { const u32x2 ga = *(const u32x2*)(gp + goffA + bj * HALF + n * 16), gb = *(const u32x2*)(gp + goffB + bj * HALF + n * 16);
                        const float a0 = __uint_as_float(ga.x << 16), a1 = __uint_as_float(ga.x & 0xffff0000u), a2 = __uint_as_float(ga.y << 16), a3 = __uint_as_float(ga.y & 0xffff0000u);
                        const float b0 = __uint_as_float(gb.x << 16), b1 = __uint_as_float(gb.x & 0xffff0000u), b2 = __uint_as_float(gb.y << 16), b3 = __uint_as_float(gb.y & 0xffff0000u);
                        f32x4 r; r[0] = a0 * __builtin_amdgcn_rcpf(b0); r[1] = a1 * __builtin_amdgcn_rcpf(b1); r[2] = a2 * __builtin_amdgcn_rcpf(b2); r[3] = a3 * __builtin_amdgcn_rcpf(b3);
                        acc[ai][bj][m][n] = acc[ai][bj][m][n] * r; }
                asm volatile("" ::: "memory"); }
    }
    __device__ __forceinline__ void operator()(const f32x4 (&acc)[2][2][4][2], const Unit& u, int wr, int wc, int fr, int fq) const {
        const int row0 = u.pm * BM + wr * 64 + fr, col0 = u.pn * BM + wc * 32 + 4 * fq;
#pragma unroll
        for (int ai = 0; ai < 2; ++ai)
#pragma unroll
            for (int m = 0; m < 4; ++m) { const int row = row0 + ai * HALF + m * 16; bf16_t* op = O + (size_t)row * 1024 + col0; const bf16_t* gp = G + (size_t)row * ldg + goffB + col0;
#pragma unroll
                for (int bj = 0; bj < 2; ++bj)
#pragma unroll
                    for (int n = 0; n < 2; ++n) { const u32x2 gw = *(const u32x2*)(gp + bj * HALF + n * 16); const f32x4 a = acc[ai][bj][m][n]; f32x4 o;
                        o[0] = a[0] * __uint_as_float(gw.x << 16); o[1] = a[1] * __uint_as_float(gw.x & 0xffff0000u);
                        o[2] = a[2] * __uint_as_float(gw.y << 16); o[3] = a[3] * __uint_as_float(gw.y & 0xffff0000u);
                        u32x2 w; w.x = cvt_pk_bf16(o[0], o[1]); w.y = cvt_pk_bf16(o[2], o[3]);
                        *(u32x2*)(op + bj * HALF + n * 16) = w; } }
    }
};
struct EpiResid {
    static constexpr bool PERM = false, AFTER_DRAIN = false; static constexpr int TMID = -1;
    float* X; const float* MODG; int rowbase; const float* Xp; const float* Xs;
    __device__ __forceinline__ void operator()(const f32x4 (&acc)[2][2][4][2], const Unit& u, int wr, int wc, int fr, int fq) const {
        const int row0 = rowbase + u.pm * BM + wr * 64 + fr, col0 = u.pn * BM + wc * 32 + 4 * fq;
        const int tok0 = rowbase + u.pm * BM; const int grp = tok0 < 8192 ? 0 : 1 + ((tok0 - 8192) >> 12);
        const float* src = Xp ? (tok0 < 8192 ? Xp : Xs - (size_t)8192 * 1024) : X;
        const float* gv = MODG + (size_t)grp * 6144 + col0;
        f32x4 g[2][2];
#pragma unroll
        for (int bj = 0; bj < 2; ++bj)
#pragma unroll
            for (int n = 0; n < 2; ++n) g[bj][n] = *(const f32x4*)(gv + bj * HALF + n * 16);
#pragma unroll
        for (int ai = 0; ai < 2; ++ai)
#pragma unroll
            for (int m = 0; m < 4; ++m) { float* rowp = X + (size_t)(row0 + ai * HALF + m * 16) * 1024 + col0; const float* srcp = src + (size_t)(row0 + ai * HALF + m * 16) * 1024 + col0;
#pragma unroll
                for (int bj = 0; bj < 2; ++bj)
#pragma unroll
                    for (int n = 0; n < 2; ++n) { f32x4 x = *(const f32x4*)(srcp + bj * HALF + n * 16); x = x + g[bj][n] * acc[ai][bj][m][n]; *(f32x4*)(rowp + bj * HALF + n * 16) = x; } }
    }
};
template <class Epi, class Sched, bool STAMP = false>
__device__ __forceinline__ void gemm_phase(PG8_LAS unsigned char* lds, const Gemm g, const Sched& S, const Epi& E, unsigned long long* stamps) {
    int tid_l = threadIdx.x; asm volatile("" : "+v"(tid_l)); const int tid = tid_l, wid = __builtin_amdgcn_readfirstlane(tid >> 6), lane = tid & 63, wr = wid >> 2, wc = wid & 3, fr = lane & 15, fq = lane >> 4;
    const int K = g.K, nt = K / BK;
    int ts_lo = 0, ts_hi = 0, nts = 0; const unsigned long long rt_entry = STAMP ? (unsigned long long)wall_clock64() : 0ull;
#define PG8_STAMP() do { if (STAMP && wid == 0 && nts < 64) { const unsigned long long _c = (unsigned long long)clock64(); \
        ts_lo = (lane == nts) ? (int)(unsigned)_c : ts_lo; ts_hi = (lane == nts) ? (int)(unsigned)(_c >> 32) : ts_hi; ++nts; } } while (0)
    PG8_STAMP();
    unsigned voffA[2], voffB[2];
#pragma unroll
    for (int i = 0; i < 2; ++i) { int R, C; stage_rc(tid * 16 + i * 8192, R, C); const int Rb = Epi::PERM ? ((R & ~31) + perm32(R & 31)) : R;
        voffA[i] = (unsigned)(R * K + C) * 2u; voffB[i] = (unsigned)(Rb * K + C) * 2u; }
    const size_t kstep = (size_t)(BK * 2);
    const size_t hstep = (size_t)HALF * K * 2;
    const size_t tstep = 2 * hstep;
    const unsigned ldsw = (unsigned)wid * 1024u;
    const int aoff = lds_byte(wr * 64 + fr, fq * 8), boff = lds_byte(wc * 32 + fr, fq * 8);
#define PG8_SA(b, h) (((b) * 2 + (h)) * HTB)
#define PG8_SB(b, h) ((4 + (b) * 2 + (h)) * HTB)
#define PG8_STAGE(bufoff, gbase, voff) do { _Pragma("unroll") for (int _i = 0; _i < 2; ++_i) \
        __builtin_amdgcn_global_load_lds((const unsigned*)((const char*)(gbase) + (voff)[_i]), (PG8_LAS unsigned*)(lds + (bufoff) + ldsw + _i * 8192), 16, 0, 0); } while (0)
#define PG8_LDA(dst, b, h) do { _Pragma("unroll") for (int m = 0; m < 4; ++m) _Pragma("unroll") for (int k = 0; k < 2; ++k) dst[m][k] = *(const PG8_LAS bf16x8*)(lds + PG8_SA(b, h) + aoff + m * 2048 + k * 1024); } while (0)
#define PG8_LDB(dst, b, h) do { _Pragma("unroll") for (int n = 0; n < 2; ++n) _Pragma("unroll") for (int k = 0; k < 2; ++k) dst[n][k] = *(const PG8_LAS bf16x8*)(lds + PG8_SB(b, h) + boff + n * 2048 + k * 1024); } while (0)
#define PG8_MMA(ai, bj, At, Bt) do { __builtin_amdgcn_s_setprio(1); _Pragma("unroll") for (int m = 0; m < 4; ++m) _Pragma("unroll") for (int n = 0; n < 2; ++n) _Pragma("unroll") for (int k = 0; k < 2; ++k) \
        acc[ai][bj][m][n] = __builtin_amdgcn_mfma_f32_16x16x32_bf16(Bt[n][k], At[m][k], acc[ai][bj][m][n], 0, 0, 0); __builtin_amdgcn_s_setprio(0); } while (0)
#define PG8_WAIT_V(n) asm volatile("s_waitcnt vmcnt(" #n ")" ::: "memory")
#define PG8_WAIT_L(n) asm volatile("s_waitcnt lgkmcnt(" #n ")" ::: "memory")
#define PG8_BAR __builtin_amdgcn_s_barrier()
#define PG8_SCHED __builtin_amdgcn_sched_barrier(0)
    Unit cur, nxt; int ui = 0;
    if (!S.next(0, cur)) return;
    f32x4 acc[2][2][4][2];
#pragma unroll
    for (int a = 0; a < 2; ++a)
#pragma unroll
        for (int b = 0; b < 2; ++b)
#pragma unroll
            for (int m = 0; m < 4; ++m)
#pragma unroll
                for (int n = 0; n < 2; ++n) acc[a][b][m][n] = (f32x4){0.f, 0.f, 0.f, 0.f};
    bf16x8 At[4][2], B0[2][2], B1[2][2];
    const char* cA = (const char*)g.A + (size_t)cur.pm * tstep; const char* cB = (const char*)g.Bt + (size_t)cur.pn * tstep;
    S.a_ready(cur);
    PG8_STAGE(PG8_SB(0, 0), cB, voffB); PG8_STAGE(PG8_SB(0, 1), cB + hstep, voffB); PG8_STAGE(PG8_SA(0, 0), cA, voffA); PG8_STAGE(PG8_SA(0, 1), cA + hstep, voffA);
    if (wr == 1) PG8_BAR;
    PG8_WAIT_V(2); PG8_BAR;
    PG8_STAGE(PG8_SB(1, 0), cB + kstep, voffB); PG8_STAGE(PG8_SA(1, 0), cA + kstep, voffA); PG8_STAGE(PG8_SB(1, 1), cB + hstep + kstep, voffB);
    PG8_WAIT_V(6); PG8_BAR;
    PG8_STAMP();
    for (;;) {
        const bool has_next = S.next(ui + 1, nxt);
        const char* nA = has_next ? (const char*)g.A + (size_t)nxt.pm * tstep : cA; const char* nB = has_next ? (const char*)g.Bt + (size_t)nxt.pn * tstep : cB;
        for (int t = 0; t < nt; t += 2) {
            const bool last = (t == nt - 2);
            const char* a1 = cA + (size_t)(t + 1) * kstep;
            const char* a2 = last ? nA : cA + (size_t)(t + 2) * kstep; const char* b2 = last ? nB : cB + (size_t)(t + 2) * kstep;
            const char* a3 = a2 + kstep; const char* b3 = b2 + kstep;
            if (last && has_next) S.a_ready(nxt);
            if constexpr (Epi::TMID >= 0) { if (t == Epi::TMID) E.mid(acc, cur, wr, wc, fr, fq); }
            PG8_LDB(B0, 0, 0); PG8_LDB(B1, 0, 1); PG8_SCHED; PG8_LDA(At, 0, 0); PG8_STAGE(PG8_SA(1, 1), a1 + hstep, voffA);
            PG8_WAIT_V(8); PG8_WAIT_L(0); PG8_BAR; PG8_MMA(0, 0, At, B0); PG8_MMA(0, 1, At, B1); PG8_BAR; PG8_SCHED;
            PG8_LDA(At, 0, 1); PG8_STAGE(PG8_SB(0, 0), b2, voffB); PG8_STAGE(PG8_SB(0, 1), b2 + hstep, voffB); PG8_STAGE(PG8_SA(0, 0), a2, voffA);
            PG8_WAIT_V(8); PG8_WAIT_L(0); PG8_BAR; PG8_MMA(1, 0, At, B0); PG8_MMA(1, 1, At, B1); PG8_BAR; PG8_SCHED;
            PG8_LDB(B0, 1, 0); PG8_LDB(B1, 1, 1); PG8_SCHED; PG8_LDA(At, 1, 0); PG8_STAGE(PG8_SA(0, 1), a2 + hstep, voffA);
            PG8_WAIT_V(8); PG8_WAIT_L(0); PG8_BAR; PG8_MMA(0, 0, At, B0); PG8_MMA(0, 1, At, B1); PG8_BAR; PG8_SCHED;
            PG8_LDA(At, 1, 1); PG8_STAGE(PG8_SB(1, 0), b3, voffB); PG8_STAGE(PG8_SB(1, 1), b3 + hstep, voffB); PG8_STAGE(PG8_SA(1, 0), a3, voffA);
            PG8_WAIT_V(8); PG8_WAIT_L(0); PG8_BAR; PG8_MMA(1, 0, At, B0); PG8_MMA(1, 1, At, B1); PG8_BAR; PG8_SCHED;
        }
        PG8_STAMP();
        if (wr == 0) PG8_BAR;
        if constexpr (!Epi::AFTER_DRAIN) { E(acc, cur, wr, wc, fr, fq); S.done(cur); }
        PG8_STAMP();
        if (!has_next) break;
#pragma unroll
        for (int a = 0; a < 2; ++a)
#pragma unroll
            for (int b = 0; b < 2; ++b)
#pragma unroll
                for (int m = 0; m < 4; ++m)
#pragma unroll
                    for (int n = 0; n < 2; ++n) acc[a][b][m][n] = (f32x4){0.f, 0.f, 0.f, 0.f};
        cur = nxt; cA = nA; cB = nB; ++ui;
        if (wr == 1) PG8_BAR;
    }
    PG8_WAIT_V(0);
    PG8_BAR;
    if constexpr (Epi::AFTER_DRAIN) { E.fused(acc, cur, wr, wc, fr, fq, lds, wid, lane); S.done(cur); }
    PG8_STAMP();
    if (STAMP && wid == 0) { stamps[lane] = lane < nts ? (((unsigned long long)(unsigned)ts_hi << 32) | (unsigned)ts_lo) : 0ull;
        if (lane == 62) stamps[62] = rt_entry; if (lane == 63) stamps[63] = (unsigned long long)wall_clock64(); }
#undef PG8_STAMP
#undef PG8_SA
#undef PG8_SB
#undef PG8_STAGE
#undef PG8_LDA
#undef PG8_LDB
#undef PG8_MMA
#undef PG8_WAIT_V
#undef PG8_WAIT_L
#undef PG8_BAR
#undef PG8_SCHED
}
}

#ifndef MULTI
#define MULTI 0
#endif
#define DI __device__ __forceinline__
typedef unsigned short bf16_t;
typedef short bf16x8 __attribute__((ext_vector_type(8)));
typedef float f32x4 __attribute__((ext_vector_type(4)));
typedef float f32x16 __attribute__((ext_vector_type(16)));
typedef unsigned u32x4 __attribute__((ext_vector_type(4)));
typedef unsigned u32x2 __attribute__((ext_vector_type(2)));

constexpr int DM = 1024, NLAYER = 4, NP = 7424, NIN = 7200, DFF = 2816, NUP = 5632;
constexpr int TTOK = 24576, HT = 12288, NCH = 192;
constexpr int C_Q = 0, C_V = 512, C_F = 1024, C_GA = 2048, C_Z = 2560, C_XBC = 3584, C_DT = 5120, C_GATE = 5152;
constexpr float EPSN = 1e-6f;
constexpr int NTHR = 512;

constexpr size_t MiB = 1u << 20;
constexpr size_t WS_MOD = 0;
constexpr size_t WS_LB = 512 * 1024;
constexpr size_t WS_DECA = 1 * MiB;
constexpr size_t WS_DECB = 3 * MiB;
constexpr size_t WS_WIN = 4 * MiB;
constexpr size_t WS_WBRA = 19 * MiB;
constexpr size_t WS_WBRB = 20 * MiB;
constexpr size_t WS_WOUT = 22 * MiB;
constexpr size_t WS_WUP = 24 * MiB;
constexpr size_t WS_WDN = 35 * MiB;
constexpr size_t WS_U = 41 * MiB;
constexpr size_t WS_OA = 65 * MiB;
constexpr size_t WS_YB = 77 * MiB;
constexpr size_t WS_SA = 101 * MiB;
constexpr size_t WS_SB = 149 * MiB;
constexpr size_t WS_PROJ = 197 * MiB;
constexpr size_t WS_W2OFS = 368 * MiB;
constexpr size_t WS_END = 410 * MiB;

struct Params {
    const float *x_prompt, *x_sample, *c, *state_hgrn, *state_ssd, *c_ctx, *w_ada, *b_ada, *ln1, *ln2, *ln_f, *w_in, *lb_logits, *a_norm,
        *conv_w, *conv_b, *dt_bias, *a_log, *d_skip, *b_norm, *w_br_a, *w_br_b, *w_out, *w_ff_up, *ff_conv_w, *ff_conv_b, *w_ff_down;
    float* out; unsigned char* ws; int ph_lo, ph_hi;
};
typedef const __attribute__((address_space(4))) Params CParams;
constexpr size_t OUT_SH = (size_t)TTOK * DM;
constexpr size_t OUT_SS = OUT_SH + (size_t)32 * 4 * 2 * 4 * 128 * 128;

DI int get_tid() { int t = threadIdx.x; asm volatile("" : "+v"(t)); return t; }
DI float bf2f(bf16_t b) { return __uint_as_float(((unsigned)b) << 16); }
typedef __bf16 hwbf16x2 __attribute__((ext_vector_type(2)));
typedef float f32x2v __attribute__((ext_vector_type(2)));
DI unsigned pk2(float lo, float hi) { const f32x2v v = {lo, hi}; const hwbf16x2 b = __builtin_convertvector(v, hwbf16x2); return __builtin_bit_cast(unsigned, b); }
DI unsigned f2bf(float f) { return pk2(f, 0.f) & 0xffffu; }
DI void unpack8(const u32x4 r, float* o) { o[0] = __uint_as_float(r.x << 16); o[1] = __uint_as_float(r.x & 0xffff0000u); o[2] = __uint_as_float(r.y << 16); o[3] = __uint_as_float(r.y & 0xffff0000u);
    o[4] = __uint_as_float(r.z << 16); o[5] = __uint_as_float(r.z & 0xffff0000u); o[6] = __uint_as_float(r.w << 16); o[7] = __uint_as_float(r.w & 0xffff0000u); }
DI u32x4 pack8(const float* y) { u32x4 o; o.x = pk2(y[0], y[1]); o.y = pk2(y[2], y[3]); o.z = pk2(y[4], y[5]); o.w = pk2(y[6], y[7]); return o; }
DI float sigm(float x) { return __builtin_amdgcn_rcpf(1.f + __expf(-x)); }
DI float silu(float x) { return x * __builtin_amdgcn_rcpf(1.f + __expf(-x)); }
DI float wave_sum(float v) {
#pragma unroll
    for (int o = 1; o < 64; o <<= 1) v += __shfl_xor(v, o);
    return v;
}
DI f32x16 mfma32(bf16x8 a, bf16x8 b, f32x16 c) { return __builtin_amdgcn_mfma_f32_32x32x16_bf16(a, b, c, 0, 0, 0); }
DI f32x16 zero16() { f32x16 z;
#pragma unroll
    for (int i = 0; i < 16; ++i) z[i] = 0.f; return z; }

struct SeqInfo { int first, nch, latent, batch; };
DI SeqInfo seq_of(int hf, int sq) { SeqInfo s; if (hf == 0) { if (sq < 32) { s.first = 4 * sq; s.nch = 4; s.latent = 0; s.batch = sq; } else { s.first = 128; s.nch = 64; s.latent = 1; s.batch = 0; } }
    else { s.first = 64 * sq; s.nch = 64; s.latent = 1; s.batch = 1 + sq; } return s; }
DI void chunk_halo(int hf, int c, bool& has_prev, bool& has_next) { const bool ctx = (hf == 0 && c < 128); has_prev = ctx && ((c & 3) != 0); has_next = ctx && ((c & 3) != 3); }

DI void phase_init(CParams& p, unsigned char* lds, int bid, int nb) {
    const int tid = get_tid();
    float* MOD = (float*)(p.ws + WS_MOD);
    float* CV = (float*)lds;
    float* RED = (float*)(lds + 20480);
    for (int i = tid; i < 5 * 1024; i += NTHR) { const int g = i >> 10, k = i & 1023; const float v = (g == 0) ? p.c_ctx[k] : p.c[(g - 1) * 1024 + k]; CV[i] = silu(v); }
    __syncthreads();
    for (int item = bid; item < 4 * 48; item += nb) {
        const int l = item / 48, jb = item % 48; const int jj = tid & 31, kp = tid >> 5;
        const float* W = p.w_ada + (size_t)l * 1024 * 6144 + (size_t)(kp * 64) * 6144 + jb * 128 + jj * 4;
        const float fz_ = __uint_as_float((unsigned)(tid >> 31)); f32x4 a0 = {fz_, fz_, fz_, fz_}, a1 = a0, a2 = a0, a3 = a0, a4 = a0;
#pragma unroll 8
        for (int k = 0; k < 64; ++k) { const f32x4 w = *(const f32x4*)(W + (size_t)k * 6144); const int kk = kp * 64 + k;
            a0 += w * CV[kk]; a1 += w * CV[1024 + kk]; a2 += w * CV[2048 + kk]; a3 += w * CV[3072 + kk]; a4 += w * CV[4096 + kk]; }
        float* r = RED + (kp * 5) * 128 + jj * 4;
        *(f32x4*)(r) = a0; *(f32x4*)(r + 128) = a1; *(f32x4*)(r + 256) = a2; *(f32x4*)(r + 384) = a3; *(f32x4*)(r + 512) = a4;
        __syncthreads();
        for (int o = tid; o < 640; o += NTHR) { const int g = o >> 7, col = o & 127; float s = p.b_ada[l * 6144 + jb * 128 + col];
#pragma unroll
            for (int q = 0; q < 16; ++q) s += RED[(q * 5 + g) * 128 + col];
            MOD[(size_t)(l * 5 + g) * 6144 + jb * 128 + col] = s; }
        __syncthreads();
    }
    if (bid == nb - 1) {
        float* LB = (float*)(p.ws + WS_LB);
        for (int i = tid; i < 1024; i += NTHR) { float v[4], mx = -1e30f;
#pragma unroll
            for (int l = 0; l < 4; ++l) { v[l] = p.lb_logits[l * 1024 + i]; mx = fmaxf(mx, v[l]); }
            float s = 0.f;
#pragma unroll
            for (int l = 0; l < 4; ++l) { v[l] = __expf(v[l] - mx); s += v[l]; }
            const float inv = 1.f / s; float cum = 0.f; LB[i] = 0.f;
#pragma unroll
            for (int l = 1; l < 4; ++l) { cum += v[l] * inv; LB[l * 1024 + i] = fmaxf(cum, 0.f); } }
    }
}

template <bool REMAP> DI void transpose_item(const float* W, int K, int N, bf16_t* WT, float* scr, int item, int lane, int ldk = 0, int koff = 0) {
    if (ldk == 0) ldk = K;
    const int nblk = N / 32, kb = item / nblk, nbk = item % nblk, k0 = 64 * kb, n0 = 32 * nbk;
    const int r0 = !REMAP ? n0 : (n0 < 2048 ? n0 : (n0 < 3584 ? 3840 + (n0 - 2048) : (n0 < 5152 ? 2048 + (n0 - 3584) : 3840 + 1536 + (n0 - 5152))));
#pragma unroll 8
    for (int i = 0; i < 32; ++i) { const int kk = 2 * i + (lane >> 5); scr[kk * 33 + (lane & 31)] = W[(size_t)(k0 + kk) * N + n0 + (lane & 31)]; }
    asm volatile("s_waitcnt lgkmcnt(0)" ::: "memory");
    const int c = lane & 7;
#pragma unroll
    for (int j = 0; j < 4; ++j) { const int n = (lane >> 3) + 8 * j; const float* s = scr + (8 * c) * 33 + n;
        u32x4 o; o.x = pk2(s[0 * 33], s[1 * 33]); o.y = pk2(s[2 * 33], s[3 * 33]); o.z = pk2(s[4 * 33], s[5 * 33]); o.w = pk2(s[6 * 33], s[7 * 33]);
        *(u32x4*)(WT + (size_t)(r0 + n) * ldk + koff + k0 + 8 * c) = o; }
    asm volatile("s_waitcnt lgkmcnt(0)" ::: "memory");
}
constexpr int WC_IN = 16 * 225, WC_A = 8 * 32, WC_B = 16 * 32, WC_O = 16 * 32, WC_U = 16 * 176, WC_D = 44 * 32;
constexpr int WC_NIT = WC_IN + WC_A + WC_B + WC_O + WC_U + WC_D;
DI void phase_wconv(CParams& p, unsigned char* lds, int l, int vb, int nvb, int it_lo, int it_hi) {
    const int tid = get_tid(), lane = tid & 63, wave = __builtin_amdgcn_readfirstlane(tid >> 6);
    float* scr = (float*)(lds + wave * 8704);
    const int gw = vb * 8 + wave, NGW = nvb * 8;
    unsigned char* ws = p.ws + ((l & 1) ? WS_W2OFS : 0);
    for (int it = it_lo + gw; it < it_hi; it += NGW) {
        int r = it;
        if (r < WC_IN) { transpose_item<true>(p.w_in + (size_t)l * 1024 * NIN, 1024, NIN, (bf16_t*)(ws + WS_WIN), scr, r, lane); continue; } r -= WC_IN;
        if (r < WC_A) { transpose_item<false>(p.w_br_a + (size_t)l * 512 * 1024, 512, 1024, (bf16_t*)(ws + WS_WBRA), scr, r, lane, 1536, 0); continue; } r -= WC_A;
        if (r < WC_B) { transpose_item<false>(p.w_br_b + (size_t)l * 1024 * 1024, 1024, 1024, (bf16_t*)(ws + WS_WBRA), scr, r, lane, 1536, 512); continue; } r -= WC_B;
        if (r < WC_O) { transpose_item<false>(p.w_out + (size_t)l * 1024 * 1024, 1024, 1024, (bf16_t*)(ws + WS_WOUT), scr, r, lane); continue; } r -= WC_O;
        if (r < WC_U) { transpose_item<false>(p.w_ff_up + (size_t)l * 1024 * NUP, 1024, NUP, (bf16_t*)(ws + WS_WUP), scr, r, lane); continue; } r -= WC_U;
        transpose_item<false>(p.w_ff_down + (size_t)l * DFF * 1024, DFF, 1024, (bf16_t*)(ws + WS_WDN), scr, r, lane);
    }
    if (it_lo == 0) {
        u32x4* z = (u32x4*)((bf16_t*)(ws + WS_WIN) + (size_t)3616 * 1024); const int nz = (3840 - 3616) * 1024 / 8;
        const unsigned uz_ = (unsigned)(tid >> 31);
        for (int i = vb * NTHR + tid; i < nz; i += nvb * NTHR) z[i] = (u32x4){uz_, uz_, uz_, uz_};
    }
    __syncthreads();
}
DI void wconv_side(CParams& p, unsigned char* lds, int l, int hf, int bid, int nb, int it_lo, int it_hi) {
    if (hf != 1 || l >= 3) return;
    if (nb > 192) { if (bid >= 192) phase_wconv(p, lds, l + 1, bid - 192, nb - 192, it_lo, it_hi); }
    else phase_wconv(p, lds, l + 1, bid, nb, it_lo, it_hi);
}

DI void phase_norm(CParams& p, int l, int hf, int which, int bid, int nb) {
    const int tid = get_tid(), lane = tid & 63, wave = __builtin_amdgcn_readfirstlane(tid >> 6);
    const float* MOD = (const float*)(p.ws + WS_MOD);
    bf16_t* U = (bf16_t*)(p.ws + WS_U);
    const float* ln = (which == 0 ? p.ln1 : p.ln2) + l * 1024;
    for (int r = bid * 8 + wave; r < HT; r += nb * 8) {
        const int tok = hf * HT + r; const int grp = tok < 8192 ? 0 : 1 + ((tok - 8192) >> 12);
        const float* md = MOD + (size_t)(l * 5 + grp) * 6144 + which * 3072;
        const float* xsrc = (l == 0 && which == 0) ? (tok < 8192 ? p.x_prompt + (size_t)tok * 1024 : p.x_sample + (size_t)(tok - 8192) * 1024) : p.out + (size_t)tok * 1024;
        const f32x4* xr = (const f32x4*)xsrc + lane;
        f32x4 v[4]; float s = 0.f;
#pragma unroll
        for (int j = 0; j < 4; ++j) { v[j] = xr[64 * j]; s += (v[j].x * v[j].x + v[j].y * v[j].y) + (v[j].z * v[j].z + v[j].w * v[j].w); }
        const float rstd = __builtin_amdgcn_rsqf(wave_sum(s) * (1.f / 1024.f) + EPSN);
        unsigned long long* o8 = (unsigned long long*)(U + (size_t)r * 1024) + lane;
#pragma unroll
        for (int j = 0; j < 4; ++j) { const int col = 4 * (64 * j + lane);
            const f32x4 g = *(const f32x4*)(ln + col), sh = *(const f32x4*)(md + col), sc = *(const f32x4*)(md + 1024 + col);
            const f32x4 y = v[j] * rstd * g * (sc + 1.f) + sh;
            o8[64 * j] = (unsigned long long)pk2(y.x, y.y) | ((unsigned long long)pk2(y.z, y.w) << 32); }
    }
}
DI void phase_final_norm(CParams& p, int bid, int nb) {
    const int tid = get_tid(), lane = tid & 63, wave = __builtin_amdgcn_readfirstlane(tid >> 6);
    for (int r = bid * 8 + wave; r < TTOK; r += nb * 8) {
        f32x4* xr = (f32x4*)(p.out + (size_t)r * 1024) + lane;
        f32x4 v[4]; float s = 0.f;
#pragma unroll
        for (int j = 0; j < 4; ++j) { v[j] = xr[64 * j]; s += (v[j].x * v[j].x + v[j].y * v[j].y) + (v[j].z * v[j].z + v[j].w * v[j].w); }
        const float rstd = __builtin_amdgcn_rsqf(wave_sum(s) * (1.f / 1024.f) + EPSN);
#pragma unroll
        for (int j = 0; j < 4; ++j) { const int col = 4 * (64 * j + lane); const f32x4 g = *(const f32x4*)(p.ln_f + col); xr[64 * j] = v[j] * rstd * g; }
    }
}

DI void phase_convact(CParams& p, int l, int hf, int bid, int nb) {
    const bf16_t* H = (const bf16_t*)(p.ws + WS_PROJ); bf16_t* ACT = (bf16_t*)(p.ws + WS_SA);
    const float* cw = p.ff_conv_w + (size_t)l * 3 * NUP; const float* cb = p.ff_conv_b + (size_t)l * NUP;
    const int tid = get_tid();
    constexpr int NRUN = HT / 32, NITEM = 352 * NRUN, PER_BLK = (NITEM + 255) / 256;
    for (int li = tid; li < PER_BLK; li += NTHR) { const int it = bid * PER_BLK + li; if (it >= NITEM) break;
        const int cg8 = (it % 352) * 8, t0 = (it / 352) * 32;
        const bool latent = (hf == 1) || (t0 >= 8192); const int per = latent ? 64 : 256;
        const bool hp = (t0 & (per - 1)) != 0, hn = ((t0 + 31) & (per - 1)) != per - 1;
        float w[2][3][8], bs[2][8];
#pragma unroll
        for (int hh = 0; hh < 2; ++hh) { const int col = hh * DFF + cg8;
#pragma unroll
            for (int k = 0; k < 3; ++k) { const f32x4 a = *(const f32x4*)(cw + k * NUP + col), b = *(const f32x4*)(cw + k * NUP + col + 4);
#pragma unroll
                for (int j = 0; j < 4; ++j) { w[hh][k][j] = a[j]; w[hh][k][4 + j] = b[j]; } }
            const f32x4 a = *(const f32x4*)(cb + col), b = *(const f32x4*)(cb + col + 4);
#pragma unroll
            for (int j = 0; j < 4; ++j) { bs[hh][j] = a[j]; bs[hh][4 + j] = b[j]; } }
        const bf16_t* ha = H + (size_t)t0 * NUP + cg8; const bf16_t* hb = ha + DFF;
        const unsigned uz_ = (unsigned)(tid >> 31); const u32x4 z4 = {uz_, uz_, uz_, uz_};
        u32x4 am = hp ? *(const u32x4*)(ha - NUP) : z4, bm = hp ? *(const u32x4*)(hb - NUP) : z4;
        u32x4 a0 = *(const u32x4*)ha, b0 = *(const u32x4*)hb;
#pragma unroll 4
        for (int t = 0; t < 32; ++t) {
            const bool more = (t < 31) || hn;
            const u32x4 ap = more ? *(const u32x4*)(ha + (size_t)(t + 1) * NUP) : z4, bp = more ? *(const u32x4*)(hb + (size_t)(t + 1) * NUP) : z4;
            float xa[3][8], xb[3][8]; unpack8(am, xa[0]); unpack8(a0, xa[1]); unpack8(ap, xa[2]); unpack8(bm, xb[0]); unpack8(b0, xb[1]); unpack8(bp, xb[2]);
            float r[8];
#pragma unroll
            for (int j = 0; j < 8; ++j) { const float va = bs[0][j] + w[0][0][j] * xa[0][j] + w[0][1][j] * xa[1][j] + w[0][2][j] * xa[2][j];
                const float vb = bs[1][j] + w[1][0][j] * xb[0][j] + w[1][1][j] * xb[1][j] + w[1][2][j] * xb[2][j]; r[j] = silu(va) * vb; }
            *(u32x4*)(ACT + (size_t)(t0 + t) * DFF + cg8) = pack8(r);
            am = a0; a0 = ap; bm = b0; b0 = bp;
        }
    }
}

constexpr int TQ = 0, TV = 512, TF = 1024, TX = 2048, TDT = 3584, NTROW = 3840;
constexpr int G_GA = 0, G_Z = 512, G_GATE = 1536, NG = 3584;
constexpr size_t WS_PROJG = WS_PROJ + (size_t)NTROW * HT * 2;
DI void hgrn_gates(const u32x4 (&raw)[4], float lb, float* SUMS, int d, int sh, int k, float (&f)[32], float& PA, float& PB) {
    const float oml = 1.f - lb; float loc = 1.f;
#pragma unroll
    for (int j = 0; j < 4; ++j) unpack8(raw[j], &f[8 * j]);
#pragma unroll
    for (int j = 0; j < 32; ++j) { f[j] = fmaxf(lb + oml * sigm(f[j]), 1e-30f); loc *= f[j]; }
    SUMS[(d * 2 + sh) * 128 + k] = loc;
    __syncthreads();
    PA = SUMS[(d * 2) * 128 + k]; PB = SUMS[(d * 2 + 1) * 128 + k];
}
DI void stage_vt(const bf16_t* PROJT, int lt0, int h, bf16_t* VT, int tid) {
#pragma unroll
    for (int r = 0; r < 2; ++r) { const int idx = tid + 512 * r, v = idx >> 3, o = idx & 7;
        *(u32x4*)(VT + v * 72 + o * 8) = *(const u32x4*)(PROJT + (size_t)(TV + h * 128 + v) * HT + lt0 + o * 8); }
}

DI void scanA_hgrn(CParams& p, unsigned char* lds, int l, int hf, int c, int h) {
    const int tid = get_tid(), lane = tid & 63, wave = __builtin_amdgcn_readfirstlane(tid >> 6), l31 = lane & 31, lh = lane >> 5;
    const bf16_t* PROJT = (const bf16_t*)(p.ws + WS_PROJ);
    bf16_t* KH = (bf16_t*)lds;
    bf16_t* VT = (bf16_t*)(lds + 36864);
    float* SUMS = (float*)(lds + 55296);
    const int lt0 = c * 64;
    {
        const int d = tid >> 8, sh = (tid >> 7) & 1, k = tid & 127;
        const bf16_t* fp = PROJT + (size_t)(TF + d * 512 + h * 128 + k) * HT + lt0 + sh * 32;
        u32x4 raw[4];
#pragma unroll
        for (int j = 0; j < 4; ++j) raw[j] = *(const u32x4*)(fp + 8 * j);
        const float lb = ((const float*)(p.ws + WS_LB))[(l * 2 + d) * 512 + h * 128 + k];
        stage_vt(PROJT, lt0, h, VT, tid);
        float f[32], PA, PB; hgrn_gates(raw, lb, SUMS, d, sh, k, f, PA, PB);
        float val[32];
        if (d == 0) { float suf = sh ? 1.f : PB;
#pragma unroll
            for (int j = 31; j >= 0; --j) { val[j] = (1.f - f[j]) * suf; suf *= f[j]; } }
        else { float pre = sh ? PA : 1.f;
#pragma unroll
            for (int j = 0; j < 32; ++j) { val[j] = (1.f - f[j]) * pre; pre *= f[j]; } }
#pragma unroll
        for (int s8 = 0; s8 < 4; ++s8) *(u32x4*)(KH + (d * 128 + k) * 72 + sh * 32 + s8 * 8) = pack8(&val[s8 * 8]);
        if (sh == 0) { float* DEC = (float*)(p.ws + WS_DECA) + (size_t)((c * 4 + h) * 2 + d) * 256; DEC[k] = PA * PB; DEC[128 + k] = (d == 0) ? PA : PB; }
    }
    __syncthreads();
    {
        const int d = wave >> 2, vq = wave & 3;
        f32x16 acc[4];
#pragma unroll
        for (int i = 0; i < 4; ++i) acc[i] = zero16();
#pragma unroll
        for (int ks = 0; ks < 4; ++ks) { const bf16x8 b = *(const bf16x8*)(VT + (vq * 32 + l31) * 72 + ks * 16 + 8 * lh);
#pragma unroll
            for (int kb = 0; kb < 4; ++kb) { const bf16x8 a = *(const bf16x8*)(KH + (d * 128 + kb * 32 + l31) * 72 + ks * 16 + 8 * lh); acc[kb] = mfma32(a, b, acc[kb]); } }
        bf16_t* S = (bf16_t*)(p.ws + WS_SA) + (size_t)((c * 4 + h) * 2 + d) * 16384 + (size_t)(vq * 32 + l31) * 128;
#pragma unroll
        for (int kb = 0; kb < 4; ++kb)
#pragma unroll
            for (int g = 0; g < 4; ++g) { u32x2 w; w.x = pk2(acc[kb][4 * g], acc[kb][4 * g + 1]); w.y = pk2(acc[kb][4 * g + 2], acc[kb][4 * g + 3]);
                *(u32x2*)(S + kb * 32 + 8 * g + 4 * lh) = w; }
    }
    __syncthreads();
}

DI void ssd_dt(CParams& p, const bf16_t* PROJT, int l, int lt0, int head, int d, int lane, float& dt, float& a, float& ac, float& total) {
    const float raw = bf2f(PROJT[(size_t)(TDT + d * 16 + head) * HT + lt0 + lane]) + p.dt_bias[(l * 2 + d) * 16 + head];
    dt = raw > 20.f ? raw : log1pf(__expf(raw));
    a = -__expf(p.a_log[(l * 2 + d) * 16 + head]) * dt;
    ac = a;
#pragma unroll
    for (int o = 1; o < 64; o <<= 1) { const float t = __shfl_up(ac, o); if (lane >= o) ac += t; }
    total = __shfl(ac, 63);
}
constexpr int LDS_CW = 122880;
DI int cw_xcol(int g, int cl) { return cl < 256 ? g * 256 + cl : (cl < 320 ? 1024 + g * 64 + (cl - 256) : 1280 + g * 64 + (cl - 320)); }
DI void cw_fill(CParams& p, unsigned char* lds, int l, int g, int tid) {
    if (tid < 384) { const int xcol = cw_xcol(g, tid); f32x4 w; w[0] = p.conv_w[(l * 3 + 0) * 1536 + xcol]; w[1] = p.conv_w[(l * 3 + 1) * 1536 + xcol]; w[2] = p.conv_w[(l * 3 + 2) * 1536 + xcol]; w[3] = p.conv_b[l * 1536 + xcol];
        *(f32x4*)(lds + LDS_CW + tid * 16) = w; }
}
struct Conv8In { u32x4 cur; float xm, xn; };
DI Conv8In conv8_load(const bf16_t* PROJT, int lt0, int sg, int xcol, bool has_prev, bool has_next) {
    Conv8In r; const bf16_t* xp = PROJT + (size_t)(TX + xcol) * HT + lt0 + sg * 8;
    r.cur = *(const u32x4*)xp; r.xm = 0.f; r.xn = 0.f;
    if (sg == 0 && has_prev) r.xm = bf2f(xp[-1]);
    if (sg == 7 && has_next) r.xn = bf2f(xp[8]);
    return r;
}
DI void conv8_math(const Conv8In& r, int sg, const unsigned char* lds, int cl, float* y) {
    const unsigned pw = __shfl_up(r.cur.w, 1), nx = __shfl_down(r.cur.x, 1);
    const float xm = (sg == 0) ? r.xm : __uint_as_float(pw & 0xffff0000u);
    const float xn = (sg == 7) ? r.xn : __uint_as_float(nx << 16);
    const f32x4 w = *(const f32x4*)(lds + LDS_CW + cl * 16);
    float x[10]; x[0] = xm; unpack8(r.cur, &x[1]); x[9] = xn;
#pragma unroll
    for (int j = 0; j < 8; ++j) y[j] = silu(w[3] + w[0] * x[j] + w[1] * x[j + 1] + w[2] * x[j + 2]);
}

DI void scanA_ssd(CParams& p, unsigned char* lds, int l, int hf, int c, int g) {
    const int tid = get_tid(), lane = tid & 63, wave = __builtin_amdgcn_readfirstlane(tid >> 6), l31 = lane & 31, lh = lane >> 5;
    const bf16_t* PROJT = (const bf16_t*)(p.ws + WS_PROJ);
    bf16_t* XT = (bf16_t*)lds;
    bf16_t* BT = (bf16_t*)(lds + 36864);
    float* WS_ = (float*)(lds + 46080);
    const int lt0 = c * 64; bool hp, hn; chunk_halo(hf, c, hp, hn);
    Conv8In cin[5];
#pragma unroll
    for (int r = 0; r < 5; ++r) { const int it = tid + r * NTHR, cl = it >> 3, sg = it & 7; const int xcol = cl < 256 ? g * 256 + cl : 1024 + g * 64 + (cl - 256); cin[r] = conv8_load(PROJT, lt0, sg, xcol, hp, hn); }
    {
        const int hh = wave >> 1, d = wave & 1, head = g * 4 + hh; float dt, a, ac, total; ssd_dt(p, PROJT, l, lt0, head, d, lane, dt, a, ac, total);
        WS_[wave * 64 + lane] = ((d == 0) ? __expf(total - ac) : __expf(ac - a)) * dt;
        if (lane == 0) ((float*)(p.ws + WS_DECB))[(c * 16 + head) * 2 + d] = __expf(total);
    }
#pragma unroll
    for (int r = 0; r < 5; ++r) { const int it = tid + r * NTHR, cl = it >> 3, sg = it & 7; float y[8]; conv8_math(cin[r], sg, lds, cl, y);
        *(u32x4*)((cl < 256 ? XT + cl * 72 : BT + (cl - 256) * 72) + sg * 8) = pack8(y); }
    __syncthreads();
    {
        const int hh = wave >> 1, d = wave & 1, head = g * 4 + hh;
        f32x16 acc[2][2];
#pragma unroll
        for (int i = 0; i < 2; ++i)
#pragma unroll
            for (int j = 0; j < 2; ++j) acc[i][j] = zero16();
#pragma unroll
        for (int ks = 0; ks < 4; ++ks) { const f32x4 wa = *(const f32x4*)(WS_ + wave * 64 + ks * 16 + 8 * lh), wb = *(const f32x4*)(WS_ + wave * 64 + ks * 16 + 8 * lh + 4);
            bf16x8 bs[2];
#pragma unroll
            for (int ct = 0; ct < 2; ++ct) { const u32x4 r = *(const u32x4*)(XT + (hh * 64 + ct * 32 + l31) * 72 + ks * 16 + 8 * lh); u32x4 o;
                o.x = pk2(__uint_as_float(r.x << 16) * wa[0], __uint_as_float(r.x & 0xffff0000u) * wa[1]); o.y = pk2(__uint_as_float(r.y << 16) * wa[2], __uint_as_float(r.y & 0xffff0000u) * wa[3]);
                o.z = pk2(__uint_as_float(r.z << 16) * wb[0], __uint_as_float(r.z & 0xffff0000u) * wb[1]); o.w = pk2(__uint_as_float(r.w << 16) * wb[2], __uint_as_float(r.w & 0xffff0000u) * wb[3]);
                bs[ct] = __builtin_bit_cast(bf16x8, o); }
#pragma unroll
            for (int rt = 0; rt < 2; ++rt) { const bf16x8 a = *(const bf16x8*)(BT + (rt * 32 + l31) * 72 + ks * 16 + 8 * lh);
#pragma unroll
                for (int ct = 0; ct < 2; ++ct) acc[rt][ct] = mfma32(a, bs[ct], acc[rt][ct]); } }
        bf16_t* S = (bf16_t*)(p.ws + WS_SB) + (size_t)((c * 16 + head) * 2 + d) * 4096;
#pragma unroll
        for (int rt = 0; rt < 2; ++rt)
#pragma unroll
            for (int ct = 0; ct < 2; ++ct)
#pragma unroll
                for (int q = 0; q < 4; ++q) { u32x2 w; w.x = pk2(acc[rt][ct][4 * q], acc[rt][ct][4 * q + 1]); w.y = pk2(acc[rt][ct][4 * q + 2], acc[rt][ct][4 * q + 3]);
                    *(u32x2*)(S + (ct * 32 + l31) * 64 + rt * 32 + 8 * q + 4 * lh) = w; }
    }
    __syncthreads();
}
DI void phase_scanA(CParams& p, unsigned char* lds, int l, int hf, int bid, int nb, int rmode = 0) {
    int cwg = -1; const int tid0 = get_tid();
    for (int it = bid; it < 2 * NCH * 4; it += nb) { if (rmode == 1 && it < NCH * 4) continue; if (rmode == 2 && it >= NCH * 4) continue; if (it < NCH * 4) scanA_hgrn(p, lds, l, hf, it >> 2, it & 3);
        else { const int j = it - NCH * 4, g = j & 3; if (g != cwg) { __syncthreads(); cw_fill(p, lds, l, g, tid0); __syncthreads(); cwg = g; } scanA_ssd(p, lds, l, hf, j >> 2, g); } }
}

template <int NBAT> DI void scanB_hgrn_run(bf16_t* SA, const float* DECA, const SeqInfo& si, int h, int d, int v, int k4, float (&S)[4]) {
    for (int i0 = 0; i0 < si.nch; i0 += NBAT) { u32x2 raw[NBAT]; f32x4 dec[NBAT], em[NBAT]; bf16_t* sp[NBAT];
#pragma unroll
        for (int j = 0; j < NBAT; ++j) { const int i = i0 + j; const int c = si.first + (d == 0 ? i : si.nch - 1 - i); const size_t base = (size_t)((c * 4 + h) * 2 + d);
            sp[j] = SA + base * 16384 + v * 128 + k4; raw[j] = *(const u32x2*)sp[j]; dec[j] = *(const f32x4*)(DECA + base * 256 + k4); em[j] = *(const f32x4*)(DECA + base * 256 + 128 + k4); }
#pragma unroll
        for (int j = 0; j < NBAT; ++j) { u32x2 w; w.x = pk2(S[0] * em[j][0], S[1] * em[j][1]); w.y = pk2(S[2] * em[j][2], S[3] * em[j][3]); *(u32x2*)sp[j] = w;
            S[0] = dec[j][0] * S[0] + __uint_as_float(raw[j].x << 16); S[1] = dec[j][1] * S[1] + __uint_as_float(raw[j].x & 0xffff0000u);
            S[2] = dec[j][2] * S[2] + __uint_as_float(raw[j].y << 16); S[3] = dec[j][3] * S[3] + __uint_as_float(raw[j].y & 0xffff0000u); } }
}
template <int NBAT> DI void scanB_ssd_run(bf16_t* SB, const float* DECB, const SeqInfo& si, int head, int d, int pp, int n4, f32x4& S) {
    for (int i0 = 0; i0 < si.nch; i0 += NBAT) { u32x2 raw[NBAT]; float dec[NBAT]; bf16_t* sp[NBAT];
#pragma unroll
        for (int j = 0; j < NBAT; ++j) { const int i = i0 + j; const int c = si.first + (d == 0 ? i : si.nch - 1 - i); const size_t base = (size_t)((c * 16 + head) * 2 + d);
            sp[j] = SB + base * 4096 + pp * 64 + n4; raw[j] = *(const u32x2*)sp[j]; dec[j] = DECB[base]; }
#pragma unroll
        for (int j = 0; j < NBAT; ++j) { u32x2 w; w.x = pk2(S[0], S[1]); w.y = pk2(S[2], S[3]); *(u32x2*)sp[j] = w;
            S[0] = dec[j] * S[0] + __uint_as_float(raw[j].x << 16); S[1] = dec[j] * S[1] + __uint_as_float(raw[j].x & 0xffff0000u);
            S[2] = dec[j] * S[2] + __uint_as_float(raw[j].y << 16); S[3] = dec[j] * S[3] + __uint_as_float(raw[j].y & 0xffff0000u); } }
}
DI void phase_scanB(CParams& p, int l, int hf, int bid, int nb) {
    const int nseq = hf == 0 ? 33 : 3; const int total = nseq << 15;
    const int gt = bid * NTHR + get_tid(), gs = nb * NTHR;
    bf16_t* SA = (bf16_t*)(p.ws + WS_SA); const float* DECA = (const float*)(p.ws + WS_DECA);
    for (int it = gt; it < total; it += gs) {
        const int q = it & 4095, combo = (it >> 12) & 7, sq = it >> 15; const int h = combo >> 1, d = combo & 1; const int v = q >> 5, k4 = (q & 31) * 4;
        const SeqInfo si = seq_of(hf, sq);
        const float fz_ = __uint_as_float((unsigned)(gt >> 31)); float S[4] = {fz_, fz_, fz_, fz_};
        const size_t sidx = ((size_t)(((si.batch * 4 + l) * 2 + d) * 4 + h) * 128 + k4) * 128 + v;
        if (si.latent) {
#pragma unroll
            for (int j = 0; j < 4; ++j) S[j] = p.state_hgrn[sidx + (size_t)j * 128];
            scanB_hgrn_run<8>(SA, DECA, si, h, d, v, k4, S);
        } else {
            scanB_hgrn_run<4>(SA, DECA, si, h, d, v, k4, S);
#pragma unroll
            for (int j = 0; j < 4; ++j) p.out[OUT_SH + sidx + (size_t)j * 128] = S[j]; }
    }
    bf16_t* SB = (bf16_t*)(p.ws + WS_SB); const float* DECB = (const float*)(p.ws + WS_DECB);
    for (int it = gt; it < total; it += gs) {
        const int q = it & 1023, combo = (it >> 10) & 31, sq = it >> 15; const int head = combo >> 1, d = combo & 1; const int pp = q >> 4, n4 = (q & 15) * 4;
        const SeqInfo si = seq_of(hf, sq);
        const float fz_ = __uint_as_float((unsigned)(gt >> 31)); f32x4 S = {fz_, fz_, fz_, fz_};
        const size_t sidx = ((size_t)(((si.batch * 4 + l) * 2 + d) * 16 + head) * 64 + pp) * 64 + n4;
        if (si.latent) { S = *(const f32x4*)(p.state_ssd + sidx); scanB_ssd_run<8>(SB, DECB, si, head, d, pp, n4, S); }
        else { scanB_ssd_run<4>(SB, DECB, si, head, d, pp, n4, S); *(f32x4*)(p.out + OUT_SS + sidx) = S; }
    }
}

DI void scanC_hgrn(CParams& p, unsigned char* lds, int l, int hf, int c, int h) {
    const int tid = get_tid(), lane = tid & 63, wave = __builtin_amdgcn_readfirstlane(tid >> 6), l31 = lane & 31, lh = lane >> 5;
    const bf16_t* PROJT = (const bf16_t*)(p.ws + WS_PROJ);
    const bf16_t* PROJG = (const bf16_t*)(p.ws + WS_PROJG);
    bf16_t* QT = (bf16_t*)lds;
    bf16_t* KT = (bf16_t*)(lds + 34816);
    bf16_t* VT = (bf16_t*)(lds + 69632);
    bf16_t* PP = (bf16_t*)(lds + 88064);
    float* OO = (float*)(lds + 34816);
    float* SUMS = (float*)(lds + 106496);
    const int lt0 = c * 64;
    const int th = wave & 1, vq = wave >> 1;
    bf16x8 sfr[2][8];
    const int nt = tid >> 3, npart = tid & 7, nch0 = h * 128 + npart * 16;
    const bf16_t* gp = PROJG + (size_t)(lt0 + nt) * NG + G_GA + nch0; const u32x4 g0 = *(const u32x4*)gp, g1 = *(const u32x4*)(gp + 8);
    {
        const int d = tid >> 8, sh = (tid >> 7) & 1, k = tid & 127;
        const bf16_t* fp = PROJT + (size_t)(TF + d * 512 + h * 128 + k) * HT + lt0 + sh * 32;
        const bf16_t* qp = PROJT + (size_t)(TQ + h * 128 + k) * HT + lt0 + sh * 32;
        u32x4 raw[4], qraw[4];
#pragma unroll
        for (int j = 0; j < 4; ++j) { raw[j] = *(const u32x4*)(fp + 8 * j); qraw[j] = *(const u32x4*)(qp + 8 * j); }
        const float lb = ((const float*)(p.ws + WS_LB))[(l * 2 + d) * 512 + h * 128 + k];
        stage_vt(PROJT, lt0, h, VT, tid);
        float f[32], PA, PB; hgrn_gates(raw, lb, SUMS, d, sh, k, f, PA, PB);
        {
            const bf16_t* SA = (const bf16_t*)(p.ws + WS_SA);
#pragma unroll
            for (int dd = 0; dd < 2; ++dd)
#pragma unroll
                for (int ks = 0; ks < 8; ++ks) sfr[dd][ks] = *(const bf16x8*)(SA + (size_t)((c * 4 + h) * 2 + dd) * 16384 + (size_t)(vq * 32 + l31) * 128 + ks * 16 + 8 * lh);
        }
        float qv[32];
#pragma unroll
        for (int j8 = 0; j8 < 4; ++j8) unpack8(qraw[j8], &qv[8 * j8]);
        const float BIG = 5.5e34f;
        bf16_t* qd = QT + (d * 64 + sh * 32) * 136 + k; bf16_t* kd = KT + (d * 64 + sh * 32) * 136 + k;
        if (d == 0) {
            if (sh == 0) { float R = 1.f;
#pragma unroll
                for (int j = 31; j >= 0; --j) { qd[j * 136] = (bf16_t)f2bf(qv[j] * fminf(__builtin_amdgcn_rcpf(R), BIG)); kd[j * 136] = (bf16_t)f2bf((1.f - f[j]) * R); R *= f[j]; } }
            else { float P = 1.f;
#pragma unroll
                for (int j = 0; j < 32; ++j) { P *= f[j]; qd[j * 136] = (bf16_t)f2bf(qv[j] * P); kd[j * 136] = (bf16_t)f2bf((1.f - f[j]) * fminf(__builtin_amdgcn_rcpf(P), BIG)); } }
        } else {
            if (sh == 0) { float E = 1.f;
#pragma unroll
                for (int j = 31; j >= 0; --j) { E *= f[j]; qd[j * 136] = (bf16_t)f2bf(qv[j] * E); kd[j * 136] = (bf16_t)f2bf((1.f - f[j]) * fminf(__builtin_amdgcn_rcpf(E), BIG)); } }
            else { float G = 1.f;
#pragma unroll
                for (int j = 0; j < 32; ++j) { qd[j * 136] = (bf16_t)f2bf(qv[j] * fminf(__builtin_amdgcn_rcpf(G), BIG)); kd[j * 136] = (bf16_t)f2bf((1.f - f[j]) * G); G *= f[j]; } }
        }
    }
    __syncthreads();
    {
        const int d = wave >> 2, tr = (wave >> 1) & 1, tc = wave & 1; f32x16 acc = zero16();
#pragma unroll
        for (int ks = 0; ks < 8; ++ks) { const bf16x8 a = *(const bf16x8*)(QT + (d * 64 + tr * 32 + l31) * 136 + ks * 16 + 8 * lh), b = *(const bf16x8*)(KT + (d * 64 + tc * 32 + l31) * 136 + ks * 16 + 8 * lh); acc = mfma32(a, b, acc); }
        const int s = tc * 32 + l31;
#pragma unroll
        for (int i = 0; i < 16; ++i) { const int t = tr * 32 + 8 * (i >> 2) + 4 * lh + (i & 3); const bool keep = (d == 0) ? (t >= s) : (t <= s); PP[(d * 64 + t) * 72 + s] = (bf16_t)f2bf(keep ? acc[i] : 0.f); }
    }
    __syncthreads();
    {
        f32x16 acc = zero16();
#pragma unroll
        for (int d = 0; d < 2; ++d) {
#pragma unroll
            for (int ks = 0; ks < 4; ++ks) { const bf16x8 a = *(const bf16x8*)(PP + (d * 64 + th * 32 + l31) * 72 + ks * 16 + 8 * lh), b = *(const bf16x8*)(VT + (vq * 32 + l31) * 72 + ks * 16 + 8 * lh); acc = mfma32(a, b, acc); }
#pragma unroll
            for (int ks = 0; ks < 8; ++ks) { const bf16x8 a = *(const bf16x8*)(QT + (d * 64 + th * 32 + l31) * 136 + ks * 16 + 8 * lh); acc = mfma32(a, sfr[d][ks], acc); }
        }
#pragma unroll
        for (int i = 0; i < 16; ++i) { const int t = th * 32 + 8 * (i >> 2) + 4 * lh + (i & 3); OO[t * 132 + vq * 32 + l31] = acc[i]; }
    }
    __syncthreads();
    {
        const float* orow = OO + nt * 132 + npart * 16; float x[16]; float ss = 0.f;
#pragma unroll
        for (int j = 0; j < 4; ++j) { const f32x4 v4 = *(const f32x4*)(orow + 4 * j); x[4 * j] = v4[0]; x[4 * j + 1] = v4[1]; x[4 * j + 2] = v4[2]; x[4 * j + 3] = v4[3]; ss += (v4[0] * v4[0] + v4[1] * v4[1]) + (v4[2] * v4[2] + v4[3] * v4[3]); }
        ss += __shfl_xor(ss, 1); ss += __shfl_xor(ss, 2); ss += __shfl_xor(ss, 4);
        const float rstd = __builtin_amdgcn_rsqf(ss * (1.f / 128.f) + EPSN);
        const float* gn = p.a_norm + l * 512 + nch0;
        unsigned o[8];
#pragma unroll
        for (int q = 0; q < 8; ++q) { const unsigned gw = q < 4 ? g0[q & 3] : g1[q & 3];
            const float y0 = x[2 * q] * rstd * gn[2 * q] * __uint_as_float(gw << 16), y1 = x[2 * q + 1] * rstd * gn[2 * q + 1] * __uint_as_float(gw & 0xffff0000u); o[q] = pk2(y0, y1); }
        bf16_t* op = (bf16_t*)(p.ws + WS_OA) + (size_t)(lt0 + nt) * 1536 + nch0;
        *(u32x4*)op = (u32x4){o[0], o[1], o[2], o[3]}; *(u32x4*)(op + 8) = (u32x4){o[4], o[5], o[6], o[7]};
    }
    __syncthreads();
}

DI void scanC_ssd(CParams& p, unsigned char* lds, int l, int hf, int c, int g, int rmode = 0) {
    const int tid = get_tid(), lane = tid & 63, wave = __builtin_amdgcn_readfirstlane(tid >> 6), l31 = lane & 31, lh = lane >> 5;
    const bf16_t* PROJT = (const bf16_t*)(p.ws + WS_PROJ);
    const bf16_t* PROJG = (const bf16_t*)(p.ws + WS_PROJG);
    bf16_t* XT = (bf16_t*)lds;
    bf16_t* BM = (bf16_t*)(lds + 36864);
    bf16_t* CM = (bf16_t*)(lds + 46080);
    float* CB = (float*)(lds + 55296);
    float* ACUM = (float*)(lds + 72704);
    float* DTS = (float*)(lds + 74752);
    float* SSQ = (float*)(lds + 76800);
    float* EAC = (float*)(lds + 77824);
    const int lt0 = c * 64; bool hp, hn; chunk_halo(hf, c, hp, hn);
    const int hh = wave >> 1, th = wave & 1, head = g * 4 + hh;
    bf16x8 sfr[2][4];
    const bf16_t* SBp = (const bf16_t*)(p.ws + WS_SB) + (size_t)((c * 16 + head) * 2) * 4096 + l31 * 64 + 8 * lh;
#pragma unroll
    for (int ct = 0; ct < 2; ++ct)
#pragma unroll
        for (int ks = 0; ks < 4; ++ks) sfr[ct][ks] = *(const bf16x8*)(SBp + ct * 2048 + ks * 16);
    const int zt = tid >> 3, zpart = tid & 7;
    u32x4 zreg[4];
#pragma unroll
    for (int j = 0; j < 4; ++j) zreg[j] = *(const u32x4*)(PROJG + (size_t)(lt0 + zt) * NG + G_Z + g * 256 + zpart * 32 + 8 * j);
    bf16_t* ZT = (bf16_t*)(lds + 36864);
    bf16_t* YT = (bf16_t*)lds;
    Conv8In cin[6];
#ifdef PROBE_SSD
    if (rmode != 5)
#endif
    {
#pragma unroll
    for (int r = 0; r < 4; ++r) { const int it = tid + r * NTHR, cl = it >> 3, sg = it & 7; cin[r] = conv8_load(PROJT, lt0, sg, g * 256 + cl, hp, hn); }
#pragma unroll
    for (int r = 0; r < 2; ++r) { const int it = tid + r * NTHR, nn = it >> 3, sg = it & 7; const int isC = nn >> 6, n = nn & 63; cin[4 + r] = conv8_load(PROJT, lt0, sg, 1024 + isC * 256 + g * 64 + n, hp, hn); }
    }
    {
        const int d = wave & 1; float dt, a, ac, total; ssd_dt(p, PROJT, l, lt0, head, d, lane, dt, a, ac, total);
        const float av = (d == 0) ? ac : (total - ac + a); ACUM[wave * 64 + lane] = av; DTS[wave * 64 + lane] = dt; EAC[wave * 64 + lane] = __expf(av);
    }
#ifdef PROBE_SSD
    if (rmode != 5)
#endif
    {
#pragma unroll
    for (int r = 0; r < 4; ++r) { const int it = tid + r * NTHR, cl = it >> 3, sg = it & 7; float y[8]; conv8_math(cin[r], sg, lds, cl, y); *(u32x4*)(XT + cl * 72 + sg * 8) = pack8(y); }
#pragma unroll
    for (int r = 0; r < 2; ++r) { const int it = tid + r * NTHR, nn = it >> 3, sg = it & 7; const int isC = nn >> 6, n = nn & 63; float y[8]; conv8_math(cin[4 + r], sg, lds, 256 + nn, y);
        bf16_t* dst = (isC ? CM : BM) + (sg * 8) * 72 + n;
#pragma unroll
        for (int j = 0; j < 8; ++j) dst[j * 72] = (bf16_t)f2bf(y[j]); }
    }
    __syncthreads();
    if (wave < 4) { const int tr = wave >> 1, tc = wave & 1; f32x16 acc = zero16();
#pragma unroll
        for (int ks = 0; ks < 4; ++ks) { const bf16x8 a = *(const bf16x8*)(CM + (tr * 32 + l31) * 72 + ks * 16 + 8 * lh), b = *(const bf16x8*)(BM + (tc * 32 + l31) * 72 + ks * 16 + 8 * lh); acc = mfma32(a, b, acc); }
#pragma unroll
        for (int i = 0; i < 16; ++i) { const int t = tr * 32 + 8 * (i >> 2) + 4 * lh + (i & 3); CB[t * 68 + tc * 32 + l31] = acc[i]; }
    }
    __syncthreads();
    f32x16 acc[2]; acc[0] = zero16(); acc[1] = zero16();
    {
        const int t = th * 32 + l31;
#pragma unroll 1
        for (int d = 0; d < 2; ++d) { const int combo = hh * 2 + d;
#ifdef PROBE_SSD
            if (rmode == 4) break;
#endif
            bf16x8 nxt[2][4];
            if (d == 0) {
#pragma unroll
            for (int ct = 0; ct < 2; ++ct)
#pragma unroll
                for (int ks = 0; ks < 4; ++ks) nxt[ct][ks] = *(const bf16x8*)(SBp + 4096 + ct * 2048 + ks * 16);
            }
            const float at = ACUM[combo * 64 + t];
#pragma unroll
            for (int ks = 0; ks < 4; ++ks) { if ((d == 0 && th == 0 && ks >= 2) || (d == 1 && th == 1 && ks < 2)) continue;
                const int s0 = ks * 16 + 8 * lh; float m[8];
                const f32x4 c0 = *(const f32x4*)(CB + t * 68 + s0), c1 = *(const f32x4*)(CB + t * 68 + s0 + 4);
                const f32x4 a0 = *(const f32x4*)(ACUM + combo * 64 + s0), a1 = *(const f32x4*)(ACUM + combo * 64 + s0 + 4);
                const f32x4 d0 = *(const f32x4*)(DTS + combo * 64 + s0), d1 = *(const f32x4*)(DTS + combo * 64 + s0 + 4);
#pragma unroll
                for (int j = 0; j < 8; ++j) { const int s = s0 + j; const bool keep = (d == 0) ? (t >= s) : (t <= s); const float cbv = j < 4 ? c0[j & 3] : c1[j & 3], as = j < 4 ? a0[j & 3] : a1[j & 3], ds = j < 4 ? d0[j & 3] : d1[j & 3];
                    m[j] = keep ? cbv * __expf(fminf(at - as, 0.f)) * ds : 0.f; }
                u32x4 o; o.x = pk2(m[0], m[1]); o.y = pk2(m[2], m[3]); o.z = pk2(m[4], m[5]); o.w = pk2(m[6], m[7]); const bf16x8 a = __builtin_bit_cast(bf16x8, o);
#pragma unroll
                for (int ct = 0; ct < 2; ++ct) { const bf16x8 b = *(const bf16x8*)(XT + (hh * 64 + ct * 32 + l31) * 72 + s0); acc[ct] = mfma32(a, b, acc[ct]); } }
            f32x16 acc2[2]; acc2[0] = zero16(); acc2[1] = zero16();
#pragma unroll
            for (int ks = 0; ks < 4; ++ks) { const bf16x8 a = *(const bf16x8*)(CM + (th * 32 + l31) * 72 + ks * 16 + 8 * lh);
#pragma unroll
                for (int ct = 0; ct < 2; ++ct) acc2[ct] = mfma32(a, sfr[ct][ks], acc2[ct]); }
#pragma unroll
            for (int i = 0; i < 16; ++i) { const int ti = th * 32 + 8 * (i >> 2) + 4 * lh + (i & 3); const float sc = EAC[combo * 64 + ti]; acc[0][i] += sc * acc2[0][i]; acc[1][i] += sc * acc2[1][i]; }
#pragma unroll
            for (int ct = 0; ct < 2; ++ct)
#pragma unroll
                for (int ks = 0; ks < 4; ++ks) sfr[ct][ks] = nxt[ct][ks];
        }
    }
    __syncthreads();
#pragma unroll
    for (int j = 0; j < 4; ++j) *(u32x4*)(ZT + zt * 264 + zpart * 32 + 8 * j) = zreg[j];
    __syncthreads();
    {
        const float dsk = p.d_skip[l * 16 + head]; float part[16];
#pragma unroll
        for (int i = 0; i < 16; ++i) { const int ti = th * 32 + 8 * (i >> 2) + 4 * lh + (i & 3); float pt = 0.f;
#pragma unroll
            for (int ct = 0; ct < 2; ++ct) { const int pc = ct * 32 + l31; const float xv = bf2f(XT[(hh * 64 + pc) * 72 + ti]); const float z = bf2f(ZT[ti * 264 + hh * 64 + pc]);
                const float y = (acc[ct][i] + dsk * xv) * z;   acc[ct][i] = y; pt += y * y; }
            part[i] = pt; }
        const bool b4 = (l31 & 16) != 0, b3 = (l31 & 8) != 0, b2 = (l31 & 4) != 0, b1 = (l31 & 2) != 0;
        float p8[8], p4[4], p2[2], p1;
#pragma unroll
        for (int j = 0; j < 8; ++j) { const float snd = b4 ? part[j] : part[j + 8], kp = b4 ? part[j + 8] : part[j]; p8[j] = kp + __shfl_xor(snd, 16); }
#pragma unroll
        for (int j = 0; j < 4; ++j) { const float snd = b3 ? p8[j] : p8[j + 4], kp = b3 ? p8[j + 4] : p8[j]; p4[j] = kp + __shfl_xor(snd, 8); }
#pragma unroll
        for (int j = 0; j < 2; ++j) { const float snd = b2 ? p4[j] : p4[j + 2], kp = b2 ? p4[j + 2] : p4[j]; p2[j] = kp + __shfl_xor(snd, 4); }
        { const float snd = b1 ? p2[0] : p2[1], kp = b1 ? p2[1] : p2[0]; p1 = kp + __shfl_xor(snd, 2); }
        p1 += __shfl_xor(p1, 1);
        const int irow = l31 >> 1; const int tir = th * 32 + 8 * (irow >> 2) + 4 * lh + (irow & 3);
        if ((l31 & 1) == 0) SSQ[hh * 64 + tir] = p1;
    }
    __syncthreads();
    {
        const int irow = l31 >> 1; const int tir = th * 32 + 8 * (irow >> 2) + 4 * lh + (irow & 3);
        const float myr = __builtin_amdgcn_rsqf(((SSQ[tir] + SSQ[64 + tir]) + (SSQ[128 + tir] + SSQ[192 + tir])) * (1.f / 256.f) + EPSN);
        const float gn0 = p.b_norm[l * 1024 + g * 256 + hh * 64 + l31], gn1 = p.b_norm[l * 1024 + g * 256 + hh * 64 + 32 + l31];
#pragma unroll
        for (int i = 0; i < 16; ++i) { const int ti = th * 32 + 8 * (i >> 2) + 4 * lh + (i & 3); const float rstd = __shfl(myr, lh * 32 + 2 * i);
            YT[ti * 264 + hh * 64 + l31] = (bf16_t)f2bf(acc[0][i] * rstd * gn0); YT[ti * 264 + hh * 64 + 32 + l31] = (bf16_t)f2bf(acc[1][i] * rstd * gn1); }
    }
    __syncthreads();
    {
        bf16_t* YB = (bf16_t*)(p.ws + WS_OA) + (size_t)(lt0 + zt) * 1536 + 512 + g * 256 + zpart * 32;
#pragma unroll
        for (int j = 0; j < 4; ++j) {
#ifdef PROBE_SSD
            if (rmode >= 3) break;
#endif
            *(u32x4*)(YB + 8 * j) = *(const u32x4*)(YT + zt * 264 + zpart * 32 + 8 * j); }
    }
    __syncthreads();
}
DI void phase_scanC(CParams& p, unsigned char* lds, int l, int hf, int bid, int nb, int rmode = 0) {
    int cwg = -1; const int tid0 = get_tid();
    for (int it = bid; it < 2 * NCH * 4; it += nb) {
        if ((rmode == 1 || rmode >= 3) && it < NCH * 4) continue; if (rmode == 2 && it >= NCH * 4) continue;
#ifndef NO_C_HGRN
        if (it < NCH * 4) scanC_hgrn(p, lds, l, hf, it >> 2, it & 3);
#endif
#ifndef NO_C_SSD
        if (it >= NCH * 4) { const int j = it - NCH * 4, g = j & 3; if (g != cwg) { __syncthreads(); cw_fill(p, lds, l, g, tid0); __syncthreads(); cwg = g; } scanC_ssd(p, lds, l, hf, j >> 2, g, rmode); }
#endif
    }
}

template <class Epi> DI void run_gemm(unsigned char* lds, const bf16_t* A, const bf16_t* Bt, int M, int N, int K, const Epi& E, int bid, int nb) {
    asm volatile("" : "+s"(N), "+s"(K), "+s"(M));
    pg8::Gemm g{A, Bt, M, N, K}; pg8::StaticOrder S; S.init(M, N, nb, bid);
    pg8::gemm_phase<Epi, pg8::StaticOrder, false>((PG8_LAS unsigned char*)lds, g, S, E, nullptr);
    __syncthreads();
}

DI void run_phase(CParams& p, unsigned char* lds, int ph, int bid, int nb, int rmode = 0) {
    unsigned char* ws = p.ws;
    if (ph == 0) { phase_init(p, lds, bid, nb); __syncthreads(); phase_wconv(p, lds, 0, bid, nb, 0, WC_NIT); return; }
    if (ph == 89) { phase_final_norm(p, bid, nb); return; }
    const int q = ph - 1; const int lh2 = q / 11, sub = q % 11; const int l = lh2 >> 1, hf = lh2 & 1;
    const float* MODL = (const float*)(ws + WS_MOD) + (size_t)l * 5 * 6144;
    const unsigned char* wl = ws + ((l & 1) ? WS_W2OFS : 0);
#ifndef PH_MASK
#define PH_MASK 0xFFFF
#endif
#define PH_ON(i) ((PH_MASK >> (i)) & 1)
    switch (sub) {
    case 0: if (PH_ON(0)) { if (hf == 0 && l == 0) phase_norm(p, 0, 0, 0, bid, nb); } break;
    case 1: if (PH_ON(1)) { pg8::EpiBf16Act E1{(bf16_t*)(ws + WS_PROJ), HT, 2, 0, 9999}; run_gemm(lds, (const bf16_t*)(wl + WS_WIN), (const bf16_t*)(ws + WS_U), NTROW, HT, 1024, E1, bid, nb);
              pg8::EpiBf16Act E2{(bf16_t*)(ws + WS_PROJG), NG, 0, 6, 6}; run_gemm(lds, (const bf16_t*)(ws + WS_U), (const bf16_t*)(wl + WS_WIN) + (size_t)NTROW * 1024, HT, NG, 1024, E2, bid, nb); } break;
    case 2: if (PH_ON(2)) phase_scanA(p, lds, l, hf, bid, nb, rmode); break;
    case 3: if (PH_ON(3)) phase_scanB(p, l, hf, bid, nb); break;
    case 4: if (PH_ON(4)) phase_scanC(p, lds, l, hf, bid, nb, rmode); break;
    case 5: if (PH_ON(5)) { wconv_side(p, lds, l, hf, bid, nb, 0, 3700); pg8::EpiGateMerge E{(bf16_t*)(ws + WS_U), (const bf16_t*)(ws + WS_PROJG), NG, G_GATE, G_GATE + 1024};
              run_gemm(lds, (const bf16_t*)(ws + WS_OA), (const bf16_t*)(wl + WS_WBRA), HT, 1024, 1536, E, bid, nb); } break;
    case 6: if (PH_ON(6)) { wconv_side(p, lds, l, hf, bid, nb, 3700, 5400); pg8::EpiResid E{p.out, MODL + 2048, hf * HT, l == 0 ? p.x_prompt : nullptr, l == 0 ? p.x_sample : nullptr}; run_gemm(lds, (const bf16_t*)(ws + WS_U), (const bf16_t*)(wl + WS_WOUT), HT, 1024, 1024, E, bid, nb); } break;
    case 7: if (PH_ON(7)) phase_norm(p, l, hf, 1, bid, nb); break;
    case 8: if (PH_ON(8)) { pg8::EpiBf16<0> E{(bf16_t*)(ws + WS_PROJ), NUP, nullptr, 0, 0}; run_gemm(lds, (const bf16_t*)(ws + WS_U), (const bf16_t*)(wl + WS_WUP), HT, NUP, 1024, E, bid, nb); } break;
    case 9: if (PH_ON(9)) phase_convact(p, l, hf, bid, nb); break;
    case 10: if (PH_ON(10)) { wconv_side(p, lds, l, hf, bid, nb, 5400, WC_NIT); pg8::EpiResid E{p.out, MODL + 5120, hf * HT, nullptr, nullptr}; run_gemm(lds, (const bf16_t*)(ws + WS_SA), (const bf16_t*)(wl + WS_WDN), HT, 1024, DFF, E, bid, nb);
               if (lh2 < 7) phase_norm(p, (lh2 + 1) >> 1, (lh2 + 1) & 1, 0, bid, nb); } break;
    }
}
constexpr int NPHASE = 90;

#define LAS __attribute__((address_space(3)))
#define XB_TMO      128
#define XB_XCNT(j)  (256  + 64 * (j))
#define XB_XSUB(j)  (1280 + 64 * (j))
#define XB_XGEN(j)  (2304 + 64 * (j))
#define XB_TOP      3328
#define XB_TOPGEN   3392
#define XCD_BAR_WORDS 3456
#define XB_SPIN_CAP (1u << 18)

__device__ __forceinline__ unsigned xb_ld(unsigned* p)              { return __hip_atomic_load(p, __ATOMIC_RELAXED, __HIP_MEMORY_SCOPE_AGENT); }
__device__ __forceinline__ unsigned xb_add(unsigned* p, unsigned v) { return __hip_atomic_fetch_add(p, v, __ATOMIC_RELAXED, __HIP_MEMORY_SCOPE_AGENT); }
__device__ __forceinline__ unsigned xb_xcc_id() { return (unsigned)__builtin_amdgcn_s_getreg((3 << 11) | 20) & 0xFu; }
#define XB_SPIN(cond, bar) do { unsigned _sp = 0; while (cond) { __builtin_amdgcn_s_sleep(1); \
    if ((++_sp & 255u) == 0u) { if (xb_ld(&(bar)[XB_TMO])) break; if (_sp > XB_SPIN_CAP) { atomicAdd(&(bar)[XB_TMO], 1u); break; } } } } while (0)

struct XcdBarrier {
    unsigned* bar; unsigned x;
    volatile LAS unsigned* st;
};

__device__ __forceinline__ XcdBarrier xcd_barrier_post(unsigned* bar, volatile LAS unsigned* st) {
    XcdBarrier b; b.bar = bar; b.x = xb_xcc_id(); b.st = st;
    if (threadIdx.x == 0) (void)xb_add(&bar[XB_XCNT(b.x)], 1u);
    return b;
}
__device__ __forceinline__ void xcd_barrier_complete(unsigned* bar, unsigned x, unsigned& nloc, unsigned& nx) {
    const unsigned G = gridDim.x * gridDim.y * gridDim.z;
    unsigned sum, cnt, mine, sp = 0u;
    for (;;) {
        sum = 0u; cnt = 0u; mine = 0u;
#pragma unroll
        for (unsigned j = 0; j < 16; ++j) { const unsigned c = xb_ld(&bar[XB_XCNT(j)]); sum += c; cnt += (c > 0u) ? 1u : 0u; mine = (j == x) ? c : mine; }
        if (sum == G) break;
        __builtin_amdgcn_s_sleep(1);
        if ((++sp & 255u) == 0u) { if (xb_ld(&bar[XB_TMO])) break; if (sp > XB_SPIN_CAP) { atomicAdd(&bar[XB_TMO], 1u); break; } }
    }
    nloc = mine > 0u ? mine : 1u; nx = cnt > 0u ? cnt : 1u;
}

__device__ __forceinline__ void xcd_barrier(const XcdBarrier& b) {
    asm volatile("s_waitcnt vmcnt(0)" ::: "memory");
    __syncthreads();
    if (threadIdx.x == 0) {
        unsigned* bar = b.bar;
        __builtin_amdgcn_s_waitcnt(0);
        unsigned nloc = b.st[0], nx = b.st[1];
        if (nloc == 0u) { xcd_barrier_complete(bar, b.x, nloc, nx); b.st[0] = nloc; b.st[1] = nx; }
        const unsigned old = xb_add(&bar[XB_XSUB(b.x)], 1u);
        const unsigned gen = old / nloc;
        if (old + 1u == (gen + 1u) * nloc) {
            __builtin_amdgcn_fence(__ATOMIC_RELEASE, "agent");
            asm volatile("s_waitcnt vmcnt(0)" ::: "memory");
            const unsigned og = xb_add(&bar[XB_TOP], 1u);
            const unsigned tg = og / nx;
            if (og + 1u == (tg + 1u) * nx) xb_add(&bar[XB_TOPGEN], 1u);
            else XB_SPIN(xb_ld(&bar[XB_TOPGEN]) == tg, bar);
            __builtin_amdgcn_fence(__ATOMIC_ACQUIRE, "agent");
            xb_add(&bar[XB_XGEN(b.x)], 1u);
            asm volatile("s_waitcnt vmcnt(0)" ::: "memory");
        } else {
            XB_SPIN(xb_ld(&bar[XB_XGEN(b.x)]) == gen, bar);
            __builtin_amdgcn_fence(__ATOMIC_ACQUIRE, "agent");
            asm volatile("s_waitcnt vmcnt(0)" ::: "memory");
        }
    }
    __syncthreads();
}

constexpr size_t WS_BAR = 3 * MiB + 512 * 1024;
__global__ void __launch_bounds__(512, 2) mega_fwd(Params p_unused) {
    extern __shared__ __attribute__((aligned(16))) unsigned char lds[];
    const int bid = blockIdx.x, nb = gridDim.x;
    CParams* pk = (CParams*)__builtin_amdgcn_kernarg_segment_ptr();
    volatile LAS unsigned* st = (volatile LAS unsigned*)((LAS unsigned char*)lds + 131072);
    if (threadIdx.x == 0) { st[0] = 0u; st[1] = 0u; }
    __syncthreads();
    unsigned* barw = (unsigned*)(pk->ws + WS_BAR);
    if (bid == 0) { for (int i = threadIdx.x; i < XCD_BAR_WORDS; i += NTHR) barw[i] = 0u; }
    {
        CParams* q = pk; asm volatile("" : "+s"(q));
        run_phase(*q, lds, 0, bid, nb);
    }
    cg::this_grid().sync();
    (void)xcd_barrier_post(barw, st);
    for (int ph = 1; ph < NPHASE; ++ph) {
        if (ph > 1 && ph < 89 && (ph - 1) % 11 == 0) continue;
        CParams* q = pk; int z_ = 0, b_ = bid, n_ = nb; asm volatile("" : "+s"(q), "+s"(z_), "+s"(b_), "+s"(n_));
        run_phase(*q, lds + z_, ph, b_, n_);
#ifndef RPT_MODE
#define RPT_MODE 0
#endif
#ifdef RPT_MASK
        if (ph < 89 && ((RPT_MASK >> ((ph - 1) % 11)) & 1)) { { XcdBarrier xb; xb.bar = (unsigned*)(q->ws + WS_BAR); xb.x = xb_xcc_id(); xb.st = st; xcd_barrier(xb); }
            CParams* q2 = pk; int z2_ = 0, b2_ = bid, n2_ = nb; asm volatile("" : "+s"(q2), "+s"(z2_), "+s"(b2_), "+s"(n2_)); run_phase(*q2, lds + z2_, ph, b2_, n2_, RPT_MODE); }
#endif
#ifdef RPT_AB
        if (ph < 89 && ((ph - 1) % 11) == 3) { for (int rr = 0; rr < 2; ++rr) { { XcdBarrier xb; xb.bar = (unsigned*)(q->ws + WS_BAR); xb.x = xb_xcc_id(); xb.st = st; xcd_barrier(xb); }
            CParams* q2 = pk; int z2_ = 0, b2_ = bid, n2_ = nb; asm volatile("" : "+s"(q2), "+s"(z2_), "+s"(b2_), "+s"(n2_)); run_phase(*q2, lds + z2_, ph - 1 + rr, b2_, n2_, 0); } }
#endif
        if (ph + 1 < NPHASE) { XcdBarrier xb; xb.bar = (unsigned*)(q->ws + WS_BAR); xb.x = xb_xcc_id(); xb.st = st; xcd_barrier(xb); }
    }
}

constexpr int LDS_BYTES = 131072 + 256;
extern "C" void kernel_launch(void* const* d_in, const int* in_sizes, int n_in, void* d_out, int out_size, void* d_ws, size_t ws_size, hipStream_t stream) {
    static int grid = 0;
    if (grid == 0) {
        if (n_in != 27 || ws_size < WS_END) { fprintf(stderr, "kernel_launch: unexpected n_in %d / ws_size %zu\n", n_in, ws_size); grid = -1; return; }
        int dev = 0, cus = 0, per_cu = 0;
        hipGetDevice(&dev); hipDeviceGetAttribute(&cus, hipDeviceAttributeMultiprocessorCount, dev);
        if (hipFuncSetAttribute((const void*)mega_fwd, hipFuncAttributeMaxDynamicSharedMemorySize, LDS_BYTES) != hipSuccess) { fprintf(stderr, "hipFuncSetAttribute failed\n"); grid = -1; return; }
        if (hipOccupancyMaxActiveBlocksPerMultiprocessor(&per_cu, (const void*)mega_fwd, 512, LDS_BYTES) != hipSuccess || per_cu < 1) { fprintf(stderr, "occupancy query: %d\n", per_cu); per_cu = 1; }
        (void)hipGetLastError();
        grid = cus * 1;
    }
    if (grid < 0) return;
    Params p{};
    const float** pp = (const float**)&p;
    for (int i = 0; i < 27; ++i) pp[i] = (const float*)d_in[i];
    p.out = (float*)d_out; p.ws = (unsigned char*)d_ws;
    p.ph_lo = 0; p.ph_hi = NPHASE;
    void* args[] = {&p};
    hipError_t e = hipLaunchCooperativeKernel((const void*)mega_fwd, dim3(grid), dim3(512), args, LDS_BYTES, stream);
    if (e != hipSuccess) fprintf(stderr, "cooperative launch failed: %s (grid %d)\n", hipGetErrorString(e), grid);
}
```

```cpp
#include <hip/hip_runtime.h>
#include <hip/hip_cooperative_groups.h>
#include <cstdio>
namespace cg = cooperative_groups;
#define MULTI 0
namespace pg8 {
#define PG8_LAS __attribute__((address_space(3)))
typedef unsigned short bf16_t;
typedef short bf16x8 __attribute__((ext_vector_type(8)));
typedef float f32x4 __attribute__((ext_vector_type(4)));
typedef unsigned u32x4 __attribute__((ext_vector_type(4)));
constexpr int BM = 256, BK = 64, HALF = 128, HTB = HALF * BK * 2  , STAGE_BYTES = 8 * HTB, NXCD = 8, WGM = 8;

__host__ __device__ __forceinline__ int lds_byte(int r, int c) { const int st = (r >> 4) * 2 + (c >> 5), rr = r & 15, cc = c & 31, ob = rr * 64 + cc * 2; return st * 1024 + (ob ^ (((ob >> 9) & 1) << 5)); }
__host__ __device__ __forceinline__ void stage_rc(int b, int& R, int& C) { const int st = b / 1024, sb = b % 1024, swz = sb ^ (((sb >> 9) & 1) << 5); R = (st >> 1) * 16 + swz / 64; C = (st & 1) * 32 + (swz % 64) / 2; }
__host__ __device__ __forceinline__ int perm32(int rho) { const int n = rho >> 4, i = rho & 15; return 8 * (i >> 2) + 4 * n + (i & 3); }

struct Unit { int pm, pn; };
struct Gemm { const bf16_t* A; const bf16_t* Bt; int M, N, K; };

struct StaticOrder {
    int nM, nN, nwg, G, c;
    __host__ __device__ void init(int M, int N, int G_, int c_) { nM = M / BM; nN = N / BM; nwg = nM * nN; G = G_; c = c_; }
    __host__ __device__ bool next(int i, Unit& u) const {
        const long L = (long)i * G + c; if (L >= nwg) return false;
        int wgid = (int)L; { const int q = nwg / NXCD, r = nwg % NXCD, xcd = wgid % NXCD, off = wgid / NXCD; wgid = (xcd < r ? xcd * (q + 1) : r * (q + 1) + (xcd - r) * q) + off; }
        const int nig = WGM * nN, gid = wgid / nig, fm = gid * WGM, gsz = (nM - fm) < WGM ? (nM - fm) : WGM;
        u.pm = fm + ((wgid % nig) % gsz); u.pn = (wgid % nig) / gsz; return true;
    }
    __device__ __forceinline__ void a_ready(const Unit&) const {}
    __device__ __forceinline__ void done(const Unit&) const {}
};
__device__ __forceinline__ unsigned cvt_pk_bf16(float lo, float hi) { unsigned r; asm volatile("v_cvt_pk_bf16_f32 %0, %1, %2" : "=v"(r) : "v"(lo), "v"(hi)); return r; }
typedef float f32x2 __attribute__((ext_vector_type(2)));
__device__ __forceinline__ f32x2 gelu_pk(f32x2 v) {
    const f32x2 av = __builtin_elementwise_abs(v), d = av * 0.2316418882f + 1.0f;
    f32x2 t; t.x = __builtin_amdgcn_rcpf(d.x); t.y = __builtin_amdgcn_rcpf(d.y);
    f32x2 q = t * 0.5307027145f + (-0.7265760135f); q = q * t + 0.7107068705f; q = q * t + (-0.142248368f); q = q * t + 0.127414796f; q = q * t;
    const f32x2 s = (v * v) * (-0.72134752044f);
    f32x2 e; e.x = __builtin_amdgcn_exp2f(s.x); e.y = __builtin_amdgcn_exp2f(s.y);
    const f32x2 m = v * (q * e), r = v - m;
    f32x2 o; o.x = v.x < 0.f ? m.x : r.x; o.y = v.y < 0.f ? m.y : r.y; return o;
}
template <int ACT  > struct EpiBf16 {
    static constexpr bool PERM = true, AFTER_DRAIN = false; static constexpr int TMID = -1;
    bf16_t* O; int ldc; const float* bias; int split_cols; size_t split_stride;
    __device__ __forceinline__ void operator()(const f32x4 (&acc)[2][2][4][2], const Unit& u, int wr, int wc, int fr, int fq) const {
        const int row0 = u.pm * BM + wr * 64 + fr; int colt = u.pn * BM; bf16_t* base = O;
        if (split_cols) { const int t = colt / split_cols; base += (size_t)t * split_stride; colt -= t * split_cols; }
        const int col0 = colt + wc * 32 + 8 * fq, bcol0 = u.pn * BM + wc * 32 + 8 * fq;
        f32x4 bv[2][2];
#pragma unroll
        for (int bj = 0; bj < 2; ++bj)
#pragma unroll
            for (int n = 0; n < 2; ++n) bv[bj][n] = bias ? *(const f32x4*)(bias + bcol0 + bj * HALF + 4 * n) : (f32x4){0.f, 0.f, 0.f, 0.f};
#pragma unroll
        for (int ai = 0; ai < 2; ++ai)
#pragma unroll
            for (int m = 0; m < 4; ++m) { bf16_t* rowp = base + (size_t)(row0 + ai * HALF + m * 16) * ldc + col0;
#pragma unroll
                for (int bj = 0; bj < 2; ++bj) { f32x4 v0 = acc[ai][bj][m][0] + bv[bj][0], v1 = acc[ai][bj][m][1] + bv[bj][1];
                    if (ACT == 1) { f32x2 a = gelu_pk((f32x2){v0[0], v0[1]}), b = gelu_pk((f32x2){v0[2], v0[3]}), c = gelu_pk((f32x2){v1[0], v1[1]}), d = gelu_pk((f32x2){v1[2], v1[3]});
                        v0 = (f32x4){a.x, a.y, b.x, b.y}; v1 = (f32x4){c.x, c.y, d.x, d.y}; }
                    if (ACT == 2) {
#pragma unroll
                        for (int j = 0; j < 4; ++j) { v0[j] = 0.5f * v0[j] * (1.0f + erff(v0[j] * 0.70710678f)); v1[j] = 0.5f * v1[j] * (1.0f + erff(v1[j] * 0.70710678f)); } }
                    u32x4 w; w.x = cvt_pk_bf16(v0[0], v0[1]); w.y = cvt_pk_bf16(v0[2], v0[3]); w.z = cvt_pk_bf16(v1[0], v1[1]); w.w = cvt_pk_bf16(v1[2], v1[3]);
                    *(u32x4*)(rowp + bj * HALF) = w; } }
    }
};
__device__ __forceinline__ float epi_bf2f(unsigned short b) { return __uint_as_float(((unsigned)b) << 16); }
__device__ __forceinline__ float epi_sigmoid(float x) { return __builtin_amdgcn_rcpf(1.f + __expf(-x)); }
typedef unsigned u32x2 __attribute__((ext_vector_type(2)));
struct EpiBf16Act {
    static constexpr bool PERM = true, AFTER_DRAIN = false; static constexpr int TMID = -1;
    bf16_t* O; int ldc; int silu_pm_lt, silu_pn_lt, sig_pn_ge;
    __device__ __forceinline__ void operator()(const f32x4 (&acc)[2][2][4][2], const Unit& u, int wr, int wc, int fr, int fq) const {
        const int row0 = u.pm * BM + wr * 64 + fr, col0 = u.pn * BM + wc * 32 + 8 * fq;
        int act = 0; if (u.pm < silu_pm_lt) act = 1; if (u.pn < silu_pn_lt) act = 1; else if (u.pn >= sig_pn_ge) act = 2;
#pragma unroll
        for (int ai = 0; ai < 2; ++ai)
#pragma unroll
            for (int m = 0; m < 4; ++m) { bf16_t* rowp = O + (size_t)(row0 + ai * HALF + m * 16) * ldc + col0;
#pragma unroll
                for (int bj = 0; bj < 2; ++bj) { f32x4 v0 = acc[ai][bj][m][0], v1 = acc[ai][bj][m][1];
                    if (act) {
#pragma unroll
                        for (int j = 0; j < 4; ++j) { const float s0 = __builtin_amdgcn_rcpf(1.f + __expf(-v0[j])), s1 = __builtin_amdgcn_rcpf(1.f + __expf(-v1[j]));
                            v0[j] = (act == 1) ? v0[j] * s0 : s0; v1[j] = (act == 1) ? v1[j] * s1 : s1; } }
                    u32x4 w; w.x = cvt_pk_bf16(v0[0], v0[1]); w.y = cvt_pk_bf16(v0[2], v0[3]); w.z = cvt_pk_bf16(v1[0], v1[1]); w.w = cvt_pk_bf16(v1[2], v1[3]);
                    *(u32x4*)(rowp + bj * HALF) = w; } }
    }
};
struct EpiGateMerge {
    static constexpr bool PERM = false, AFTER_DRAIN = false; static constexpr int TMID = 8;
    bf16_t* O; const bf16_t* G; int ldg; int goffA, goffB;
    __device__ __forceinline__ void mid(f32x4 (&acc)[2][2][4][2], const Unit& u, int wr, int wc, int fr, int fq) const {
        int row0 = u.pm * BM + wr * 64 + fr, col0 = u.pn * BM + wc * 32 + 4 * fq;
        asm volatile("" : "+v"(row0), "+v"(col0));
#pragma unroll
        for (int ai = 0; ai < 2; ++ai)
#pragma unroll
            for (int m = 0; m < 4; ++m) { const int row = row0 + ai * HALF + m * 16; const bf16_t* gp = G + (size_t)row * ldg + col0;
#pragma unroll
                for (int bj = 0; bj < 2; ++bj)
#pragma unroll
                    for (int n = 0; n < 2; ++n) { const u32x2 ga = *(const u32x2*)(gp + goffA + bj * HALF + n * 16), gb = *(const u32x2*)(gp + goffB + bj * HALF + n * 16);
                        const float a0 = __uint_as_float(ga.x << 16), a1 = __uint_as_float(ga.x & 0xffff0000u), a2 = __uint_as_float(ga.y << 16), a3 = __uint_as_float(ga.y & 0xffff0000u);
                        const float b0 = __uint_as_float(gb.x << 16), b1 = __uint_as_float(gb.x & 0xffff0000u), b2 = __uint_as_float(gb.y << 16), b3 = __uint_as_float(gb.y & 0xffff0000u);
                        f32x4 r; r[0] = a0 * __builtin_amdgcn_rcpf(b0); r[1] = a1 * __builtin_amdgcn_rcpf(b1); r[2] = a2 * __builtin_amdgcn_rcpf(b2); r[3] = a3 * __builtin_amdgcn_rcpf(b3);
                        acc[ai][bj][m][n] = acc[ai][bj][m][n] * r; }
                asm volatile("" ::: "memory"); }
    }
    __device__ __forceinline__ void operator()(const f32x4 (&acc)[2][2][4][2], const Unit& u, int wr, int wc, int fr, int fq) const {
        const int row0 = u.pm * BM + wr * 64 + fr, col0 = u.pn * BM + wc * 32 + 4 * fq;
#pragma unroll
        for (int ai = 0; ai < 2; ++ai)
#pragma unroll
            for (int m = 0; m < 4; ++m) { const int row = row0 + ai * HALF + m * 16; bf16_t* op = O + (size_t)row * 1024 + col0; const bf16_t* gp = G + (size_t)row * ldg + goffB + col0;
#pragma unroll
                for (int bj = 0; bj < 2; ++bj)
#pragma unroll
                    for (int n = 0; n < 2; ++n) { const u32x2 gw = *(const u32x2*)(gp + bj * HALF + n * 16); const f32x4 a = acc[ai][bj][m][n]; f32x4 o;
                        o[0] = a[0] * __uint_as_float(gw.x << 16); o[1] = a[1] * __uint_as_float(gw.x & 0xffff0000u);
                        o[2] = a[2] * __uint_as_float(gw.y << 16); o[3] = a[3] * __uint_as_float(gw.y & 0xffff0000u);
                        u32x2 w; w.x = cvt_pk_bf16(o[0], o[1]); w.y = cvt_pk_bf16(o[2], o[3]);
                        *(u32x2*)(op + bj * HALF + n * 16) = w; } }
    }
};
struct EpiResid {
    static constexpr bool PERM = false, AFTER_DRAIN = false; static constexpr int TMID = -1;
    float* X; const float* MODG; int rowbase; const float* Xp; const float* Xs;
    __device__ __forceinline__ void operator()(const f32x4 (&acc)[2][2][4][2], const Unit& u, int wr, int wc, int fr, int fq) const {
        const int row0 = rowbase + u.pm * BM + wr * 64 + fr, col0 = u.pn * BM + wc * 32 + 4 * fq;
        const int tok0 = rowbase + u.pm * BM; const int grp = tok0 < 8192 ? 0 : 1 + ((tok0 - 8192) >> 12);
        const float* src = Xp ? (tok0 < 8192 ? Xp : Xs - (size_t)8192 * 1024) : X;
        const float* gv = MODG + (size_t)grp * 6144 + col0;
        f32x4 g[2][2];
#pragma unroll
        for (int bj = 0; bj < 2; ++bj)
#pragma unroll
            for (int n = 0; n < 2; ++n) g[bj][n] = *(const f32x4*)(gv + bj * HALF + n * 16);
#pragma unroll
        for (int ai = 0; ai < 2; ++ai)
#pragma unroll
            for (int m = 0; m < 4; ++m) { float* rowp = X + (size_t)(row0 + ai * HALF + m * 16) * 1024 + col0; const float* srcp = src + (size_t)(row0 + ai * HALF + m * 16) * 1024 + col0;
#pragma unroll
                for (int bj = 0; bj < 2; ++bj)
#pragma unroll
                    for (int n = 0; n < 2; ++n) { f32x4 x = *(const f32x4*)(srcp + bj * HALF + n * 16); x = x + g[bj][n] * acc[ai][bj][m][n]; *(f32x4*)(rowp + bj * HALF + n * 16) = x; } }
    }
};
template <class Epi, class Sched, bool STAMP = false>
__device__ __forceinline__ void gemm_phase(PG8_LAS unsigned char* lds, const Gemm g, const Sched& S, const Epi& E, unsigned long long* stamps) {
    int tid_l = threadIdx.x; asm volatile("" : "+v"(tid_l)); const int tid = tid_l, wid = __builtin_amdgcn_readfirstlane(tid >> 6), lane = tid & 63, wr = wid >> 2, wc = wid & 3, fr = lane & 15, fq = lane >> 4;
    const int K = g.K, nt = K / BK;
    int ts_lo = 0, ts_hi = 0, nts = 0; const unsigned long long rt_entry = STAMP ? (unsigned long long)wall_clock64() : 0ull;
#define PG8_STAMP() do { if (STAMP && wid == 0 && nts < 64) { const unsigned long long _c = (unsigned long long)clock64(); \
        ts_lo = (lane == nts) ? (int)(unsigned)_c : ts_lo; ts_hi = (lane == nts) ? (int)(unsigned)(_c >> 32) : ts_hi; ++nts; } } while (0)
    PG8_STAMP();
    unsigned voffA[2], voffB[2];
#pragma unroll
    for (int i = 0; i < 2; ++i) { int R, C; stage_rc(tid * 16 + i * 8192, R, C); const int Rb = Epi::PERM ? ((R & ~31) + perm32(R & 31)) : R;
        voffA[i] = (unsigned)(R * K + C) * 2u; voffB[i] = (unsigned)(Rb * K + C) * 2u; }
    const size_t kstep = (size_t)(BK * 2);
    const size_t hstep = (size_t)HALF * K * 2;
    const size_t tstep = 2 * hstep;
    const unsigned ldsw = (unsigned)wid * 1024u;
    const int aoff = lds_byte(wr * 64 + fr, fq * 8), boff = lds_byte(wc * 32 + fr, fq * 8);
#define PG8_SA(b, h) (((b) * 2 + (h)) * HTB)
#define PG8_SB(b, h) ((4 + (b) * 2 + (h)) * HTB)
#define PG8_STAGE(bufoff, gbase, voff) do { _Pragma("unroll") for (int _i = 0; _i < 2; ++_i) \
        __builtin_amdgcn_global_load_lds((const unsigned*)((const char*)(gbase) + (voff)[_i]), (PG8_LAS unsigned*)(lds + (bufoff) + ldsw + _i * 8192), 16, 0, 0); } while (0)
#define PG8_LDA(dst, b, h) do { _Pragma("unroll") for (int m = 0; m < 4; ++m) _Pragma("unroll") for (int k = 0; k < 2; ++k) dst[m][k] = *(const PG8_LAS bf16x8*)(lds + PG8_SA(b, h) + aoff + m * 2048 + k * 1024); } while (0)
#define PG8_LDB(dst, b, h) do { _Pragma("unroll") for (int n = 0; n < 2; ++n) _Pragma("unroll") for (int k = 0; k < 2; ++k) dst[n][k] = *(const PG8_LAS bf16x8*)(lds + PG8_SB(b, h) + boff + n * 2048 + k * 1024); } while (0)
#define PG8_MMA(ai, bj, At, Bt) do { __builtin_amdgcn_s_setprio(1); _Pragma("unroll") for (int m = 0; m < 4; ++m) _Pragma("unroll") for (int n = 0; n < 2; ++n) _Pragma("unroll") for (int k = 0; k < 2; ++k) \
        acc[ai][bj][m][n] = __builtin_amdgcn_mfma_f32_16x16x32_bf16(Bt[n][k], At[m][k], acc[ai][bj][m][n], 0, 0, 0); __builtin_amdgcn_s_setprio(0); } while (0)
#define PG8_WAIT_V(n) asm volatile("s_waitcnt vmcnt(" #n ")" ::: "memory")
#define PG8_WAIT_L(n) asm volatile("s_waitcnt lgkmcnt(" #n ")" ::: "memory")
#define PG8_BAR __builtin_amdgcn_s_barrier()
#define PG8_SCHED __builtin_amdgcn_sched_barrier(0)
    Unit cur, nxt; int ui = 0;
    if (!S.next(0, cur)) return;
    f32x4 acc[2][2][4][2];
#pragma unroll
    for (int a = 0; a < 2; ++a)
#pragma unroll
        for (int b = 0; b < 2; ++b)
#pragma unroll
            for (int m = 0; m < 4; ++m)
#pragma unroll
                for (int n = 0; n < 2; ++n) acc[a][b][m][n] = (f32x4){0.f, 0.f, 0.f, 0.f};
    bf16x8 At[4][2], B0[2][2], B1[2][2];
    const char* cA = (const char*)g.A + (size_t)cur.pm * tstep; const char* cB = (const char*)g.Bt + (size_t)cur.pn * tstep;
    S.a_ready(cur);
    PG8_STAGE(PG8_SB(0, 0), cB, voffB); PG8_STAGE(PG8_SB(0, 1), cB + hstep, voffB); PG8_STAGE(PG8_SA(0, 0), cA, voffA); PG8_STAGE(PG8_SA(0, 1), cA + hstep, voffA);
    if (wr == 1) PG8_BAR;
    PG8_WAIT_V(2); PG8_BAR;
    PG8_STAGE(PG8_SB(1, 0), cB + kstep, voffB); PG8_STAGE(PG8_SA(1, 0), cA + kstep, voffA); PG8_STAGE(PG8_SB(1, 1), cB + hstep + kstep, voffB);
    PG8_WAIT_V(6); PG8_BAR;
    PG8_STAMP();
    for (;;) {
        const bool has_next = S.next(ui + 1, nxt);
        const char* nA = has_next ? (const char*)g.A + (size_t)nxt.pm * tstep : cA; const char* nB = has_next ? (const char*)g.Bt + (size_t)nxt.pn * tstep : cB;
        for (int t = 0; t < nt; t += 2) {
            const bool last = (t == nt - 2);
            const char* a1 = cA + (size_t)(t + 1) * kstep;
            const char* a2 = last ? nA : cA + (size_t)(t + 2) * kstep; const char* b2 = last ? nB : cB + (size_t)(t + 2) * kstep;
            const char* a3 = a2 + kstep; const char* b3 = b2 + kstep;
            if (last && has_next) S.a_ready(nxt);
            if constexpr (Epi::TMID >= 0) { if (t == Epi::TMID) E.mid(acc, cur, wr, wc, fr, fq); }
            PG8_LDB(B0, 0, 0); PG8_LDB(B1, 0, 1); PG8_SCHED; PG8_LDA(At, 0, 0); PG8_STAGE(PG8_SA(1, 1), a1 + hstep, voffA);
            PG8_WAIT_V(8); PG8_WAIT_L(0); PG8_BAR; PG8_MMA(0, 0, At, B0); PG8_MMA(0, 1, At, B1); PG8_BAR; PG8_SCHED;
            PG8_LDA(At, 0, 1); PG8_STAGE(PG8_SB(0, 0), b2, voffB); PG8_STAGE(PG8_SB(0, 1), b2 + hstep, voffB); PG8_STAGE(PG8_SA(0, 0), a2, voffA);
            PG8_WAIT_V(8); PG8_WAIT_L(0); PG8_BAR; PG8_MMA(1, 0, At, B0); PG8_MMA(1, 1, At, B1); PG8_BAR; PG8_SCHED;
            PG8_LDB(B0, 1, 0); PG8_LDB(B1, 1, 1); PG8_SCHED; PG8_LDA(At, 1, 0); PG8_STAGE(PG8_SA(0, 1), a2 + hstep, voffA);
            PG8_WAIT_V(8); PG8_WAIT_L(0); PG8_BAR; PG8_MMA(0, 0, At, B0); PG8_MMA(0, 1, At, B1); PG8_BAR; PG8_SCHED;
            PG8_LDA(At, 1, 1); PG8_STAGE(PG8_SB(1, 0), b3, voffB); PG8_STAGE(PG8_SB(1, 1), b3 + hstep, voffB); PG8_STAGE(PG8_SA(1, 0), a3, voffA);
            PG8_WAIT_V(8); PG8_WAIT_L(0); PG8_BAR; PG8_MMA(1, 0, At, B0); PG8_MMA(1, 1, At, B1); PG8_BAR; PG8_SCHED;
        }
        PG8_STAMP();
        if (wr == 0) PG8_BAR;
        if constexpr (!Epi::AFTER_DRAIN) { E(acc, cur, wr, wc, fr, fq); S.done(cur); }
        PG8_STAMP();
        if (!has_next) break;
#pragma unroll
        for (int a = 0; a < 2; ++a)
#pragma unroll
            for (int b = 0; b < 2; ++b)
#pragma unroll
                for (int m = 0; m < 4; ++m)
#pragma unroll
                    for (int n = 0; n < 2; ++n) acc[a][b][m][n] = (f32x4){0.f, 0.f, 0.f, 0.f};
        cur = nxt; cA = nA; cB = nB; ++ui;
        if (wr == 1) PG8_BAR;
    }
    PG8_WAIT_V(0);
    PG8_BAR;
    if constexpr (Epi::AFTER_DRAIN) { E.fused(acc, cur, wr, wc, fr, fq, lds, wid, lane); S.done(cur); }
    PG8_STAMP();
    if (STAMP && wid == 0) { stamps[lane] = lane < nts ? (((unsigned long long)(unsigned)ts_hi << 32) | (unsigned)ts_lo) : 0ull;
        if (lane == 62) stamps[62] = rt_entry; if (lane == 63) stamps[63] = (unsigned long long)wall_clock64(); }
#undef PG8_STAMP
#undef PG8_SA
#undef PG8_SB
#undef PG8_STAGE
#undef PG8_LDA
#undef PG8_LDB
#undef PG8_MMA
#undef PG8_WAIT_V
#undef PG8_WAIT_L
#undef PG8_BAR
#undef PG8_SCHED
}
}

#ifndef MULTI
#define MULTI 0
#endif
#define DI __device__ __forceinline__
typedef unsigned short bf16_t;
typedef short bf16x8 __attribute__((ext_vector_type(8)));
typedef float f32x4 __attribute__((ext_vector_type(4)));
typedef float f32x16 __attribute__((ext_vector_type(16)));
typedef unsigned u32x4 __attribute__((ext_vector_type(4)));
typedef unsigned u32x2 __attribute__((ext_vector_type(2)));

constexpr int DM = 1024, NLAYER = 4, NP = 7424, NIN = 7200, DFF = 2816, NUP = 5632;
constexpr int TTOK = 24576, HT = 12288, NCH = 192;
constexpr int C_Q = 0, C_V = 512, C_F = 1024, C_GA = 2048, C_Z = 2560, C_XBC = 3584, C_DT = 5120, C_GATE = 5152;
constexpr float EPSN = 1e-6f;
constexpr int NTHR = 512;

constexpr size_t MiB = 1u << 20;
constexpr size_t WS_MOD = 0;
constexpr size_t WS_LB = 512 * 1024;
constexpr size_t WS_DECA = 1 * MiB;
constexpr size_t WS_DECB = 3 * MiB;
constexpr size_t WS_WIN = 4 * MiB;
constexpr size_t WS_WBRA = 19 * MiB;
constexpr size_t WS_WBRB = 20 * MiB;
constexpr size_t WS_WOUT = 22 * MiB;
constexpr size_t WS_WUP = 24 * MiB;
constexpr size_t WS_WDN = 35 * MiB;
constexpr size_t WS_U = 41 * MiB;
constexpr size_t WS_OA = 65 * MiB;
constexpr size_t WS_YB = 77 * MiB;
constexpr size_t WS_SA = 101 * MiB;
constexpr size_t WS_SB = 149 * MiB;
constexpr size_t WS_PROJ = 197 * MiB;
constexpr size_t WS_W2OFS = 368 * MiB;
constexpr size_t WS_END = 410 * MiB;

struct Params {
    const float *x_prompt, *x_sample, *c, *state_hgrn, *state_ssd, *c_ctx, *w_ada, *b_ada, *ln1, *ln2, *ln_f, *w_in, *lb_logits, *a_norm,
        *conv_w, *conv_b, *dt_bias, *a_log, *d_skip, *b_norm, *w_br_a, *w_br_b, *w_out, *w_ff_up, *ff_conv_w, *ff_conv_b, *w_ff_down;
    float* out; unsigned char* ws; int ph_lo, ph_hi;
};
typedef const __attribute__((address_space(4))) Params CParams;
constexpr size_t OUT_SH = (size_t)TTOK * DM;
constexpr size_t OUT_SS = OUT_SH + (size_t)32 * 4 * 2 * 4 * 128 * 128;

DI int get_tid() { int t = threadIdx.x; asm volatile("" : "+v"(t)); return t; }
DI float bf2f(bf16_t b) { return __uint_as_float(((unsigned)b) << 16); }
typedef __bf16 hwbf16x2 __attribute__((ext_vector_type(2)));
typedef float f32x2v __attribute__((ext_vector_type(2)));
DI unsigned pk2(float lo, float hi) { const f32x2v v = {lo, hi}; const hwbf16x2 b = __builtin_convertvector(v, hwbf16x2); return __builtin_bit_cast(unsigned, b); }
DI unsigned f2bf(float f) { return pk2(f, 0.f) & 0xffffu; }
DI void unpack8(const u32x4 r, float* o) { o[0] = __uint_as_float(r.x << 16); o[1] = __uint_as_float(r.x & 0xffff0000u); o[2] = __uint_as_float(r.y << 16); o[3] = __uint_as_float(r.y & 0xffff0000u);
    o[4] = __uint_as_float(r.z << 16); o[5] = __uint_as_float(r.z & 0xffff0000u); o[6] = __uint_as_float(r.w << 16); o[7] = __uint_as_float(r.w & 0xffff0000u); }
DI u32x4 pack8(const float* y) { u32x4 o; o.x = pk2(y[0], y[1]); o.y = pk2(y[2], y[3]); o.z = pk2(y[4], y[5]); o.w = pk2(y[6], y[7]); return o; }
DI float sigm(float x) { return __builtin_amdgcn_rcpf(1.f + __expf(-x)); }
DI float silu(float x) { return x * __builtin_amdgcn_rcpf(1.f + __expf(-x)); }
DI float wave_sum(float v) {
#pragma unroll
    for (int o = 1; o < 64; o <<= 1) v += __shfl_xor(v, o);
    return v;
}
DI f32x16 mfma32(bf16x8 a, bf16x8 b, f32x16 c) { return __builtin_amdgcn_mfma_f32_32x32x16_bf16(a, b, c, 0, 0, 0); }
DI f32x16 zero16() { f32x16 z;
#pragma unroll
    for (int i = 0; i < 16; ++i) z[i] = 0.f; return z; }

struct SeqInfo { int first, nch, latent, batch; };
DI SeqInfo seq_of(int hf, int sq) { SeqInfo s; if (hf == 0) { if (sq < 32) { s.first = 4 * sq; s.nch = 4; s.latent = 0; s.batch = sq; } else { s.first = 128; s.nch = 64; s.latent = 1; s.batch = 0; } }
    else { s.first = 64 * sq; s.nch = 64; s.latent = 1; s.batch = 1 + sq; } return s; }
DI void chunk_halo(int hf, int c, bool& has_prev, bool& has_next) { const bool ctx = (hf == 0 && c < 128); has_prev = ctx && ((c & 3) != 0); has_next = ctx && ((c & 3) != 3); }

DI void phase_init(CParams& p, unsigned char* lds, int bid, int nb) {
    const int tid = get_tid();
    float* MOD = (float*)(p.ws + WS_MOD);
    float* CV = (float*)lds;
    float* RED = (float*)(lds + 20480);
    for (int i = tid; i < 5 * 1024; i += NTHR) { const int g = i >> 10, k = i & 1023; const float v = (g == 0) ? p.c_ctx[k] : p.c[(g - 1) * 1024 + k]; CV[i] = silu(v); }
    __syncthreads();
    for (int item = bid; item < 4 * 48; item += nb) {
        const int l = item / 48, jb = item % 48; const int jj = tid & 31, kp = tid >> 5;
        const float* W = p.w_ada + (size_t)l * 1024 * 6144 + (size_t)(kp * 64) * 6144 + jb * 128 + jj * 4;
        const float fz_ = __uint_as_float((unsigned)(tid >> 31)); f32x4 a0 = {fz_, fz_, fz_, fz_}, a1 = a0, a2 = a0, a3 = a0, a4 = a0;
#pragma unroll 8
        for (int k = 0; k < 64; ++k) { const f32x4 w = *(const f32x4*)(W + (size_t)k * 6144); const int kk = kp * 64 + k;
            a0 += w * CV[kk]; a1 += w * CV[1024 + kk]; a2 += w * CV[2048 + kk]; a3 += w * CV[3072 + kk]; a4 += w * CV[4096 + kk]; }
        float* r = RED + (kp * 5) * 128 + jj * 4;
        *(f32x4*)(r) = a0; *(f32x4*)(r + 128) = a1; *(f32x4*)(r + 256) = a2; *(f32x4*)(r + 384) = a3; *(f32x4*)(r + 512) = a4;
        __syncthreads();
        for (int o = tid; o < 640; o += NTHR) { const int g = o >> 7, col = o & 127; float s = p.b_ada[l * 6144 + jb * 128 + col];
#pragma unroll
            for (int q = 0; q < 16; ++q) s += RED[(q * 5 + g) * 128 + col];
            MOD[(size_t)(l * 5 + g) * 6144 + jb * 128 + col] = s; }
        __syncthreads();
    }
    if (bid == nb - 1) {
        float* LB = (float*)(p.ws + WS_LB);
        for (int i = tid; i < 1024; i += NTHR) { float v[4], mx = -1e30f;
#pragma unroll
            for (int l = 0; l < 4; ++l) { v[l] = p.lb_logits[l * 1024 + i]; mx = fmaxf(mx, v[l]); }
            float s = 0.f;
#pragma unroll
            for (int l = 0; l < 4; ++l) { v[l] = __expf(v[l] - mx); s += v[l]; }
            const float inv = 1.f / s; float cum = 0.f; LB[i] = 0.f;
#pragma unroll
            for (int l = 1; l < 4; ++l) { cum += v[l] * inv; LB[l * 1024 + i] = fmaxf(cum, 0.f); } }
    }
}

template <bool REMAP> DI void transpose_item(const float* W, int K, int N, bf16_t* WT, float* scr, int item, int lane, int ldk = 0, int koff = 0) {
    if (ldk == 0) ldk = K;
    const int nblk = N / 32, kb = item / nblk, nbk = item % nblk, k0 = 64 * kb, n0 = 32 * nbk;
    const int r0 = !REMAP ? n0 : (n0 < 2048 ? n0 : (n0 < 3584 ? 3840 + (n0 - 2048) : (n0 < 5152 ? 2048 + (n0 - 3584) : 3840 + 1536 + (n0 - 5152))));
#pragma unroll 8
    for (int i = 0; i < 32; ++i) { const int kk = 2 * i + (lane >> 5); scr[kk * 33 + (lane & 31)] = W[(size_t)(k0 + kk) * N + n0 + (lane & 31)]; }
    asm volatile("s_waitcnt lgkmcnt(0)" ::: "memory");
    const int c = lane & 7;
#pragma unroll
    for (int j = 0; j < 4; ++j) { const int n = (lane >> 3) + 8 * j; const float* s = scr + (8 * c) * 33 + n;
        u32x4 o; o.x = pk2(s[0 * 33], s[1 * 33]); o.y = pk2(s[2 * 33], s[3 * 33]); o.z = pk2(s[4 * 33], s[5 * 33]); o.w = pk2(s[6 * 33], s[7 * 33]);
        *(u32x4*)(WT + (size_t)(r0 + n) * ldk + koff + k0 + 8 * c) = o; }
    asm volatile("s_waitcnt lgkmcnt(0)" ::: "memory");
}
constexpr int WC_IN = 16 * 225, WC_A = 8 * 32, WC_B = 16 * 32, WC_O = 16 * 32, WC_U = 16 * 176, WC_D = 44 * 32;
constexpr int WC_NIT = WC_IN + WC_A + WC_B + WC_O + WC_U + WC_D;
DI void phase_wconv(CParams& p, unsigned char* lds, int l, int vb, int nvb, int it_lo, int it_hi) {
    const int tid = get_tid(), lane = tid & 63, wave = __builtin_amdgcn_readfirstlane(tid >> 6);
    float* scr = (float*)(lds + wave * 8704);
    const int gw = vb * 8 + wave, NGW = nvb * 8;
    unsigned char* ws = p.ws + ((l & 1) ? WS_W2OFS : 0);
    for (int it = it_lo + gw; it < it_hi; it += NGW) {
        int r = it;
        if (r < WC_IN) { transpose_item<true>(p.w_in + (size_t)l * 1024 * NIN, 1024, NIN, (bf16_t*)(ws + WS_WIN), scr, r, lane); continue; } r -= WC_IN;
        if (r < WC_A) { transpose_item<false>(p.w_br_a + (size_t)l * 512 * 1024, 512, 1024, (bf16_t*)(ws + WS_WBRA), scr, r, lane, 1536, 0); continue; } r -= WC_A;
        if (r < WC_B) { transpose_item<false>(p.w_br_b + (size_t)l * 1024 * 1024, 1024, 1024, (bf16_t*)(ws + WS_WBRA), scr, r, lane, 1536, 512); continue; } r -= WC_B;
        if (r < WC_O) { transpose_item<false>(p.w_out + (size_t)l * 1024 * 1024, 1024, 1024, (bf16_t*)(ws + WS_WOUT), scr, r, lane); continue; } r -= WC_O;
        if (r < WC_U) { transpose_item<false>(p.w_ff_up + (size_t)l * 1024 * NUP, 1024, NUP, (bf16_t*)(ws + WS_WUP), scr, r, lane); continue; } r -= WC_U;
        transpose_item<false>(p.w_ff_down + (size_t)l * DFF * 1024, DFF, 1024, (bf16_t*)(ws + WS_WDN), scr, r, lane);
    }
    if (it_lo == 0) {
        u32x4* z = (u32x4*)((bf16_t*)(ws + WS_WIN) + (size_t)3616 * 1024); const int nz = (3840 - 3616) * 1024 / 8;
        const unsigned uz_ = (unsigned)(tid >> 31);
        for (int i = vb * NTHR + tid; i < nz; i += nvb * NTHR) z[i] = (u32x4){uz_, uz_, uz_, uz_};
    }
    __syncthreads();
}
DI void wconv_side(CParams& p, unsigned char* lds, int l, int hf, int bid, int nb, int it_lo, int it_hi) {
    if (hf != 1 || l >= 3) return;
    if (nb > 192) { if (bid >= 192) phase_wconv(p, lds, l + 1, bid - 192, nb - 192, it_lo, it_hi); }
    else phase_wconv(p, lds, l + 1, bid, nb, it_lo, it_hi);
}

DI void phase_norm(CParams& p, int l, int hf, int which, int bid, int nb) {
    const int tid = get_tid(), lane = tid & 63, wave = __builtin_amdgcn_readfirstlane(tid >> 6);
    const float* MOD = (const float*)(p.ws + WS_MOD);
    bf16_t* U = (bf16_t*)(p.ws + WS_U);
    const float* ln = (which == 0 ? p.ln1 : p.ln2) + l * 1024;
    for (int r = bid * 8 + wave; r < HT; r += nb * 8) {
        const int tok = hf * HT + r; const int grp = tok < 8192 ? 0 : 1 + ((tok - 8192) >> 12);
        const float* md = MOD + (size_t)(l * 5 + grp) * 6144 + which * 3072;
        const float* xsrc = (l == 0 && which == 0) ? (tok < 8192 ? p.x_prompt + (size_t)tok * 1024 : p.x_sample + (size_t)(tok - 8192) * 1024) : p.out + (size_t)tok * 1024;
        const f32x4* xr = (const f32x4*)xsrc + lane;
        f32x4 v[4]; float s = 0.f;
#pragma unroll
        for (int j = 0; j < 4; ++j) { v[j] = xr[64 * j]; s += (v[j].x * v[j].x + v[j].y * v[j].y) + (v[j].z * v[j].z + v[j].w * v[j].w); }
        const float rstd = __builtin_amdgcn_rsqf(wave_sum(s) * (1.f / 1024.f) + EPSN);
        unsigned long long* o8 = (unsigned long long*)(U + (size_t)r * 1024) + lane;
#pragma unroll
        for (int j = 0; j < 4; ++j) { const int col = 4 * (64 * j + lane);
            const f32x4 g = *(const f32x4*)(ln + col), sh = *(const f32x4*)(md + col), sc = *(const f32x4*)(md + 1024 + col);
            const f32x4 y = v[j] * rstd * g * (sc + 1.f) + sh;
            o8[64 * j] = (unsigned long long)pk2(y.x, y.y) | ((unsigned long long)pk2(y.z, y.w) << 32); }
    }
}
DI void phase_final_norm(CParams& p, int bid, int nb) {
    const int tid = get_tid(), lane = tid & 63, wave = __builtin_amdgcn_readfirstlane(tid >> 6);
    for (int r = bid * 8 + wave; r < TTOK; r += nb * 8) {
        f32x4* xr = (f32x4*)(p.out + (size_t)r * 1024) + lane;
        f32x4 v[4]; float s = 0.f;
#pragma unroll
        for (int j = 0; j < 4; ++j) { v[j] = xr[64 * j]; s += (v[j].x * v[j].x + v[j].y * v[j].y) + (v[j].z * v[j].z + v[j].w * v[j].w); }
        const float rstd = __builtin_amdgcn_rsqf(wave_sum(s) * (1.f / 1024.f) + EPSN);
#pragma unroll
        for (int j = 0; j < 4; ++j) { const int col = 4 * (64 * j + lane); const f32x4 g = *(const f32x4*)(p.ln_f + col); xr[64 * j] = v[j] * rstd * g; }
    }
}

DI void phase_convact(CParams& p, int l, int hf, int bid, int nb) {
    const bf16_t* H = (const bf16_t*)(p.ws + WS_PROJ); bf16_t* ACT = (bf16_t*)(p.ws + WS_SA);
    const float* cw = p.ff_conv_w + (size_t)l * 3 * NUP; const float* cb = p.ff_conv_b + (size_t)l * NUP;
    const int tid = get_tid();
    constexpr int NRUN = HT / 32, NITEM = 352 * NRUN, PER_BLK = (NITEM + 255) / 256;
    for (int li = tid; li < PER_BLK; li += NTHR) { const int it = bid * PER_BLK + li; if (it >= NITEM) break;
        const int cg8 = (it % 352) * 8, t0 = (it / 352) * 32;
        const bool latent = (hf == 1) || (t0 >= 8192); const int per = latent ? 64 : 256;
        const bool hp = (t0 & (per - 1)) != 0, hn = ((t0 + 31) & (per - 1)) != per - 1;
        float w[2][3][8], bs[2][8];
#pragma unroll
        for (int hh = 0; hh < 2; ++hh) { const int col = hh * DFF + cg8;
#pragma unroll
            for (int k = 0; k < 3; ++k) { const f32x4 a = *(const f32x4*)(cw + k * NUP + col), b = *(const f32x4*)(cw + k * NUP + col + 4);
#pragma unroll
                for (int j = 0; j < 4; ++j) { w[hh][k][j] = a[j]; w[hh][k][4 + j] = b[j]; } }
            const f32x4 a = *(const f32x4*)(cb + col), b = *(const f32x4*)(cb + col + 4);
#pragma unroll
            for (int j = 0; j < 4; ++j) { bs[hh][j] = a[j]; bs[hh][4 + j] = b[j]; } }
        const bf16_t* ha = H + (size_t)t0 * NUP + cg8; const bf16_t* hb = ha + DFF;
        const unsigned uz_ = (unsigned)(tid >> 31); const u32x4 z4 = {uz_, uz_, uz_, uz_};
        u32x4 am = hp ? *(const u32x4*)(ha - NUP) : z4, bm = hp ? *(const u32x4*)(hb - NUP) : z4;
        u32x4 a0 = *(const u32x4*)ha, b0 = *(const u32x4*)hb;
#pragma unroll 4
        for (int t = 0; t < 32; ++t) {
            const bool more = (t < 31) || hn;
            const u32x4 ap = more ? *(const u32x4*)(ha + (size_t)(t + 1) * NUP) : z4, bp = more ? *(const u32x4*)(hb + (size_t)(t + 1) * NUP) : z4;
            float xa[3][8], xb[3][8]; unpack8(am, xa[0]); unpack8(a0, xa[1]); unpack8(ap, xa[2]); unpack8(bm, xb[0]); unpack8(b0, xb[1]); unpack8(bp, xb[2]);
            float r[8];
#pragma unroll
            for (int j = 0; j < 8; ++j) { const float va = bs[0][j] + w[0][0][j] * xa[0][j] + w[0][1][j] * xa[1][j] + w[0][2][j] * xa[2][j];
                const float vb = bs[1][j] + w[1][0][j] * xb[0][j] + w[1][1][j] * xb[1][j] + w[1][2][j] * xb[2][j]; r[j] = silu(va) * vb; }
            *(u32x4*)(ACT + (size_t)(t0 + t) * DFF + cg8) = pack8(r);
            am = a0; a0 = ap; bm = b0; b0 = bp;
        }
    }
}

constexpr int TQ = 0, TV = 512, TF = 1024, TX = 2048, TDT = 3584, NTROW = 3840;
constexpr int G_GA = 0, G_Z = 512, G_GATE = 1536, NG = 3584;
constexpr size_t WS_PROJG = WS_PROJ + (size_t)NTROW * HT * 2;
DI void hgrn_gates(const u32x4 (&raw)[4], float lb, float* SUMS, int d, int sh, int k, float (&f)[32], float& PA, float& PB) {
    const float oml = 1.f - lb; float loc = 1.f;
#pragma unroll
    for (int j = 0; j < 4; ++j) unpack8(raw[j], &f[8 * j]);
#pragma unroll
    for (int j = 0; j < 32; ++j) { f[j] = fmaxf(lb + oml * sigm(f[j]), 1e-30f); loc *= f[j]; }
    SUMS[(d * 2 + sh) * 128 + k] = loc;
    __syncthreads();
    PA = SUMS[(d * 2) * 128 + k]; PB = SUMS[(d * 2 + 1) * 128 + k];
}
DI void stage_vt(const bf16_t* PROJT, int lt0, int h, bf16_t* VT, int tid) {
#pragma unroll
    for (int r = 0; r < 2; ++r) { const int idx = tid + 512 * r, v = idx >> 3, o = idx & 7;
        *(u32x4*)(VT + v * 72 + o * 8) = *(const u32x4*)(PROJT + (size_t)(TV + h * 128 + v) * HT + lt0 + o * 8); }
}

DI void scanA_hgrn(CParams& p, unsigned char* lds, int l, int hf, int c, int h) {
    const int tid = get_tid(), lane = tid & 63, wave = __builtin_amdgcn_readfirstlane(tid >> 6), l31 = lane & 31, lh = lane >> 5;
    const bf16_t* PROJT = (const bf16_t*)(p.ws + WS_PROJ);
    bf16_t* KH = (bf16_t*)lds;
    bf16_t* VT = (bf16_t*)(lds + 36864);
    float* SUMS = (float*)(lds + 55296);
    const int lt0 = c * 64;
    {
        const int d = tid >> 8, sh = (tid >> 7) & 1, k = tid & 127;
        const bf16_t* fp = PROJT + (size_t)(TF + d * 512 + h * 128 + k) * HT + lt0 + sh * 32;
        u32x4 raw[4];
#pragma unroll
        for (int j = 0; j < 4; ++j) raw[j] = *(const u32x4*)(fp + 8 * j);
        const float lb = ((const float*)(p.ws + WS_LB))[(l * 2 + d) * 512 + h * 128 + k];
        stage_vt(PROJT, lt0, h, VT, tid);
        float f[32], PA, PB; hgrn_gates(raw, lb, SUMS, d, sh, k, f, PA, PB);
        float val[32];
        if (d == 0) { float suf = sh ? 1.f : PB;
#pragma unroll
            for (int j = 31; j >= 0; --j) { val[j] = (1.f - f[j]) * suf; suf *= f[j]; } }
        else { float pre = sh ? PA : 1.f;
#pragma unroll
            for (int j = 0; j < 32; ++j) { val[j] = (1.f - f[j]) * pre; pre *= f[j]; } }
#pragma unroll
        for (int s8 = 0; s8 < 4; ++s8) *(u32x4*)(KH + (d * 128 + k) * 72 + sh * 32 + s8 * 8) = pack8(&val[s8 * 8]);
        if (sh == 0) { float* DEC = (float*)(p.ws + WS_DECA) + (size_t)((c * 4 + h) * 2 + d) * 256; DEC[k] = PA * PB; DEC[128 + k] = (d == 0) ? PA : PB; }
    }
    __syncthreads();
    {
        const int d = wave >> 2, vq = wave & 3;
        f32x16 acc[4];
#pragma unroll
        for (int i = 0; i < 4; ++i) acc[i] = zero16();
#pragma unroll
        for (int ks = 0; ks < 4; ++ks) { const bf16x8 b = *(const bf16x8*)(VT + (vq * 32 + l31) * 72 + ks * 16 + 8 * lh);
#pragma unroll
            for (int kb = 0; kb < 4; ++kb) { const bf16x8 a = *(const bf16x8*)(KH + (d * 128 + kb * 32 + l31) * 72 + ks * 16 + 8 * lh); acc[kb] = mfma32(a, b, acc[kb]); } }
        bf16_t* S = (bf16_t*)(p.ws + WS_SA) + (size_t)((c * 4 + h) * 2 + d) * 16384 + (size_t)(vq * 32 + l31) * 128;
#pragma unroll
        for (int kb = 0; kb < 4; ++kb)
#pragma unroll
            for (int g = 0; g < 4; ++g) { u32x2 w; w.x = pk2(acc[kb][4 * g], acc[kb][4 * g + 1]); w.y = pk2(acc[kb][4 * g + 2], acc[kb][4 * g + 3]);
                *(u32x2*)(S + kb * 32 + 8 * g + 4 * lh) = w; }
    }
    __syncthreads();
}

DI void ssd_dt(CParams& p, const bf16_t* PROJT, int l, int lt0, int head, int d, int lane, float& dt, float& a, float& ac, float& total) {
    const float raw = bf2f(PROJT[(size_t)(TDT + d * 16 + head) * HT + lt0 + lane]) + p.dt_bias[(l * 2 + d) * 16 + head];
    dt = raw > 20.f ? raw : log1pf(__expf(raw));
    a = -__expf(p.a_log[(l * 2 + d) * 16 + head]) * dt;
    ac = a;
#pragma unroll
    for (int o = 1; o < 64; o <<= 1) { const float t = __shfl_up(ac, o); if (lane >= o) ac += t; }
    total = __shfl(ac, 63);
}
constexpr int LDS_CW = 122880;
DI int cw_xcol(int g, int cl) { return cl < 256 ? g * 256 + cl : (cl < 320 ? 1024 + g * 64 + (cl - 256) : 1280 + g * 64 + (cl - 320)); }
DI void cw_fill(CParams& p, unsigned char* lds, int l, int g, int tid) {
    if (tid < 384) { const int xcol = cw_xcol(g, tid); f32x4 w; w[0] = p.conv_w[(l * 3 + 0) * 1536 + xcol]; w[1] = p.conv_w[(l * 3 + 1) * 1536 + xcol]; w[2] = p.conv_w[(l * 3 + 2) * 1536 + xcol]; w[3] = p.conv_b[l * 1536 + xcol];
        *(f32x4*)(lds + LDS_CW + tid * 16) = w; }
}
struct Conv8In { u32x4 cur; float xm, xn; };
DI Conv8In conv8_load(const bf16_t* PROJT, int lt0, int sg, int xcol, bool has_prev, bool has_next) {
    Conv8In r; const bf16_t* xp = PROJT + (size_t)(TX + xcol) * HT + lt0 + sg * 8;
    r.cur = *(const u32x4*)xp; r.xm = 0.f; r.xn = 0.f;
    if (sg == 0 && has_prev) r.xm = bf2f(xp[-1]);
    if (sg == 7 && has_next) r.xn = bf2f(xp[8]);
    return r;
}
DI void conv8_math(const Conv8In& r, int sg, const unsigned char* lds, int cl, float* y) {
    const unsigned pw = __shfl_up(r.cur.w, 1), nx = __shfl_down(r.cur.x, 1);
    const float xm = (sg == 0) ? r.xm : __uint_as_float(pw & 0xffff0000u);
    const float xn = (sg == 7) ? r.xn : __uint_as_float(nx << 16);
    const f32x4 w = *(const f32x4*)(lds + LDS_CW + cl * 16);
    float x[10]; x[0] = xm; unpack8(r.cur, &x[1]); x[9] = xn;
#pragma unroll
    for (int j = 0; j < 8; ++j) y[j] = silu(w[3] + w[0] * x[j] + w[1] * x[j + 1] + w[2] * x[j + 2]);
}

DI void scanA_ssd(CParams& p, unsigned char* lds, int l, int hf, int c, int g) {
    const int tid = get_tid(), lane = tid & 63, wave = __builtin_amdgcn_readfirstlane(tid >> 6), l31 = lane & 31, lh = lane >> 5;
    const bf16_t* PROJT = (const bf16_t*)(p.ws + WS_PROJ);
    bf16_t* XT = (bf16_t*)lds;
    bf16_t* BT = (bf16_t*)(lds + 36864);
    float* WS_ = (float*)(lds + 46080);
    const int lt0 = c * 64; bool hp, hn; chunk_halo(hf, c, hp, hn);
    Conv8In cin[5];
#pragma unroll
    for (int r = 0; r < 5; ++r) { const int it = tid + r * NTHR, cl = it >> 3, sg = it & 7; const int xcol = cl < 256 ? g * 256 + cl : 1024 + g * 64 + (cl - 256); cin[r] = conv8_load(PROJT, lt0, sg, xcol, hp, hn); }
    {
        const int hh = wave >> 1, d = wave & 1, head = g * 4 + hh; float dt, a, ac, total; ssd_dt(p, PROJT, l, lt0, head, d, lane, dt, a, ac, total);
        WS_[wave * 64 + lane] = ((d == 0) ? __expf(total - ac) : __expf(ac - a)) * dt;
        if (lane == 0) ((float*)(p.ws + WS_DECB))[(c * 16 + head) * 2 + d] = __expf(total);
    }
#pragma unroll
    for (int r = 0; r < 5; ++r) { const int it = tid + r * NTHR, cl = it >> 3, sg = it & 7; float y[8]; conv8_math(cin[r], sg, lds, cl, y);
        *(u32x4*)((cl < 256 ? XT + cl * 72 : BT + (cl - 256) * 72) + sg * 8) = pack8(y); }
    __syncthreads();
    {
        const int hh = wave >> 1, d = wave & 1, head = g * 4 + hh;
        f32x16 acc[2][2];
#pragma unroll
        for (int i = 0; i < 2; ++i)
#pragma unroll
            for (int j = 0; j < 2; ++j) acc[i][j] = zero16();
#pragma unroll
        for (int ks = 0; ks < 4; ++ks) { const f32x4 wa = *(const f32x4*)(WS_ + wave * 64 + ks * 16 + 8 * lh), wb = *(const f32x4*)(WS_ + wave * 64 + ks * 16 + 8 * lh + 4);
            bf16x8 bs[2];
#pragma unroll
            for (int ct = 0; ct < 2; ++ct) { const u32x4 r = *(const u32x4*)(XT + (hh * 64 + ct * 32 + l31) * 72 + ks * 16 + 8 * lh); u32x4 o;
                o.x = pk2(__uint_as_float(r.x << 16) * wa[0], __uint_as_float(r.x & 0xffff0000u) * wa[1]); o.y = pk2(__uint_as_float(r.y << 16) * wa[2], __uint_as_float(r.y & 0xffff0000u) * wa[3]);
                o.z = pk2(__uint_as_float(r.z << 16) * wb[0], __uint_as_float(r.z & 0xffff0000u) * wb[1]); o.w = pk2(__uint_as_float(r.w << 16) * wb[2], __uint_as_float(r.w & 0xffff0000u) * wb[3]);
                bs[ct] = __builtin_bit_cast(bf16x8, o); }
#pragma unroll
            for (int rt = 0; rt < 2; ++rt) { const bf16x8 a = *(const bf16x8*)(BT + (rt * 32 + l31) * 72 + ks * 16 + 8 * lh);
#pragma unroll
                for (int ct = 0; ct < 2; ++ct) acc[rt][ct] = mfma32(a, bs[ct], acc[rt][ct]); } }
        bf16_t* S = (bf16_t*)(p.ws + WS_SB) + (size_t)((c * 16 + head) * 2 + d) * 4096;
#pragma unroll
        for (int rt = 0; rt < 2; ++rt)
#pragma unroll
            for (int ct = 0; ct < 2; ++ct)
#pragma unroll
                for (int q = 0; q < 4; ++q) { u32x2 w; w.x = pk2(acc[rt][ct][4 * q], acc[rt][ct][4 * q + 1]); w.y = pk2(acc[rt][ct][4 * q + 2], acc[rt][ct][4 * q + 3]);
                    *(u32x2*)(S + (ct * 32 + l31) * 64 + rt * 32 + 8 * q + 4 * lh) = w; }
    }
    __syncthreads();
}
DI void phase_scanA(CParams& p, unsigned char* lds, int l, int hf, int bid, int nb, int rmode = 0) {
    int cwg = -1; const int tid0 = get_tid();
    for (int it = bid; it < 2 * NCH * 4; it += nb) { if (rmode == 1 && it < NCH * 4) continue; if (rmode == 2 && it >= NCH * 4) continue; if (it < NCH * 4) scanA_hgrn(p, lds, l, hf, it >> 2, it & 3);
        else { const int j = it - NCH * 4, g = j & 3; if (g != cwg) { __syncthreads(); cw_fill(p, lds, l, g, tid0); __syncthreads(); cwg = g; } scanA_ssd(p, lds, l, hf, j >> 2, g); } }
}

template <int NBAT> DI void scanB_hgrn_run(bf16_t* SA, const float* DECA, const SeqInfo& si, int h, int d, int v, int k4, float (&S)[4]) {
    for (int i0 = 0; i0 < si.nch; i0 += NBAT) { u32x2 raw[NBAT]; f32x4 dec[NBAT], em[NBAT]; bf16_t* sp[NBAT];
#pragma unroll
        for (int j = 0; j < NBAT; ++j) { const int i = i0 + j; const int c = si.first + (d == 0 ? i : si.nch - 1 - i); const size_t base = (size_t)((c * 4 + h) * 2 + d);
            sp[j] = SA + base * 16384 + v * 128 + k4; raw[j] = *(const u32x2*)sp[j]; dec[j] = *(const f32x4*)(DECA + base * 256 + k4); em[j] = *(const f32x4*)(DECA + base * 256 + 128 + k4); }
#pragma unroll
        for (int j = 0; j < NBAT; ++j) { u32x2 w; w.x = pk2(S[0] * em[j][0], S[1] * em[j][1]); w.y = pk2(S[2] * em[j][2], S[3] * em[j][3]); *(u32x2*)sp[j] = w;
            S[0] = dec[j][0] * S[0] + __uint_as_float(raw[j].x << 16); S[1] = dec[j][1] * S[1] + __uint_as_float(raw[j].x & 0xffff0000u);
            S[2] = dec[j][2] * S[2] + __uint_as_float(raw[j].y << 16); S[3] = dec[j][3] * S[3] + __uint_as_float(raw[j].y & 0xffff0000u); } }
}
template <int NBAT> DI void scanB_ssd_run(bf16_t* SB, const float* DECB, const SeqInfo& si, int head, int d, int pp, int n4, f32x4& S) {
    for (int i0 = 0; i0 < si.nch; i0 += NBAT) { u32x2 raw[NBAT]; float dec[NBAT]; bf16_t* sp[NBAT];
#pragma unroll
        for (int j = 0; j < NBAT; ++j) { const int i = i0 + j; const int c = si.first + (d == 0 ? i : si.nch - 1 - i); const size_t base = (size_t)((c * 16 + head) * 2 + d);
            sp[j] = SB + base * 4096 + pp * 64 + n4; raw[j] = *(const u32x2*)sp[j]; dec[j] = DECB[base]; }
#pragma unroll
        for (int j = 0; j < NBAT; ++j) { u32x2 w; w.x = pk2(S[0], S[1]); w.y = pk2(S[2], S[3]); *(u32x2*)sp[j] = w;
            S[0] = dec[j] * S[0] + __uint_as_float(raw[j].x << 16); S[1] = dec[j] * S[1] + __uint_as_float(raw[j].x & 0xffff0000u);
            S[2] = dec[j] * S[2] + __uint_as_float(raw[j].y << 16); S[3] = dec[j] * S[3] + __uint_as_float(raw[j].y & 0xffff0000u); } }
}
DI void phase_scanB(CParams& p, int l, int hf, int bid, int nb) {
    const int nseq = hf == 0 ? 33 : 3; const int total = nseq << 15;
    const int gt = bid * NTHR + get_tid(), gs = nb * NTHR;
    bf16_t* SA = (bf16_t*)(p.ws + WS_SA); const float* DECA = (const float*)(p.ws + WS_DECA);
    for (int it = gt; it < total; it += gs) {
        const int q = it & 4095, combo = (it >> 12) & 7, sq = it >> 15; const int h = combo >> 1, d = combo & 1; const int v = q >> 5, k4 = (q & 31) * 4;
        const SeqInfo si = seq_of(hf, sq);
        const float fz_ = __uint_as_float((unsigned)(gt >> 31)); float S[4] = {fz_, fz_, fz_, fz_};
        const size_t sidx = ((size_t)(((si.batch * 4 + l) * 2 + d) * 4 + h) * 128 + k4) * 128 + v;
        if (si.latent) {
#pragma unroll
            for (int j = 0; j < 4; ++j) S[j] = p.state_hgrn[sidx + (size_t)j * 128];
            scanB_hgrn_run<8>(SA, DECA, si, h, d, v, k4, S);
        } else {
            scanB_hgrn_run<4>(SA, DECA, si, h, d, v, k4, S);
#pragma unroll
            for (int j = 0; j < 4; ++j) p.out[OUT_SH + sidx + (size_t)j * 128] = S[j]; }
    }
    bf16_t* SB = (bf16_t*)(p.ws + WS_SB); const float* DECB = (const float*)(p.ws + WS_DECB);
    for (int it = gt; it < total; it += gs) {
        const int q = it & 1023, combo = (it >> 10) & 31, sq = it >> 15; const int head = combo >> 1, d = combo & 1; const int pp = q >> 4, n4 = (q & 15) * 4;
        const SeqInfo si = seq_of(hf, sq);
        const float fz_ = __uint_as_float((unsigned)(gt >> 31)); f32x4 S = {fz_, fz_, fz_, fz_};
        const size_t sidx = ((size_t)(((si.batch * 4 + l) * 2 + d) * 16 + head) * 64 + pp) * 64 + n4;
        if (si.latent) { S = *(const f32x4*)(p.state_ssd + sidx); scanB_ssd_run<8>(SB, DECB, si, head, d, pp, n4, S); }
        else { scanB_ssd_run<4>(SB, DECB, si, head, d, pp, n4, S); *(f32x4*)(p.out + OUT_SS + sidx) = S; }
    }
}

DI void scanC_hgrn(CParams& p, unsigned char* lds, int l, int hf, int c, int h) {
    const int tid = get_tid(), lane = tid & 63, wave = __builtin_amdgcn_readfirstlane(tid >> 6), l31 = lane & 31, lh = lane >> 5;
    const bf16_t* PROJT = (const bf16_t*)(p.ws + WS_PROJ);
    const bf16_t* PROJG = (const bf16_t*)(p.ws + WS_PROJG);
    bf16_t* QT = (bf16_t*)lds;
    bf16_t* KT = (bf16_t*)(lds + 34816);
    bf16_t* VT = (bf16_t*)(lds + 69632);
    bf16_t* PP = (bf16_t*)(lds + 88064);
    float* OO = (float*)(lds + 34816);
    float* SUMS = (float*)(lds + 106496);
    const int lt0 = c * 64;
    const int th = wave & 1, vq = wave >> 1;
    bf16x8 sfr[2][8];
    const int nt = tid >> 3, npart = tid & 7, nch0 = h * 128 + npart * 16;
    const bf16_t* gp = PROJG + (size_t)(lt0 + nt) * NG + G_GA + nch0; const u32x4 g0 = *(const u32x4*)gp, g1 = *(const u32x4*)(gp + 8);
    {
        const int d = tid >> 8, sh = (tid >> 7) & 1, k = tid & 127;
        const bf16_t* fp = PROJT + (size_t)(TF + d * 512 + h * 128 + k) * HT + lt0 + sh * 32;
        const bf16_t* qp = PROJT + (size_t)(TQ + h * 128 + k) * HT + lt0 + sh * 32;
        u32x4 raw[4], qraw[4];
#pragma unroll
        for (int j = 0; j < 4; ++j) { raw[j] = *(const u32x4*)(fp + 8 * j); qraw[j] = *(const u32x4*)(qp + 8 * j); }
        const float lb = ((const float*)(p.ws + WS_LB))[(l * 2 + d) * 512 + h * 128 + k];
        stage_vt(PROJT, lt0, h, VT, tid);
        float f[32], PA, PB; hgrn_gates(raw, lb, SUMS, d, sh, k, f, PA, PB);
        {
            const bf16_t* SA = (const bf16_t*)(p.ws + WS_SA);
#pragma unroll
            for (int dd = 0; dd < 2; ++dd)
#pragma unroll
                for (int ks = 0; ks < 8; ++ks) sfr[dd][ks] = *(const bf16x8*)(SA + (size_t)((c * 4 + h) * 2 + dd) * 16384 + (size_t)(vq * 32 + l31) * 128 + ks * 16 + 8 * lh);
        }
        float qv[32];
#pragma unroll
        for (int j8 = 0; j8 < 4; ++j8) unpack8(qraw[j8], &qv[8 * j8]);
        const float BIG = 5.5e34f;
        bf16_t* qd = QT + (d * 64 + sh * 32) * 136 + k; bf16_t* kd = KT + (d * 64 + sh * 32) * 136 + k;
        if (d == 0) {
            if (sh == 0) { float R = 1.f;
#pragma unroll
                for (int j = 31; j >= 0; --j) { qd[j * 136] = (bf16_t)f2bf(qv[j] * fminf(__builtin_amdgcn_rcpf(R), BIG)); kd[j * 136] = (bf16_t)f2bf((1.f - f[j]) * R); R *= f[j]; } }
            else { float P = 1.f;
#pragma unroll
                for (int j = 0; j < 32; ++j) { P *= f[j]; qd[j * 136] = (bf16_t)f2bf(qv[j] * P); kd[j * 136] = (bf16_t)f2bf((1.f - f[j]) * fminf(__builtin_amdgcn_rcpf(P), BIG)); } }
        } else {
            if (sh == 0) { float E = 1.f;
#pragma unroll
                for (int j = 31; j >= 0; --j) { E *= f[j]; qd[j * 136] = (bf16_t)f2bf(qv[j] * E); kd[j * 136] = (bf16_t)f2bf((1.f - f[j]) * fminf(__builtin_amdgcn_rcpf(E), BIG)); } }
            else { float G = 1.f;
#pragma unroll
                for (int j = 0; j < 32; ++j) { qd[j * 136] = (bf16_t)f2bf(qv[j] * fminf(__builtin_amdgcn_rcpf(G), BIG)); kd[j * 136] = (bf16_t)f2bf((1.f - f[j]) * G); G *= f[j]; } }
        }
    }
    __syncthreads();
    {
        const int d = wave >> 2, tr = (wave >> 1) & 1, tc = wave & 1; f32x16 acc = zero16();
#pragma unroll
        for (int ks = 0; ks < 8; ++ks) { const bf16x8 a = *(const bf16x8*)(QT + (d * 64 + tr * 32 + l31) * 136 + ks * 16 + 8 * lh), b = *(const bf16x8*)(KT + (d * 64 + tc * 32 + l31) * 136 + ks * 16 + 8 * lh); acc = mfma32(b, a, acc); }
        const int t = tr * 32 + l31;
#pragma unroll
        for (int g4 = 0; g4 < 4; ++g4) { const int sb = tc * 32 + 8 * g4 + 4 * lh; float v[4];
#pragma unroll
            for (int q = 0; q < 4; ++q) { const int s = sb + q; const bool keep = (d == 0) ? (t >= s) : (t <= s); v[q] = keep ? acc[4 * g4 + q] : 0.f; }
            u32x2 w; w.x = pk2(v[0], v[1]); w.y = pk2(v[2], v[3]); *(u32x2*)(PP + (d * 64 + t) * 72 + sb) = w; }
    }
    __syncthreads();
    {
        f32x16 acc = zero16();
#pragma unroll
        for (int d = 0; d < 2; ++d) {
#pragma unroll
            for (int ks = 0; ks < 4; ++ks) { const bf16x8 a = *(const bf16x8*)(PP + (d * 64 + th * 32 + l31) * 72 + ks * 16 + 8 * lh), b = *(const bf16x8*)(VT + (vq * 32 + l31) * 72 + ks * 16 + 8 * lh); acc = mfma32(b, a, acc); }
#pragma unroll
            for (int ks = 0; ks < 8; ++ks) { const bf16x8 a = *(const bf16x8*)(QT + (d * 64 + th * 32 + l31) * 136 + ks * 16 + 8 * lh); acc = mfma32(sfr[d][ks], a, acc); }
        }
#pragma unroll
        for (int g4 = 0; g4 < 4; ++g4) { const f32x4 o4 = {acc[4 * g4], acc[4 * g4 + 1], acc[4 * g4 + 2], acc[4 * g4 + 3]}; *(f32x4*)(OO + (th * 32 + l31) * 132 + vq * 32 + 8 * g4 + 4 * lh) = o4; }
    }
    __syncthreads();
    {
        const float* orow = OO + nt * 132 + npart * 16; float x[16]; float ss = 0.f;
#pragma unroll
        for (int j = 0; j < 4; ++j) { const f32x4 v4 = *(const f32x4*)(orow + 4 * j); x[4 * j] = v4[0]; x[4 * j + 1] = v4[1]; x[4 * j + 2] = v4[2]; x[4 * j + 3] = v4[3]; ss += (v4[0] * v4[0] + v4[1] * v4[1]) + (v4[2] * v4[2] + v4[3] * v4[3]); }
        ss += __shfl_xor(ss, 1); ss += __shfl_xor(ss, 2); ss += __shfl_xor(ss, 4);
        const float rstd = __builtin_amdgcn_rsqf(ss * (1.f / 128.f) + EPSN);
        const float* gn = p.a_norm + l * 512 + nch0;
        unsigned o[8];
#pragma unroll
        for (int q = 0; q < 8; ++q) { const unsigned gw = q < 4 ? g0[q & 3] : g1[q & 3];
            const float y0 = x[2 * q] * rstd * gn[2 * q] * __uint_as_float(gw << 16), y1 = x[2 * q + 1] * rstd * gn[2 * q + 1] * __uint_as_float(gw & 0xffff0000u); o[q] = pk2(y0, y1); }
        bf16_t* op = (bf16_t*)(p.ws + WS_OA) + (size_t)(lt0 + nt) * 1536 + nch0;
        *(u32x4*)op = (u32x4){o[0], o[1], o[2], o[3]}; *(u32x4*)(op + 8) = (u32x4){o[4], o[5], o[6], o[7]};
    }
    __syncthreads();
}

DI void scanC_ssd(CParams& p, unsigned char* lds, int l, int hf, int c, int g, int rmode = 0) {
    const int tid = get_tid(), lane = tid & 63, wave = __builtin_amdgcn_readfirstlane(tid >> 6), l31 = lane & 31, lh = lane >> 5;
    const bf16_t* PROJT = (const bf16_t*)(p.ws + WS_PROJ);
    const bf16_t* PROJG = (const bf16_t*)(p.ws + WS_PROJG);
    bf16_t* XT = (bf16_t*)lds;
    bf16_t* BM = (bf16_t*)(lds + 36864);
    bf16_t* CM = (bf16_t*)(lds + 46080);
    float* CB = (float*)(lds + 55296);
    float* ACUM = (float*)(lds + 72704);
    float* DTS = (float*)(lds + 74752);
    float* SSQ = (float*)(lds + 76800);
    float* EAC = (float*)(lds + 77824);
    const int lt0 = c * 64; bool hp, hn; chunk_halo(hf, c, hp, hn);
    const int hh = wave >> 1, th = wave & 1, head = g * 4 + hh;
    bf16x8 sfr[2][4];
    const bf16_t* SBp = (const bf16_t*)(p.ws + WS_SB) + (size_t)((c * 16 + head) * 2) * 4096 + l31 * 64 + 8 * lh;
#pragma unroll
    for (int ct = 0; ct < 2; ++ct)
#pragma unroll
        for (int ks = 0; ks < 4; ++ks) sfr[ct][ks] = *(const bf16x8*)(SBp + ct * 2048 + ks * 16);
    const int zt = tid >> 3, zpart = tid & 7;
    u32x4 zreg[4];
#pragma unroll
    for (int j = 0; j < 4; ++j) zreg[j] = *(const u32x4*)(PROJG + (size_t)(lt0 + zt) * NG + G_Z + g * 256 + zpart * 32 + 8 * j);
    bf16_t* ZT = (bf16_t*)(lds + 36864);
    bf16_t* YT = (bf16_t*)lds;
    Conv8In cin[6];
#ifdef PROBE_SSD
    if (rmode != 5)
#endif
    {
#pragma unroll
    for (int r = 0; r < 4; ++r) { const int it = tid + r * NTHR, cl = it >> 3, sg = it & 7; cin[r] = conv8_load(PROJT, lt0, sg, g * 256 + cl, hp, hn); }
#pragma unroll
    for (int r = 0; r < 2; ++r) { const int it = tid + r * NTHR, nn = it >> 3, sg = it & 7; const int isC = nn >> 6, n = nn & 63; cin[4 + r] = conv8_load(PROJT, lt0, sg, 1024 + isC * 256 + g * 64 + n, hp, hn); }
    }
    {
        const int d = wave & 1; float dt, a, ac, total; ssd_dt(p, PROJT, l, lt0, head, d, lane, dt, a, ac, total);
        const float av = (d == 0) ? ac : (total - ac + a); ACUM[wave * 64 + lane] = av; DTS[wave * 64 + lane] = dt; EAC[wave * 64 + lane] = __expf(av);
    }
#ifdef PROBE_SSD
    if (rmode != 5)
#endif
    {
#pragma unroll
    for (int r = 0; r < 4; ++r) { const int it = tid + r * NTHR, cl = it >> 3, sg = it & 7; float y[8]; conv8_math(cin[r], sg, lds, cl, y); *(u32x4*)(XT + cl * 72 + sg * 8) = pack8(y); }
#pragma unroll
    for (int r = 0; r < 2; ++r) { const int it = tid + r * NTHR, nn = it >> 3, sg = it & 7; const int isC = nn >> 6, n = nn & 63; float y[8]; conv8_math(cin[4 + r], sg, lds, 256 + nn, y);
        bf16_t* dst = (isC ? CM : BM) + (sg * 8) * 72 + n;
#pragma unroll
        for (int j = 0; j < 8; ++j) dst[j * 72] = (bf16_t)f2bf(y[j]); }
    }
    __syncthreads();
    if (wave < 4) { const int tr = wave >> 1, tc = wave & 1; f32x16 acc = zero16();
#pragma unroll
        for (int ks = 0; ks < 4; ++ks) { const bf16x8 a = *(const bf16x8*)(CM + (tr * 32 + l31) * 72 + ks * 16 + 8 * lh), b = *(const bf16x8*)(BM + (tc * 32 + l31) * 72 + ks * 16 + 8 * lh); acc = mfma32(a, b, acc); }
#pragma unroll
        for (int i = 0; i < 16; ++i) { const int t = tr * 32 + 8 * (i >> 2) + 4 * lh + (i & 3); CB[t * 68 + tc * 32 + l31] = acc[i]; }
    }
    __syncthreads();
    f32x16 acc[2]; acc[0] = zero16(); acc[1] = zero16();
    {
        const int t = th * 32 + l31;
#pragma unroll 1
        for (int d = 0; d < 2; ++d) { const int combo = hh * 2 + d;
#ifdef PROBE_SSD
            if (rmode == 4) break;
#endif
            bf16x8 nxt[2][4];
            if (d == 0) {
#pragma unroll
            for (int ct = 0; ct < 2; ++ct)
#pragma unroll
                for (int ks = 0; ks < 4; ++ks) nxt[ct][ks] = *(const bf16x8*)(SBp + 4096 + ct * 2048 + ks * 16);
            }
            const float at = ACUM[combo * 64 + t];
#pragma unroll
            for (int ks = 0; ks < 4; ++ks) { if ((d == 0 && th == 0 && ks >= 2) || (d == 1 && th == 1 && ks < 2)) continue;
                const int s0 = ks * 16 + 8 * lh; float m[8];
                const f32x4 c0 = *(const f32x4*)(CB + t * 68 + s0), c1 = *(const f32x4*)(CB + t * 68 + s0 + 4);
                const f32x4 a0 = *(const f32x4*)(ACUM + combo * 64 + s0), a1 = *(const f32x4*)(ACUM + combo * 64 + s0 + 4);
                const f32x4 d0 = *(const f32x4*)(DTS + combo * 64 + s0), d1 = *(const f32x4*)(DTS + combo * 64 + s0 + 4);
#pragma unroll
                for (int j = 0; j < 8; ++j) { const int s = s0 + j; const bool keep = (d == 0) ? (t >= s) : (t <= s); const float cbv = j < 4 ? c0[j & 3] : c1[j & 3], as = j < 4 ? a0[j & 3] : a1[j & 3], ds = j < 4 ? d0[j & 3] : d1[j & 3];
                    m[j] = keep ? cbv * __expf(fminf(at - as, 0.f)) * ds : 0.f; }
                u32x4 o; o.x = pk2(m[0], m[1]); o.y = pk2(m[2], m[3]); o.z = pk2(m[4], m[5]); o.w = pk2(m[6], m[7]); const bf16x8 a = __builtin_bit_cast(bf16x8, o);
#pragma unroll
                for (int ct = 0; ct < 2; ++ct) { const bf16x8 b = *(const bf16x8*)(XT + (hh * 64 + ct * 32 + l31) * 72 + s0); acc[ct] = mfma32(a, b, acc[ct]); } }
            f32x16 acc2[2]; acc2[0] = zero16(); acc2[1] = zero16();
#pragma unroll
            for (int ks = 0; ks < 4; ++ks) { const bf16x8 a = *(const bf16x8*)(CM + (th * 32 + l31) * 72 + ks * 16 + 8 * lh);
#pragma unroll
                for (int ct = 0; ct < 2; ++ct) acc2[ct] = mfma32(a, sfr[ct][ks], acc2[ct]); }
#pragma unroll
            for (int g4 = 0; g4 < 4; ++g4) { const f32x4 sc4 = *(const f32x4*)(EAC + combo * 64 + th * 32 + 8 * g4 + 4 * lh);
#pragma unroll
                for (int q = 0; q < 4; ++q) { const int i = 4 * g4 + q; acc[0][i] += sc4[q] * acc2[0][i]; acc[1][i] += sc4[q] * acc2[1][i]; } }
#pragma unroll
            for (int ct = 0; ct < 2; ++ct)
#pragma unroll
                for (int ks = 0; ks < 4; ++ks) sfr[ct][ks] = nxt[ct][ks];
        }
    }
    __syncthreads();
#pragma unroll
    for (int j = 0; j < 4; ++j) *(u32x4*)(ZT + zt * 264 + zpart * 32 + 8 * j) = zreg[j];
    __syncthreads();
    {
        const float dsk = p.d_skip[l * 16 + head]; float part[16];
#pragma unroll
        for (int g4 = 0; g4 < 4; ++g4) { const int tb = th * 32 + 8 * g4 + 4 * lh;
            const u32x2 xr0 = *(const u32x2*)(XT + (hh * 64 + l31) * 72 + tb), xr1 = *(const u32x2*)(XT + (hh * 64 + 32 + l31) * 72 + tb);
#pragma unroll
            for (int q = 0; q < 4; ++q) { const int i = 4 * g4 + q, ti = tb + q; float pt = 0.f;
#pragma unroll
                for (int ct = 0; ct < 2; ++ct) { const int pc = ct * 32 + l31; const unsigned xw = (ct == 0) ? (q < 2 ? xr0.x : xr0.y) : (q < 2 ? xr1.x : xr1.y);
                    const float xv = __uint_as_float((q & 1) ? (xw & 0xffff0000u) : (xw << 16)); const float z = bf2f(ZT[ti * 264 + hh * 64 + pc]);
                    const float y = (acc[ct][i] + dsk * xv) * z;   acc[ct][i] = y; pt += y * y; }
                part[i] = pt; } }
        const bool b4 = (l31 & 16) != 0, b3 = (l31 & 8) != 0, b2 = (l31 & 4) != 0, b1 = (l31 & 2) != 0;
        float p8[8], p4[4], p2[2], p1;
#pragma unroll
        for (int j = 0; j < 8; ++j) { const float snd = b4 ? part[j] : part[j + 8], kp = b4 ? part[j + 8] : part[j]; p8[j] = kp + __shfl_xor(snd, 16); }
#pragma unroll
        for (int j = 0; j < 4; ++j) { const float snd = b3 ? p8[j] : p8[j + 4], kp = b3 ? p8[j + 4] : p8[j]; p4[j] = kp + __shfl_xor(snd, 8); }
#pragma unroll
        for (int j = 0; j < 2; ++j) { const float snd = b2 ? p4[j] : p4[j + 2], kp = b2 ? p4[j + 2] : p4[j]; p2[j] = kp + __shfl_xor(snd, 4); }
        { const float snd = b1 ? p2[0] : p2[1], kp = b1 ? p2[1] : p2[0]; p1 = kp + __shfl_xor(snd, 2); }
        p1 += __shfl_xor(p1, 1);
        const int irow = l31 >> 1; const int tir = th * 32 + 8 * (irow >> 2) + 4 * lh + (irow & 3);
        if ((l31 & 1) == 0) SSQ[hh * 64 + tir] = p1;
    }
    __syncthreads();
    {
        const int irow = l31 >> 1; const int tir = th * 32 + 8 * (irow >> 2) + 4 * lh + (irow & 3);
        const float myr = __builtin_amdgcn_rsqf(((SSQ[tir] + SSQ[64 + tir]) + (SSQ[128 + tir] + SSQ[192 + tir])) * (1.f / 256.f) + EPSN);
        const float gn0 = p.b_norm[l * 1024 + g * 256 + hh * 64 + l31], gn1 = p.b_norm[l * 1024 + g * 256 + hh * 64 + 32 + l31];
#pragma unroll
        for (int i = 0; i < 16; ++i) { const int ti = th * 32 + 8 * (i >> 2) + 4 * lh + (i & 3); const float rstd = __shfl(myr, lh * 32 + 2 * i);
            YT[ti * 264 + hh * 64 + l31] = (bf16_t)f2bf(acc[0][i] * rstd * gn0); YT[ti * 264 + hh * 64 + 32 + l31] = (bf16_t)f2bf(acc[1][i] * rstd * gn1); }
    }
    __syncthreads();
    {
        bf16_t* YB = (bf16_t*)(p.ws + WS_OA) + (size_t)(lt0 + zt) * 1536 + 512 + g * 256 + zpart * 32;
#pragma unroll
        for (int j = 0; j < 4; ++j) {
#ifdef PROBE_SSD
            if (rmode >= 3) break;
#endif
            *(u32x4*)(YB + 8 * j) = *(const u32x4*)(YT + zt * 264 + zpart * 32 + 8 * j); }
    }
    __syncthreads();
}
DI void phase_scanC(CParams& p, unsigned char* lds, int l, int hf, int bid, int nb, int rmode = 0) {
    int cwg = -1; const int tid0 = get_tid();
    for (int it = bid; it < 2 * NCH * 4; it += nb) {
        if ((rmode == 1 || rmode >= 3) && it < NCH * 4) continue; if (rmode == 2 && it >= NCH * 4) continue;
#ifndef NO_C_HGRN
        if (it < NCH * 4) scanC_hgrn(p, lds, l, hf, it >> 2, it & 3);
#endif
#ifndef NO_C_SSD
        if (it >= NCH * 4) { const int j = it - NCH * 4, g = j & 3; if (g != cwg) { __syncthreads(); cw_fill(p, lds, l, g, tid0); __syncthreads(); cwg = g; } scanC_ssd(p, lds, l, hf, j >> 2, g, rmode); }
#endif
    }
}

template <class Epi> DI void run_gemm(unsigned char* lds, const bf16_t* A, const bf16_t* Bt, int M, int N, int K, const Epi& E, int bid, int nb) {
    asm volatile("" : "+s"(N), "+s"(K), "+s"(M));
    pg8::Gemm g{A, Bt, M, N, K}; pg8::StaticOrder S; S.init(M, N, nb, bid);
    pg8::gemm_phase<Epi, pg8::StaticOrder, false>((PG8_LAS unsigned char*)lds, g, S, E, nullptr);
    __syncthreads();
}

DI void run_phase(CParams& p, unsigned char* lds, int ph, int bid, int nb, int rmode = 0) {
    unsigned char* ws = p.ws;
    if (ph == 0) { phase_init(p, lds, bid, nb); __syncthreads(); phase_wconv(p, lds, 0, bid, nb, 0, WC_NIT); return; }
    if (ph == 89) { phase_final_norm(p, bid, nb); return; }
    const int q = ph - 1; const int lh2 = q / 11, sub = q % 11; const int l = lh2 >> 1, hf = lh2 & 1;
    const float* MODL = (const float*)(ws + WS_MOD) + (size_t)l * 5 * 6144;
    const unsigned char* wl = ws + ((l & 1) ? WS_W2OFS : 0);
#ifndef PH_MASK
#define PH_MASK 0xFFFF
#endif
#define PH_ON(i) ((PH_MASK >> (i)) & 1)
    switch (sub) {
    case 0: if (PH_ON(0)) { if (hf == 0 && l == 0) phase_norm(p, 0, 0, 0, bid, nb); } break;
    case 1: if (PH_ON(1)) { pg8::EpiBf16Act E1{(bf16_t*)(ws + WS_PROJ), HT, 2, 0, 9999}; run_gemm(lds, (const bf16_t*)(wl + WS_WIN), (const bf16_t*)(ws + WS_U), NTROW, HT, 1024, E1, bid, nb);
              pg8::EpiBf16Act E2{(bf16_t*)(ws + WS_PROJG), NG, 0, 6, 6}; run_gemm(lds, (const bf16_t*)(ws + WS_U), (const bf16_t*)(wl + WS_WIN) + (size_t)NTROW * 1024, HT, NG, 1024, E2, bid, nb); } break;
    case 2: if (PH_ON(2)) phase_scanA(p, lds, l, hf, bid, nb, rmode); break;
    case 3: if (PH_ON(3)) phase_scanB(p, l, hf, bid, nb); break;
    case 4: if (PH_ON(4)) phase_scanC(p, lds, l, hf, bid, nb, rmode); break;
    case 5: if (PH_ON(5)) { wconv_side(p, lds, l, hf, bid, nb, 0, 3700); pg8::EpiGateMerge E{(bf16_t*)(ws + WS_U), (const bf16_t*)(ws + WS_PROJG), NG, G_GATE, G_GATE + 1024};
              run_gemm(lds, (const bf16_t*)(ws + WS_OA), (const bf16_t*)(wl + WS_WBRA), HT, 1024, 1536, E, bid, nb); } break;
    case 6: if (PH_ON(6)) { wconv_side(p, lds, l, hf, bid, nb, 3700, 5400); pg8::EpiResid E{p.out, MODL + 2048, hf * HT, l == 0 ? p.x_prompt : nullptr, l == 0 ? p.x_sample : nullptr}; run_gemm(lds, (const bf16_t*)(ws + WS_U), (const bf16_t*)(wl + WS_WOUT), HT, 1024, 1024, E, bid, nb); } break;
    case 7: if (PH_ON(7)) phase_norm(p, l, hf, 1, bid, nb); break;
    case 8: if (PH_ON(8)) { pg8::EpiBf16<0> E{(bf16_t*)(ws + WS_PROJ), NUP, nullptr, 0, 0}; run_gemm(lds, (const bf16_t*)(ws + WS_U), (const bf16_t*)(wl + WS_WUP), HT, NUP, 1024, E, bid, nb); } break;
    case 9: if (PH_ON(9)) phase_convact(p, l, hf, bid, nb); break;
    case 10: if (PH_ON(10)) { wconv_side(p, lds, l, hf, bid, nb, 5400, WC_NIT); pg8::EpiResid E{p.out, MODL + 5120, hf * HT, nullptr, nullptr}; run_gemm(lds, (const bf16_t*)(ws + WS_SA), (const bf16_t*)(wl + WS_WDN), HT, 1024, DFF, E, bid, nb);
               if (lh2 < 7) phase_norm(p, (lh2 + 1) >> 1, (lh2 + 1) & 1, 0, bid, nb); } break;
    }
}
constexpr int NPHASE = 90;

#define LAS __attribute__((address_space(3)))
#define XB_TMO      128
#define XB_XCNT(j)  (256  + 64 * (j))
#define XB_XSUB(j)  (1280 + 64 * (j))
#define XB_XGEN(j)  (2304 + 64 * (j))
#define XB_TOP      3328
#define XB_TOPGEN   3392
#define XCD_BAR_WORDS 3456
#define XB_SPIN_CAP (1u << 18)

__device__ __forceinline__ unsigned xb_ld(unsigned* p)              { return __hip_atomic_load(p, __ATOMIC_RELAXED, __HIP_MEMORY_SCOPE_AGENT); }
__device__ __forceinline__ unsigned xb_add(unsigned* p, unsigned v) { return __hip_atomic_fetch_add(p, v, __ATOMIC_RELAXED, __HIP_MEMORY_SCOPE_AGENT); }
__device__ __forceinline__ unsigned xb_xcc_id() { return (unsigned)__builtin_amdgcn_s_getreg((3 << 11) | 20) & 0xFu; }
#define XB_SPIN(cond, bar) do { unsigned _sp = 0; while (cond) { __builtin_amdgcn_s_sleep(1); \
    if ((++_sp & 255u) == 0u) { if (xb_ld(&(bar)[XB_TMO])) break; if (_sp > XB_SPIN_CAP) { atomicAdd(&(bar)[XB_TMO], 1u); break; } } } } while (0)

struct XcdBarrier {
    unsigned* bar; unsigned x;
    volatile LAS unsigned* st;
};

__device__ __forceinline__ XcdBarrier xcd_barrier_post(unsigned* bar, volatile LAS unsigned* st) {
    XcdBarrier b; b.bar = bar; b.x = xb_xcc_id(); b.st = st;
    if (threadIdx.x == 0) (void)xb_add(&bar[XB_XCNT(b.x)], 1u);
    return b;
}
__device__ __forceinline__ void xcd_barrier_complete(unsigned* bar, unsigned x, unsigned& nloc, unsigned& nx) {
    const unsigned G = gridDim.x * gridDim.y * gridDim.z;
    unsigned sum, cnt, mine, sp = 0u;
    for (;;) {
        sum = 0u; cnt = 0u; mine = 0u;
#pragma unroll
        for (unsigned j = 0; j < 16; ++j) { const unsigned c = xb_ld(&bar[XB_XCNT(j)]); sum += c; cnt += (c > 0u) ? 1u : 0u; mine = (j == x) ? c : mine; }
        if (sum == G) break;
        __builtin_amdgcn_s_sleep(1);
        if ((++sp & 255u) == 0u) { if (xb_ld(&bar[XB_TMO])) break; if (sp > XB_SPIN_CAP) { atomicAdd(&bar[XB_TMO], 1u); break; } }
    }
    nloc = mine > 0u ? mine : 1u; nx = cnt > 0u ? cnt : 1u;
}

__device__ __forceinline__ void xcd_barrier(const XcdBarrier& b) {
    asm volatile("s_waitcnt vmcnt(0)" ::: "memory");
    __syncthreads();
    if (threadIdx.x == 0) {
        unsigned* bar = b.bar;
        __builtin_amdgcn_s_waitcnt(0);
        unsigned nloc = b.st[0], nx = b.st[1];
        if (nloc == 0u) { xcd_barrier_complete(bar, b.x, nloc, nx); b.st[0] = nloc; b.st[1] = nx; }
        const unsigned old = xb_add(&bar[XB_XSUB(b.x)], 1u);
        const unsigned gen = old / nloc;
        if (old + 1u == (gen + 1u) * nloc) {
            __builtin_amdgcn_fence(__ATOMIC_RELEASE, "agent");
            asm volatile("s_waitcnt vmcnt(0)" ::: "memory");
            const unsigned og = xb_add(&bar[XB_TOP], 1u);
            const unsigned tg = og / nx;
            if (og + 1u == (tg + 1u) * nx) xb_add(&bar[XB_TOPGEN], 1u);
            else XB_SPIN(xb_ld(&bar[XB_TOPGEN]) == tg, bar);
            __builtin_amdgcn_fence(__ATOMIC_ACQUIRE, "agent");
            xb_add(&bar[XB_XGEN(b.x)], 1u);
            asm volatile("s_waitcnt vmcnt(0)" ::: "memory");
        } else {
            XB_SPIN(xb_ld(&bar[XB_XGEN(b.x)]) == gen, bar);
            __builtin_amdgcn_fence(__ATOMIC_ACQUIRE, "agent");
            asm volatile("s_waitcnt vmcnt(0)" ::: "memory");
        }
    }
    __syncthreads();
}

constexpr size_t WS_BAR = 3 * MiB + 512 * 1024;
__global__ void __launch_bounds__(512, 2) mega_fwd(Params p_unused) {
    extern __shared__ __attribute__((aligned(16))) unsigned char lds[];
    const int bid = blockIdx.x, nb = gridDim.x;
    CParams* pk = (CParams*)__builtin_amdgcn_kernarg_segment_ptr();
    volatile LAS unsigned* st = (volatile LAS unsigned*)((LAS unsigned char*)lds + 131072);
    if (threadIdx.x == 0) { st[0] = 0u; st[1] = 0u; }
    __syncthreads();
    unsigned* barw = (unsigned*)(pk->ws + WS_BAR);
    if (bid == 0) { for (int i = threadIdx.x; i < XCD_BAR_WORDS; i += NTHR) barw[i] = 0u; }
    {
        CParams* q = pk; asm volatile("" : "+s"(q));
        run_phase(*q, lds, 0, bid, nb);
    }
    cg::this_grid().sync();
    (void)xcd_barrier_post(barw, st);
    for (int ph = 1; ph < NPHASE; ++ph) {
        if (ph > 1 && ph < 89 && (ph - 1) % 11 == 0) continue;
        CParams* q = pk; int z_ = 0, b_ = bid, n_ = nb; asm volatile("" : "+s"(q), "+s"(z_), "+s"(b_), "+s"(n_));
        run_phase(*q, lds + z_, ph, b_, n_);
#ifndef RPT_MODE
#define RPT_MODE 0
#endif
#ifdef RPT_MASK
        if (ph < 89 && ((RPT_MASK >> ((ph - 1) % 11)) & 1)) { { XcdBarrier xb; xb.bar = (unsigned*)(q->ws + WS_BAR); xb.x = xb_xcc_id(); xb.st = st; xcd_barrier(xb); }
            CParams* q2 = pk; int z2_ = 0, b2_ = bid, n2_ = nb; asm volatile("" : "+s"(q2), "+s"(z2_), "+s"(b2_), "+s"(n2_)); run_phase(*q2, lds + z2_, ph, b2_, n2_, RPT_MODE); }
#endif
#ifdef RPT_AB
        if (ph < 89 && ((ph - 1) % 11) == 3) { for (int rr = 0; rr < 2; ++rr) { { XcdBarrier xb; xb.bar = (unsigned*)(q->ws + WS_BAR); xb.x = xb_xcc_id(); xb.st = st; xcd_barrier(xb); }
            CParams* q2 = pk; int z2_ = 0, b2_ = bid, n2_ = nb; asm volatile("" : "+s"(q2), "+s"(z2_), "+s"(b2_), "+s"(n2_)); run_phase(*q2, lds + z2_, ph - 1 + rr, b2_, n2_, 0); } }
#endif
        if (ph + 1 < NPHASE) { XcdBarrier xb; xb.bar = (unsigned*)(q->ws + WS_BAR); xb.x = xb_xcc_id(); xb.st = st; xcd_barrier(xb); }
    }
}

constexpr int LDS_BYTES = 131072 + 256;
extern "C" void kernel_launch(void* const* d_in, const int* in_sizes, int n_in, void* d_out, int out_size, void* d_ws, size_t ws_size, hipStream_t stream) {
    static int grid = 0;
    if (grid == 0) {
        if (n_in != 27 || ws_size < WS_END) { fprintf(stderr, "kernel_launch: unexpected n_in %d / ws_size %zu\n", n_in, ws_size); grid = -1; return; }
        int dev = 0, cus = 0, per_cu = 0;
        hipGetDevice(&dev); hipDeviceGetAttribute(&cus, hipDeviceAttributeMultiprocessorCount, dev);
        if (hipFuncSetAttribute((const void*)mega_fwd, hipFuncAttributeMaxDynamicSharedMemorySize, LDS_BYTES) != hipSuccess) { fprintf(stderr, "hipFuncSetAttribute failed\n"); grid = -1; return; }
        if (hipOccupancyMaxActiveBlocksPerMultiprocessor(&per_cu, (const void*)mega_fwd, 512, LDS_BYTES) != hipSuccess || per_cu < 1) { fprintf(stderr, "occupancy query: %d\n", per_cu); per_cu = 1; }
        (void)hipGetLastError();
        grid = cus * 1;
    }
    if (grid < 0) return;
    Params p{};
    const float** pp = (const float**)&p;
    for (int i = 0; i < 27; ++i) pp[i] = (const float*)d_in[i];
    p.out = (float*)d_out; p.ws = (unsigned char*)d_ws;
    p.ph_lo = 0; p.ph_hi = NPHASE;
    void* args[] = {&p};
    hipError_t e = hipLaunchCooperativeKernel((const void*)mega_fwd, dim3(grid), dim3(512), args, LDS_BYTES, stream);
    if (e != hipSuccess) fprintf(stderr, "cooperative launch failed: %s (grid %d)\n", hipGetErrorString(e), grid);
}
```

```cpp
#include <hip/hip_runtime.h>
#include <hip/hip_cooperative_groups.h>
#include <cstdio>
namespace cg = cooperative_groups;
#define MULTI 0
namespace pg8 {
#define PG8_LAS __attribute__((address_space(3)))
typedef unsigned short bf16_t;
typedef short bf16x8 __attribute__((ext_vector_type(8)));
typedef float f32x4 __attribute__((ext_vector_type(4)));
typedef unsigned u32x4 __attribute__((ext_vector_type(4)));
constexpr int BM = 256, BK = 64, HALF = 128, HTB = HALF * BK * 2  , STAGE_BYTES = 8 * HTB, NXCD = 8, WGM = 8;

__host__ __device__ __forceinline__ int lds_byte(int r, int c) { const int st = (r >> 4) * 2 + (c >> 5), rr = r & 15, cc = c & 31, ob = rr * 64 + cc * 2; return st * 1024 + (ob ^ (((ob >> 9) & 1) << 5)); }
__host__ __device__ __forceinline__ void stage_rc(int b, int& R, int& C) { const int st = b / 1024, sb = b % 1024, swz = sb ^ (((sb >> 9) & 1) << 5); R = (st >> 1) * 16 + swz / 64; C = (st & 1) * 32 + (swz % 64) / 2; }
__host__ __device__ __forceinline__ int perm32(int rho) { const int n = rho >> 4, i = rho & 15; return 8 * (i >> 2) + 4 * n + (i & 3); }

struct Unit { int pm, pn; };
struct Gemm { const bf16_t* A; const bf16_t* Bt; int M, N, K; };

struct StaticOrder {
    int nM, nN, nwg, G, c;
    __host__ __device__ void init(int M, int N, int G_, int c_) { nM = M / BM; nN = N / BM; nwg = nM * nN; G = G_; c = c_; }
    __host__ __device__ bool next(int i, Unit& u) const {
        const long L = (long)i * G + c; if (L >= nwg) return false;
        int wgid = (int)L; { const int q = nwg / NXCD, r = nwg % NXCD, xcd = wgid % NXCD, off = wgid / NXCD; wgid = (xcd < r ? xcd * (q + 1) : r * (q + 1) + (xcd - r) * q) + off; }
        const int nig = WGM * nN, gid = wgid / nig, fm = gid * WGM, gsz = (nM - fm) < WGM ? (nM - fm) : WGM;
        u.pm = fm + ((wgid % nig) % gsz); u.pn = (wgid % nig) / gsz; return true;
    }
    __device__ __forceinline__ void a_ready(const Unit&) const {}
    __device__ __forceinline__ void done(const Unit&) const {}
};
__device__ __forceinline__ unsigned cvt_pk_bf16(float lo, float hi) { unsigned r; asm volatile("v_cvt_pk_bf16_f32 %0, %1, %2" : "=v"(r) : "v"(lo), "v"(hi)); return r; }
typedef float f32x2 __attribute__((ext_vector_type(2)));
__device__ __forceinline__ f32x2 gelu_pk(f32x2 v) {
    const f32x2 av = __builtin_elementwise_abs(v), d = av * 0.2316418882f + 1.0f;
    f32x2 t; t.x = __builtin_amdgcn_rcpf(d.x); t.y = __builtin_amdgcn_rcpf(d.y);
    f32x2 q = t * 0.5307027145f + (-0.7265760135f); q = q * t + 0.7107068705f; q = q * t + (-0.142248368f); q = q * t + 0.127414796f; q = q * t;
    const f32x2 s = (v * v) * (-0.72134752044f);
    f32x2 e; e.x = __builtin_amdgcn_exp2f(s.x); e.y = __builtin_amdgcn_exp2f(s.y);
    const f32x2 m = v * (q * e), r = v - m;
    f32x2 o; o.x = v.x < 0.f ? m.x : r.x; o.y = v.y < 0.f ? m.y : r.y; return o;
}
template <int ACT  > struct EpiBf16 {
    static constexpr bool PERM = true, AFTER_DRAIN = false; static constexpr int TMID = -1;
    bf16_t* O; int ldc; const float* bias; int split_cols; size_t split_stride;
    __device__ __forceinline__ void operator()(const f32x4 (&acc)[2][2][4][2], const Unit& u, int wr, int wc, int fr, int fq) const {
        const int row0 = u.pm * BM + wr * 64 + fr; int colt = u.pn * BM; bf16_t* base = O;
        if (split_cols) { const int t = colt / split_cols; base += (size_t)t * split_stride; colt -= t * split_cols; }
        const int col0 = colt + wc * 32 + 8 * fq, bcol0 = u.pn * BM + wc * 32 + 8 * fq;
        f32x4 bv[2][2];
#pragma unroll
        for (int bj = 0; bj < 2; ++bj)
#pragma unroll
            for (int n = 0; n < 2; ++n) bv[bj][n] = bias ? *(const f32x4*)(bias + bcol0 + bj * HALF + 4 * n) : (f32x4){0.f, 0.f, 0.f, 0.f};
#pragma unroll
        for (int ai = 0; ai < 2; ++ai)
#pragma unroll
            for (int m = 0; m < 4; ++m) { bf16_t* rowp = base + (size_t)(row0 + ai * HALF + m * 16) * ldc + col0;
#pragma unroll
                for (int bj = 0; bj < 2; ++bj) { f32x4 v0 = acc[ai][bj][m][0] + bv[bj][0], v1 = acc[ai][bj][m][1] + bv[bj][1];
                    if (ACT == 1) { f32x2 a = gelu_pk((f32x2){v0[0], v0[1]}), b = gelu_pk((f32x2){v0[2], v0[3]}), c = gelu_pk((f32x2){v1[0], v1[1]}), d = gelu_pk((f32x2){v1[2], v1[3]});
                        v0 = (f32x4){a.x, a.y, b.x, b.y}; v1 = (f32x4){c.x, c.y, d.x, d.y}; }
                    if (ACT == 2) {
#pragma unroll
                        for (int j = 0; j < 4; ++j) { v0[j] = 0.5f * v0[j] * (1.0f + erff(v0[j] * 0.70710678f)); v1[j] = 0.5f * v1[j] * (1.0f + erff(v1[j] * 0.70710678f)); } }
                    u32x4 w; w.x = cvt_pk_bf16(v0[0], v0[1]); w.y = cvt_pk_bf16(v0[2], v0[3]); w.z = cvt_pk_bf16(v1[0], v1[1]); w.w = cvt_pk_bf16(v1[2], v1[3]);
                    *(u32x4*)(rowp + bj * HALF) = w; } }
    }
};
__device__ __forceinline__ float epi_bf2f(unsigned short b) { return __uint_as_float(((unsigned)b) << 16); }
__device__ __forceinline__ float epi_sigmoid(float x) { return __builtin_amdgcn_rcpf(1.f + __expf(-x)); }
typedef unsigned u32x2 __attribute__((ext_vector_type(2)));
struct EpiBf16Act {
    static constexpr bool PERM = true, AFTER_DRAIN = false; static constexpr int TMID = -1;
    bf16_t* O; int ldc; int silu_pm_lt, silu_pn_lt, sig_pn_ge;
    __device__ __forceinline__ void operator()(const f32x4 (&acc)[2][2][4][2], const Unit& u, int wr, int wc, int fr, int fq) const {
        const int row0 = u.pm * BM + wr * 64 + fr, col0 = u.pn * BM + wc * 32 + 8 * fq;
        int act = 0; if (u.pm < silu_pm_lt) act = 1; if (u.pn < silu_pn_lt) act = 1; else if (u.pn >= sig_pn_ge) act = 2;
#pragma unroll
        for (int ai = 0; ai < 2; ++ai)
#pragma unroll
            for (int m = 0; m < 4; ++m) { bf16_t* rowp = O + (size_t)(row0 + ai * HALF + m * 16) * ldc + col0;
#pragma unroll
                for (int bj = 0; bj < 2; ++bj) { f32x4 v0 = acc[ai][bj][m][0], v1 = acc[ai][bj][m][1];
                    if (act) {
#pragma unroll
                        for (int j = 0; j < 4; ++j) { const float s0 = __builtin_amdgcn_rcpf(1.f + __expf(-v0[j])), s1 = __builtin_amdgcn_rcpf(1.f + __expf(-v1[j]));
                            v0[j] = (act == 1) ? v0[j] * s0 : s0; v1[j] = (act == 1) ? v1[j] * s1 : s1; } }
                    u32x4 w; w.x = cvt_pk_bf16(v0[0], v0[1]); w.y = cvt_pk_bf16(v0[2], v0[3]); w.z = cvt_pk_bf16(v1[0], v1[1]); w.w = cvt_pk_bf16(v1[2], v1[3]);
                    *(u32x4*)(rowp + bj * HALF) = w; } }
    }
};
struct EpiGateMerge {
    static constexpr bool PERM = false, AFTER_DRAIN = false; static constexpr int TMID = 8;
    bf16_t* O; const bf16_t* G; int ldg; int goffA, goffB;
    __device__ __forceinline__ void mid(f32x4 (&acc)[2][2][4][2], const Unit& u, int wr, int wc, int fr, int fq) const {
        int row0 = u.pm * BM + wr * 64 + fr, col0 = u.pn * BM + wc * 32 + 4 * fq;
        asm volatile("" : "+v"(row0), "+v"(col0));
#pragma unroll
        for (int ai = 0; ai < 2; ++ai)
#pragma unroll
            for (int m = 0; m < 4; ++m) { const int row = row0 + ai * HALF + m * 16; const bf16_t* gp = G + (size_t)row * ldg + col0;
#pragma unroll
                for (int bj = 0; bj < 2; ++bj)
#pragma unroll
                    for (int n = 0; n < 2; ++n) { const u32x2 ga = *(const u32x2*)(gp + goffA + bj * HALF + n * 16), gb = *(const u32x2*)(gp + goffB + bj * HALF + n * 16);
                        const float a0 = __uint_as_float(ga.x << 16), a1 = __uint_as_float(ga.x & 0xffff0000u), a2 = __uint_as_float(ga.y << 16), a3 = __uint_as_float(ga.y & 0xffff0000u);
                        const float b0 = __uint_as_float(gb.x << 16), b1 = __uint_as_float(gb.x & 0xffff0000u), b2 = __uint_as_float(gb.y << 16), b3 = __uint_as_float(gb.y & 0xffff0000u);
                        f32x4 r; r[0] = a0 * __builtin_amdgcn_rcpf(b0); r[1] = a1 * __builtin_amdgcn_rcpf(b1); r[2] = a2 * __builtin_amdgcn_rcpf(b2); r[3] = a3 * __builtin_amdgcn_rcpf(b3);
                        acc[ai][bj][m][n] = acc[ai][bj][m][n] * r; }
                asm volatile("" ::: "memory"); }
    }
    __device__ __forceinline__ void operator()(const f32x4 (&acc)[2][2][4][2], const Unit& u, int wr, int wc, int fr, int fq) const {
        const int row0 = u.pm * BM + wr * 64 + fr, col0 = u.pn * BM + wc * 32 + 4 * fq;
#pragma unroll
        for (int ai = 0; ai < 2; ++ai)
#pragma unroll
            for (int m = 0; m < 4; ++m) { const int row = row0 + ai * HALF + m * 16; bf16_t* op = O + (size_t)row * 1024 + col0; const bf16_t* gp = G + (size_t)row * ldg + goffB + col0;
#pragma unroll
                for (int bj = 0; bj < 2; ++bj)
#pragma unroll
                    for (int n = 0; n < 2; ++n) { const u32x2 gw = *(const u32x2*)(gp + bj * HALF + n * 16); const f32x4 a = acc[ai][bj][m][n]; f32x4 o;
                        o[0] = a[0] * __uint_as_float(gw.x << 16); o[1] = a[1] * __uint_as_float(gw.x & 0xffff0000u);
                        o[2] = a[2] * __uint_as_float(gw.y << 16); o[3] = a[3] * __uint_as_float(gw.y & 0xffff0000u);
                        u32x2 w; w.x = cvt_pk_bf16(o[0], o[1]); w.y = cvt_pk_bf16(o[2], o[3]);
                        *(u32x2*)(op + bj * HALF + n * 16) = w; } }
    }
};
struct EpiResid {
    static constexpr bool PERM = false, AFTER_DRAIN = false; static constexpr int TMID = -1;
    float* X; const float* MODG; int rowbase; const float* Xp; const float* Xs;
    __device__ __forceinline__ void operator()(const f32x4 (&acc)[2][2][4][2], const Unit& u, int wr, int wc, int fr, int fq) const {
        const int row0 = rowbase + u.pm * BM + wr * 64 + fr, col0 = u.pn * BM + wc * 32 + 4 * fq;
        const int tok0 = rowbase + u.pm * BM; const int grp = tok0 < 8192 ? 0 : 1 + ((tok0 - 8192) >> 12);
        const float* src = Xp ? (tok0 < 8192 ? Xp : Xs - (size_t)8192 * 1024) : X;
        const float* gv = MODG + (size_t)grp * 6144 + col0;
        f32x4 g[2][2];
#pragma unroll
        for (int bj = 0; bj < 2; ++bj)
#pragma unroll
            for (int n = 0; n < 2; ++n) g[bj][n] = *(const f32x4*)(gv + bj * HALF + n * 16);
#pragma unroll
        for (int ai = 0; ai < 2; ++ai)
#pragma unroll
            for (int m = 0; m < 4; ++m) { float* rowp = X + (size_t)(row0 + ai * HALF + m * 16) * 1024 + col0; const float* srcp = src + (size_t)(row0 + ai * HALF + m * 16) * 1024 + col0;
#pragma unroll
                for (int bj = 0; bj < 2; ++bj)
#pragma unroll
                    for (int n = 0; n < 2; ++n) { f32x4 x = *(const f32x4*)(srcp + bj * HALF + n * 16); x = x + g[bj][n] * acc[ai][bj][m][n]; *(f32x4*)(rowp + bj * HALF + n * 16) = x; } }
    }
};
template <class Epi, class Sched, bool STAMP = false>
__device__ __forceinline__ void gemm_phase(PG8_LAS unsigned char* lds, const Gemm g, const Sched& S, const Epi& E, unsigned long long* stamps) {
    int tid_l = threadIdx.x; asm volatile("" : "+v"(tid_l)); const int tid = tid_l, wid = __builtin_amdgcn_readfirstlane(tid >> 6), lane = tid & 63, wr = wid >> 2, wc = wid & 3, fr = lane & 15, fq = lane >> 4;
    const int K = g.K, nt = K / BK;
    int ts_lo = 0, ts_hi = 0, nts = 0; const unsigned long long rt_entry = STAMP ? (unsigned long long)wall_clock64() : 0ull;
#define PG8_STAMP() do { if (STAMP && wid == 0 && nts < 64) { const unsigned long long _c = (unsigned long long)clock64(); \
        ts_lo = (lane == nts) ? (int)(unsigned)_c : ts_lo; ts_hi = (lane == nts) ? (int)(unsigned)(_c >> 32) : ts_hi; ++nts; } } while (0)
    PG8_STAMP();
    unsigned voffA[2], voffB[2];
#pragma unroll
    for (int i = 0; i < 2; ++i) { int R, C; stage_rc(tid * 16 + i * 8192, R, C); const int Rb = Epi::PERM ? ((R & ~31) + perm32(R & 31)) : R;
        voffA[i] = (unsigned)(R * K + C) * 2u; voffB[i] = (unsigned)(Rb * K + C) * 2u; }
    const size_t kstep = (size_t)(BK * 2);
    const size_t hstep = (size_t)HALF * K * 2;
    const size_t tstep = 2 * hstep;
    const unsigned ldsw = (unsigned)wid * 1024u;
    const int aoff = lds_byte(wr * 64 + fr, fq * 8), boff = lds_byte(wc * 32 + fr, fq * 8);
#define PG8_SA(b, h) (((b) * 2 + (h)) * HTB)
#define PG8_SB(b, h) ((4 + (b) * 2 + (h)) * HTB)
#define PG8_STAGE(bufoff, gbase, voff) do { _Pragma("unroll") for (int _i = 0; _i < 2; ++_i) \
        __builtin_amdgcn_global_load_lds((const unsigned*)((const char*)(gbase) + (voff)[_i]), (PG8_LAS unsigned*)(lds + (bufoff) + ldsw + _i * 8192), 16, 0, 0); } while (0)
#define PG8_LDA(dst, b, h) do { _Pragma("unroll") for (int m = 0; m < 4; ++m) _Pragma("unroll") for (int k = 0; k < 2; ++k) dst[m][k] = *(const PG8_LAS bf16x8*)(lds + PG8_SA(b, h) + aoff + m * 2048 + k * 1024); } while (0)
#define PG8_LDB(dst, b, h) do { _Pragma("unroll") for (int n = 0; n < 2; ++n) _Pragma("unroll") for (int k = 0; k < 2; ++k) dst[n][k] = *(const PG8_LAS bf16x8*)(lds + PG8_SB(b, h) + boff + n * 2048 + k * 1024); } while (0)
#define PG8_MMA(ai, bj, At, Bt) do { __builtin_amdgcn_s_setprio(1); _Pragma("unroll") for (int m = 0; m < 4; ++m) _Pragma("unroll") for (int n = 0; n < 2; ++n) _Pragma("unroll") for (int k = 0; k < 2; ++k) \
        acc[ai][bj][m][n] = __builtin_amdgcn_mfma_f32_16x16x32_bf16(Bt[n][k], At[m][k], acc[ai][bj][m][n], 0, 0, 0); __builtin_amdgcn_s_setprio(0); } while (0)
#define PG8_WAIT_V(n) asm volatile("s_waitcnt vmcnt(" #n ")" ::: "memory")
#define PG8_WAIT_L(n) asm volatile("s_waitcnt lgkmcnt(" #n ")" ::: "memory")
#define PG8_BAR __builtin_amdgcn_s_barrier()
#define PG8_SCHED __builtin_amdgcn_sched_barrier(0)
    Unit cur, nxt; int ui = 0;
    if (!S.next(0, cur)) return;
    f32x4 acc[2][2][4][2];
#pragma unroll
    for (int a = 0; a < 2; ++a)
#pragma unroll
        for (int b = 0; b < 2; ++b)
#pragma unroll
            for (int m = 0; m < 4; ++m)
#pragma unroll
                for (int n = 0; n < 2; ++n) acc[a][b][m][n] = (f32x4){0.f, 0.f, 0.f, 0.f};
    bf16x8 At[4][2], B0[2][2], B1[2][2];
    const char* cA = (const char*)g.A + (size_t)cur.pm * tstep; const char* cB = (const char*)g.Bt + (size_t)cur.pn * tstep;
    S.a_ready(cur);
    PG8_STAGE(PG8_SB(0, 0), cB, voffB); PG8_STAGE(PG8_SB(0, 1), cB + hstep, voffB); PG8_STAGE(PG8_SA(0, 0), cA, voffA); PG8_STAGE(PG8_SA(0, 1), cA + hstep, voffA);
    if (wr == 1) PG8_BAR;
    PG8_WAIT_V(2); PG8_BAR;
    PG8_STAGE(PG8_SB(1, 0), cB + kstep, voffB); PG8_STAGE(PG8_SA(1, 0), cA + kstep, voffA); PG8_STAGE(PG8_SB(1, 1), cB + hstep + kstep, voffB);
    PG8_WAIT_V(6); PG8_BAR;
    PG8_STAMP();
    for (;;) {
        const bool has_next = S.next(ui + 1, nxt);
        const char* nA = has_next ? (const char*)g.A + (size_t)nxt.pm * tstep : cA; const char* nB = has_next ? (const char*)g.Bt + (size_t)nxt.pn * tstep : cB;
        for (int t = 0; t < nt; t += 2) {
            const bool last = (t == nt - 2);
            const char* a1 = cA + (size_t)(t + 1) * kstep;
            const char* a2 = last ? nA : cA + (size_t)(t + 2) * kstep; const char* b2 = last ? nB : cB + (size_t)(t + 2) * kstep;
            const char* a3 = a2 + kstep; const char* b3 = b2 + kstep;
            if (last && has_next) S.a_ready(nxt);
            if constexpr (Epi::TMID >= 0) { if (t == Epi::TMID) E.mid(acc, cur, wr, wc, fr, fq); }
            PG8_LDB(B0, 0, 0); PG8_LDB(B1, 0, 1); PG8_SCHED; PG8_LDA(At, 0, 0); PG8_STAGE(PG8_SA(1, 1), a1 + hstep, voffA);
            PG8_WAIT_V(8); PG8_WAIT_L(0); PG8_BAR; PG8_MMA(0, 0, At, B0); PG8_MMA(0, 1, At, B1); PG8_BAR; PG8_SCHED;
            PG8_LDA(At, 0, 1); PG8_STAGE(PG8_SB(0, 0), b2, voffB); PG8_STAGE(PG8_SB(0, 1), b2 + hstep, voffB); PG8_STAGE(PG8_SA(0, 0), a2, voffA);
            PG8_WAIT_V(8); PG8_WAIT_L(0); PG8_BAR; PG8_MMA(1, 0, At, B0); PG8_MMA(1, 1, At, B1); PG8_BAR; PG8_SCHED;
            PG8_LDB(B0, 1, 0); PG8_LDB(B1, 1, 1); PG8_SCHED; PG8_LDA(At, 1, 0); PG8_STAGE(PG8_SA(0, 1), a2 + hstep, voffA);
            PG8_WAIT_V(8); PG8_WAIT_L(0); PG8_BAR; PG8_MMA(0, 0, At, B0); PG8_MMA(0, 1, At, B1); PG8_BAR; PG8_SCHED;
            PG8_LDA(At, 1, 1); PG8_STAGE(PG8_SB(1, 0), b3, voffB); PG8_STAGE(PG8_SB(1, 1), b3 + hstep, voffB); PG8_STAGE(PG8_SA(1, 0), a3, voffA);
            PG8_WAIT_V(8); PG8_WAIT_L(0); PG8_BAR; PG8_MMA(1, 0, At, B0); PG8_MMA(1, 1, At, B1); PG8_BAR; PG8_SCHED;
        }
        PG8_STAMP();
        if (wr == 0) PG8_BAR;
        if constexpr (!Epi::AFTER_DRAIN) { E(acc, cur, wr, wc, fr, fq); S.done(cur); }
        PG8_STAMP();
        if (!has_next) break;
#pragma unroll
        for (int a = 0; a < 2; ++a)
#pragma unroll
            for (int b = 0; b < 2; ++b)
#pragma unroll
                for (int m = 0; m < 4; ++m)
#pragma unroll
                    for (int n = 0; n < 2; ++n) acc[a][b][m][n] = (f32x4){0.f, 0.f, 0.f, 0.f};
        cur = nxt; cA = nA; cB = nB; ++ui;
        if (wr == 1) PG8_BAR;
    }
    PG8_WAIT_V(0);
    PG8_BAR;
    if constexpr (Epi::AFTER_DRAIN) { E.fused(acc, cur, wr, wc, fr, fq, lds, wid, lane); S.done(cur); }
    PG8_STAMP();
    if (STAMP && wid == 0) { stamps[lane] = lane < nts ? (((unsigned long long)(unsigned)ts_hi << 32) | (unsigned)ts_lo) : 0ull;
        if (lane == 62) stamps[62] = rt_entry; if (lane == 63) stamps[63] = (unsigned long long)wall_clock64(); }
#undef PG8_STAMP
#undef PG8_SA
#undef PG8_SB
#undef PG8_STAGE
#undef PG8_LDA
#undef PG8_LDB
#undef PG8_MMA
#undef PG8_WAIT_V
#undef PG8_WAIT_L
#undef PG8_BAR
#undef PG8_SCHED
}
}

#ifndef MULTI
#define MULTI 0
#endif
#define DI __device__ __forceinline__
typedef unsigned short bf16_t;
typedef short bf16x8 __attribute__((ext_vector_type(8)));
typedef float f32x4 __attribute__((ext_vector_type(4)));
typedef float f32x16 __attribute__((ext_vector_type(16)));
typedef unsigned u32x4 __attribute__((ext_vector_type(4)));
typedef unsigned u32x2 __attribute__((ext_vector_type(2)));

constexpr int DM = 1024, NLAYER = 4, NP = 7424, NIN = 7200, DFF = 2816, NUP = 5632;
constexpr int TTOK = 24576, HT = 12288, NCH = 192;
constexpr int C_Q = 0, C_V = 512, C_F = 1024, C_GA = 2048, C_Z = 2560, C_XBC = 3584, C_DT = 5120, C_GATE = 5152;
constexpr float EPSN = 1e-6f;
constexpr int NTHR = 512;

constexpr size_t MiB = 1u << 20;
constexpr size_t WS_MOD = 0;
constexpr size_t WS_LB = 512 * 1024;
constexpr size_t WS_DECA = 1 * MiB;
constexpr size_t WS_DECB = 3 * MiB;
constexpr size_t WS_WIN = 4 * MiB;
constexpr size_t WS_WBRA = 19 * MiB;
constexpr size_t WS_WBRB = 20 * MiB;
constexpr size_t WS_WOUT = 22 * MiB;
constexpr size_t WS_WUP = 24 * MiB;
constexpr size_t WS_WDN = 35 * MiB;
constexpr size_t WS_U = 41 * MiB;
constexpr size_t WS_OA = 65 * MiB;
constexpr size_t WS_YB = 77 * MiB;
constexpr size_t WS_SA = 101 * MiB;
constexpr size_t WS_SB = 149 * MiB;
constexpr size_t WS_PROJ = 197 * MiB;
constexpr size_t WS_W2OFS = 368 * MiB;
constexpr size_t WS_END = 410 * MiB;

struct Params {
    const float *x_prompt, *x_sample, *c, *state_hgrn, *state_ssd, *c_ctx, *w_ada, *b_ada, *ln1, *ln2, *ln_f, *w_in, *lb_logits, *a_norm,
        *conv_w, *conv_b, *dt_bias, *a_log, *d_skip, *b_norm, *w_br_a, *w_br_b, *w_out, *w_ff_up, *ff_conv_w, *ff_conv_b, *w_ff_down;
    float* out; unsigned char* ws; int ph_lo, ph_hi;
};
typedef const __attribute__((address_space(4))) Params CParams;
constexpr size_t OUT_SH = (size_t)TTOK * DM;
constexpr size_t OUT_SS = OUT_SH + (size_t)32 * 4 * 2 * 4 * 128 * 128;

DI int get_tid() { int t = threadIdx.x; asm volatile("" : "+v"(t)); return t; }
DI float bf2f(bf16_t b) { return __uint_as_float(((unsigned)b) << 16); }
typedef __bf16 hwbf16x2 __attribute__((ext_vector_type(2)));
typedef float f32x2v __attribute__((ext_vector_type(2)));
DI unsigned pk2(float lo, float hi) { const f32x2v v = {lo, hi}; const hwbf16x2 b = __builtin_convertvector(v, hwbf16x2); return __builtin_bit_cast(unsigned, b); }
DI unsigned f2bf(float f) { return pk2(f, 0.f) & 0xffffu; }
DI void unpack8(const u32x4 r, float* o) { o[0] = __uint_as_float(r.x << 16); o[1] = __uint_as_float(r.x & 0xffff0000u); o[2] = __uint_as_float(r.y << 16); o[3] = __uint_as_float(r.y & 0xffff0000u);
    o[4] = __uint_as_float(r.z << 16); o[5] = __uint_as_float(r.z & 0xffff0000u); o[6] = __uint_as_float(r.w << 16); o[7] = __uint_as_float(r.w & 0xffff0000u); }
DI u32x4 pack8(const float* y) { u32x4 o; o.x = pk2(y[0], y[1]); o.y = pk2(y[2], y[3]); o.z = pk2(y[4], y[5]); o.w = pk2(y[6], y[7]); return o; }
DI float sigm(float x) { return __builtin_amdgcn_rcpf(1.f + __expf(-x)); }
DI float silu(float x) { return x * __builtin_amdgcn_rcpf(1.f + __expf(-x)); }
DI float wave_sum(float v) {
#pragma unroll
    for (int o = 1; o < 64; o <<= 1) v += __shfl_xor(v, o);
    return v;
}
DI f32x16 mfma32(bf16x8 a, bf16x8 b, f32x16 c) { return __builtin_amdgcn_mfma_f32_32x32x16_bf16(a, b, c, 0, 0, 0); }
DI f32x16 zero16() { f32x16 z;
#pragma unroll
    for (int i = 0; i < 16; ++i) z[i] = 0.f; return z; }

struct SeqInfo { int first, nch, latent, batch; };
DI SeqInfo seq_of(int hf, int sq) { SeqInfo s; if (hf == 0) { if (sq < 32) { s.first = 4 * sq; s.nch = 4; s.latent = 0; s.batch = sq; } else { s.first = 128; s.nch = 64; s.latent = 1; s.batch = 0; } }
    else { s.first = 64 * sq; s.nch = 64; s.latent = 1; s.batch = 1 + sq; } return s; }
DI void chunk_halo(int hf, int c, bool& has_prev, bool& has_next) { const bool ctx = (hf == 0 && c < 128); has_prev = ctx && ((c & 3) != 0); has_next = ctx && ((c & 3) != 3); }

DI void phase_init(CParams& p, unsigned char* lds, int bid, int nb) {
    const int tid = get_tid();
    float* MOD = (float*)(p.ws + WS_MOD);
    float* CV = (float*)lds;
    float* RED = (float*)(lds + 20480);
    for (int i = tid; i < 5 * 1024; i += NTHR) { const int g = i >> 10, k = i & 1023; const float v = (g == 0) ? p.c_ctx[k] : p.c[(g - 1) * 1024 + k]; CV[i] = silu(v); }
    __syncthreads();
    for (int item = bid; item < 4 * 48; item += nb) {
        const int l = item / 48, jb = item % 48; const int jj = tid & 31, kp = tid >> 5;
        const float* W = p.w_ada + (size_t)l * 1024 * 6144 + (size_t)(kp * 64) * 6144 + jb * 128 + jj * 4;
        const float fz_ = __uint_as_float((unsigned)(tid >> 31)); f32x4 a0 = {fz_, fz_, fz_, fz_}, a1 = a0, a2 = a0, a3 = a0, a4 = a0;
#pragma unroll 8
        for (int k = 0; k < 64; ++k) { const f32x4 w = *(const f32x4*)(W + (size_t)k * 6144); const int kk = kp * 64 + k;
            a0 += w * CV[kk]; a1 += w * CV[1024 + kk]; a2 += w * CV[2048 + kk]; a3 += w * CV[3072 + kk]; a4 += w * CV[4096 + kk]; }
        float* r = RED + (kp * 5) * 128 + jj * 4;
        *(f32x4*)(r) = a0; *(f32x4*)(r + 128) = a1; *(f32x4*)(r + 256) = a2; *(f32x4*)(r + 384) = a3; *(f32x4*)(r + 512) = a4;
        __syncthreads();
        for (int o = tid; o < 640; o += NTHR) { const int g = o >> 7, col = o & 127; float s = p.b_ada[l * 6144 + jb * 128 + col];
#pragma unroll
            for (int q = 0; q < 16; ++q) s += RED[(q * 5 + g) * 128 + col];
            MOD[(size_t)(l * 5 + g) * 6144 + jb * 128 + col] = s; }
        __syncthreads();
    }
    if (bid == nb - 1) {
        float* LB = (float*)(p.ws + WS_LB);
        for (int i = tid; i < 1024; i += NTHR) { float v[4], mx = -1e30f;
#pragma unroll
            for (int l = 0; l < 4; ++l) { v[l] = p.lb_logits[l * 1024 + i]; mx = fmaxf(mx, v[l]); }
            float s = 0.f;
#pragma unroll
            for (int l = 0; l < 4; ++l) { v[l] = __expf(v[l] - mx); s += v[l]; }
            const float inv = 1.f / s; float cum = 0.f; LB[i] = 0.f;
#pragma unroll
            for (int l = 1; l < 4; ++l) { cum += v[l] * inv; LB[l * 1024 + i] = fmaxf(cum, 0.f); } }
    }
}

template <bool REMAP> DI void transpose_item(const float* W, int K, int N, bf16_t* WT, float* scr, int item, int lane, int ldk = 0, int koff = 0) {
    if (ldk == 0) ldk = K;
    const int nblk = N / 32, kb = item / nblk, nbk = item % nblk, k0 = 64 * kb, n0 = 32 * nbk;
    const int r0 = !REMAP ? n0 : (n0 < 2048 ? n0 : (n0 < 3584 ? 3840 + (n0 - 2048) : (n0 < 5152 ? 2048 + (n0 - 3584) : 3840 + 1536 + (n0 - 5152))));
#pragma unroll 8
    for (int i = 0; i < 32; ++i) { const int kk = 2 * i + (lane >> 5); scr[kk * 33 + (lane & 31)] = W[(size_t)(k0 + kk) * N + n0 + (lane & 31)]; }
    asm volatile("s_waitcnt lgkmcnt(0)" ::: "memory");
    const int c = lane & 7;
#pragma unroll
    for (int j = 0; j < 4; ++j) { const int n = (lane >> 3) + 8 * j; const float* s = scr + (8 * c) * 33 + n;
        u32x4 o; o.x = pk2(s[0 * 33], s[1 * 33]); o.y = pk2(s[2 * 33], s[3 * 33]); o.z = pk2(s[4 * 33], s[5 * 33]); o.w = pk2(s[6 * 33], s[7 * 33]);
        *(u32x4*)(WT + (size_t)(r0 + n) * ldk + koff + k0 + 8 * c) = o; }
    asm volatile("s_waitcnt lgkmcnt(0)" ::: "memory");
}
constexpr int WC_IN = 16 * 225, WC_A = 8 * 32, WC_B = 16 * 32, WC_O = 16 * 32, WC_U = 16 * 176, WC_D = 44 * 32;
constexpr int WC_NIT = WC_IN + WC_A + WC_B + WC_O + WC_U + WC_D;
DI void phase_wconv(CParams& p, unsigned char* lds, int l, int vb, int nvb, int it_lo, int it_hi) {
    const int tid = get_tid(), lane = tid & 63, wave = __builtin_amdgcn_readfirstlane(tid >> 6);
    float* scr = (float*)(lds + wave * 8704);
    const int gw = vb * 8 + wave, NGW = nvb * 8;
    unsigned char* ws = p.ws + ((l & 1) ? WS_W2OFS : 0);
    for (int it = it_lo + gw; it < it_hi; it += NGW) {
        int r = it;
        if (r < WC_IN) { transpose_item<true>(p.w_in + (size_t)l * 1024 * NIN, 1024, NIN, (bf16_t*)(ws + WS_WIN), scr, r, lane); continue; } r -= WC_IN;
        if (r < WC_A) { transpose_item<false>(p.w_br_a + (size_t)l * 512 * 1024, 512, 1024, (bf16_t*)(ws + WS_WBRA), scr, r, lane, 1536, 0); continue; } r -= WC_A;
        if (r < WC_B) { transpose_item<false>(p.w_br_b + (size_t)l * 1024 * 1024, 1024, 1024, (bf16_t*)(ws + WS_WBRA), scr, r, lane, 1536, 512); continue; } r -= WC_B;
        if (r < WC_O) { transpose_item<false>(p.w_out + (size_t)l * 1024 * 1024, 1024, 1024, (bf16_t*)(ws + WS_WOUT), scr, r, lane); continue; } r -= WC_O;
        if (r < WC_U) { transpose_item<false>(p.w_ff_up + (size_t)l * 1024 * NUP, 1024, NUP, (bf16_t*)(ws + WS_WUP), scr, r, lane); continue; } r -= WC_U;
        transpose_item<false>(p.w_ff_down + (size_t)l * DFF * 1024, DFF, 1024, (bf16_t*)(ws + WS_WDN), scr, r, lane);
    }
    if (it_lo == 0) {
        u32x4* z = (u32x4*)((bf16_t*)(ws + WS_WIN) + (size_t)3616 * 1024); const int nz = (3840 - 3616) * 1024 / 8;
        const unsigned uz_ = (unsigned)(tid >> 31);
        for (int i = vb * NTHR + tid; i < nz; i += nvb * NTHR) z[i] = (u32x4){uz_, uz_, uz_, uz_};
    }
    __syncthreads();
}
DI void wconv_side(CParams& p, unsigned char* lds, int l, int hf, int bid, int nb, int it_lo, int it_hi) {
    if (l >= 3) return;
    if (nb > 192) { if (bid >= 192) phase_wconv(p, lds, l + 1, bid - 192, nb - 192, it_lo, it_hi); }
    else phase_wconv(p, lds, l + 1, bid, nb, it_lo, it_hi);
}

DI void phase_norm(CParams& p, int l, int hf, int which, int bid, int nb) {
    const int tid = get_tid(), lane = tid & 63, wave = __builtin_amdgcn_readfirstlane(tid >> 6);
    const float* MOD = (const float*)(p.ws + WS_MOD);
    bf16_t* U = (bf16_t*)(p.ws + WS_U);
    const float* ln = (which == 0 ? p.ln1 : p.ln2) + l * 1024;
    for (int r = bid * 8 + wave; r < HT; r += nb * 8) {
        const int tok = hf * HT + r; const int grp = tok < 8192 ? 0 : 1 + ((tok - 8192) >> 12);
        const float* md = MOD + (size_t)(l * 5 + grp) * 6144 + which * 3072;
        const float* xsrc = (l == 0 && which == 0) ? (tok < 8192 ? p.x_prompt + (size_t)tok * 1024 : p.x_sample + (size_t)(tok - 8192) * 1024) : p.out + (size_t)tok * 1024;
        const f32x4* xr = (const f32x4*)xsrc + lane;
        f32x4 v[4]; float s = 0.f;
#pragma unroll
        for (int j = 0; j < 4; ++j) { v[j] = xr[64 * j]; s += (v[j].x * v[j].x + v[j].y * v[j].y) + (v[j].z * v[j].z + v[j].w * v[j].w); }
        const float rstd = __builtin_amdgcn_rsqf(wave_sum(s) * (1.f / 1024.f) + EPSN);
        unsigned long long* o8 = (unsigned long long*)(U + (size_t)r * 1024) + lane;
#pragma unroll
        for (int j = 0; j < 4; ++j) { const int col = 4 * (64 * j + lane);
            const f32x4 g = *(const f32x4*)(ln + col), sh = *(const f32x4*)(md + col), sc = *(const f32x4*)(md + 1024 + col);
            const f32x4 y = v[j] * rstd * g * (sc + 1.f) + sh;
            o8[64 * j] = (unsigned long long)pk2(y.x, y.y) | ((unsigned long long)pk2(y.z, y.w) << 32); }
    }
}
DI void phase_final_norm(CParams& p, int bid, int nb) {
    const int tid = get_tid(), lane = tid & 63, wave = __builtin_amdgcn_readfirstlane(tid >> 6);
    for (int r = bid * 8 + wave; r < TTOK; r += nb * 8) {
        f32x4* xr = (f32x4*)(p.out + (size_t)r * 1024) + lane;
        f32x4 v[4]; float s = 0.f;
#pragma unroll
        for (int j = 0; j < 4; ++j) { v[j] = xr[64 * j]; s += (v[j].x * v[j].x + v[j].y * v[j].y) + (v[j].z * v[j].z + v[j].w * v[j].w); }
        const float rstd = __builtin_amdgcn_rsqf(wave_sum(s) * (1.f / 1024.f) + EPSN);
#pragma unroll
        for (int j = 0; j < 4; ++j) { const int col = 4 * (64 * j + lane); const f32x4 g = *(const f32x4*)(p.ln_f + col); xr[64 * j] = v[j] * rstd * g; }
    }
}

DI void phase_convact(CParams& p, int l, int hf, int bid, int nb) {
    const bf16_t* H = (const bf16_t*)(p.ws + WS_PROJ); bf16_t* ACT = (bf16_t*)(p.ws + WS_SA);
    const float* cw = p.ff_conv_w + (size_t)l * 3 * NUP; const float* cb = p.ff_conv_b + (size_t)l * NUP;
    const int tid = get_tid();
    constexpr int NRUN = HT / 32, NITEM = 352 * NRUN, PER_BLK = (NITEM + 255) / 256;
    for (int li = tid; li < PER_BLK; li += NTHR) { const int it = bid * PER_BLK + li; if (it >= NITEM) break;
        const int cg8 = (it % 352) * 8, t0 = (it / 352) * 32;
        const bool latent = (hf == 1) || (t0 >= 8192); const int per = latent ? 64 : 256;
        const bool hp = (t0 & (per - 1)) != 0, hn = ((t0 + 31) & (per - 1)) != per - 1;
        float w[2][3][8], bs[2][8];
#pragma unroll
        for (int hh = 0; hh < 2; ++hh) { const int col = hh * DFF + cg8;
#pragma unroll
            for (int k = 0; k < 3; ++k) { const f32x4 a = *(const f32x4*)(cw + k * NUP + col), b = *(const f32x4*)(cw + k * NUP + col + 4);
#pragma unroll
                for (int j = 0; j < 4; ++j) { w[hh][k][j] = a[j]; w[hh][k][4 + j] = b[j]; } }
            const f32x4 a = *(const f32x4*)(cb + col), b = *(const f32x4*)(cb + col + 4);
#pragma unroll
            for (int j = 0; j < 4; ++j) { bs[hh][j] = a[j]; bs[hh][4 + j] = b[j]; } }
        const bf16_t* ha = H + (size_t)t0 * NUP + cg8; const bf16_t* hb = ha + DFF;
        const unsigned uz_ = (unsigned)(tid >> 31); const u32x4 z4 = {uz_, uz_, uz_, uz_};
        u32x4 am = hp ? *(const u32x4*)(ha - NUP) : z4, bm = hp ? *(const u32x4*)(hb - NUP) : z4;
        u32x4 a0 = *(const u32x4*)ha, b0 = *(const u32x4*)hb;
#pragma unroll 4
        for (int t = 0; t < 32; ++t) {
            const bool more = (t < 31) || hn;
            const u32x4 ap = more ? *(const u32x4*)(ha + (size_t)(t + 1) * NUP) : z4, bp = more ? *(const u32x4*)(hb + (size_t)(t + 1) * NUP) : z4;
            float xa[3][8], xb[3][8]; unpack8(am, xa[0]); unpack8(a0, xa[1]); unpack8(ap, xa[2]); unpack8(bm, xb[0]); unpack8(b0, xb[1]); unpack8(bp, xb[2]);
            float r[8];
#pragma unroll
            for (int j = 0; j < 8; ++j) { const float va = bs[0][j] + w[0][0][j] * xa[0][j] + w[0][1][j] * xa[1][j] + w[0][2][j] * xa[2][j];
                const float vb = bs[1][j] + w[1][0][j] * xb[0][j] + w[1][1][j] * xb[1][j] + w[1][2][j] * xb[2][j]; r[j] = silu(va) * vb; }
            *(u32x4*)(ACT + (size_t)(t0 + t) * DFF + cg8) = pack8(r);
            am = a0; a0 = ap; bm = b0; b0 = bp;
        }
    }
}

constexpr int TQ = 0, TV = 512, TF = 1024, TX = 2048, TDT = 3584, NTROW = 3840;
constexpr int G_GA = 0, G_Z = 512, G_GATE = 1536, NG = 3584;
constexpr size_t WS_PROJG = WS_PROJ + (size_t)NTROW * HT * 2;
DI void hgrn_gates(const u32x4 (&raw)[4], float lb, float* SUMS, int d, int sh, int k, float (&f)[32], float& PA, float& PB) {
    const float oml = 1.f - lb; float loc = 1.f;
#pragma unroll
    for (int j = 0; j < 4; ++j) unpack8(raw[j], &f[8 * j]);
#pragma unroll
    for (int j = 0; j < 32; ++j) { f[j] = fmaxf(lb + oml * sigm(f[j]), 1e-30f); loc *= f[j]; }
    SUMS[(d * 2 + sh) * 128 + k] = loc;
    __syncthreads();
    PA = SUMS[(d * 2) * 128 + k]; PB = SUMS[(d * 2 + 1) * 128 + k];
}
DI void stage_vt(const bf16_t* PROJT, int lt0, int h, bf16_t* VT, int tid) {
#pragma unroll
    for (int r = 0; r < 2; ++r) { const int idx = tid + 512 * r, v = idx >> 3, o = idx & 7;
        *(u32x4*)(VT + v * 72 + o * 8) = *(const u32x4*)(PROJT + (size_t)(TV + h * 128 + v) * HT + lt0 + o * 8); }
}

DI void scanA_hgrn(CParams& p, unsigned char* lds, int l, int hf, int c, int h) {
    const int tid = get_tid(), lane = tid & 63, wave = __builtin_amdgcn_readfirstlane(tid >> 6), l31 = lane & 31, lh = lane >> 5;
    const bf16_t* PROJT = (const bf16_t*)(p.ws + WS_PROJ);
    bf16_t* KH = (bf16_t*)lds;
    bf16_t* VT = (bf16_t*)(lds + 36864);
    float* SUMS = (float*)(lds + 55296);
    const int lt0 = c * 64;
    {
        const int d = tid >> 8, sh = (tid >> 7) & 1, k = tid & 127;
        const bf16_t* fp = PROJT + (size_t)(TF + d * 512 + h * 128 + k) * HT + lt0 + sh * 32;
        u32x4 raw[4];
#pragma unroll
        for (int j = 0; j < 4; ++j) raw[j] = *(const u32x4*)(fp + 8 * j);
        const float lb = ((const float*)(p.ws + WS_LB))[(l * 2 + d) * 512 + h * 128 + k];
        stage_vt(PROJT, lt0, h, VT, tid);
        float f[32], PA, PB; hgrn_gates(raw, lb, SUMS, d, sh, k, f, PA, PB);
        float val[32];
        if (d == 0) { float suf = sh ? 1.f : PB;
#pragma unroll
            for (int j = 31; j >= 0; --j) { val[j] = (1.f - f[j]) * suf; suf *= f[j]; } }
        else { float pre = sh ? PA : 1.f;
#pragma unroll
            for (int j = 0; j < 32; ++j) { val[j] = (1.f - f[j]) * pre; pre *= f[j]; } }
#pragma unroll
        for (int s8 = 0; s8 < 4; ++s8) *(u32x4*)(KH + (d * 128 + k) * 72 + sh * 32 + s8 * 8) = pack8(&val[s8 * 8]);
        if (sh == 0) { float* DEC = (float*)(p.ws + WS_DECA) + (size_t)((c * 4 + h) * 2 + d) * 256; DEC[k] = PA * PB; DEC[128 + k] = (d == 0) ? PA : PB; }
    }
    __syncthreads();
    {
        const int d = wave >> 2, vq = wave & 3;
        f32x16 acc[4];
#pragma unroll
        for (int i = 0; i < 4; ++i) acc[i] = zero16();
#pragma unroll
        for (int ks = 0; ks < 4; ++ks) { const bf16x8 b = *(const bf16x8*)(VT + (vq * 32 + l31) * 72 + ks * 16 + 8 * lh);
#pragma unroll
            for (int kb = 0; kb < 4; ++kb) { const bf16x8 a = *(const bf16x8*)(KH + (d * 128 + kb * 32 + l31) * 72 + ks * 16 + 8 * lh); acc[kb] = mfma32(a, b, acc[kb]); } }
        bf16_t* S = (bf16_t*)(p.ws + WS_SA) + (size_t)((c * 4 + h) * 2 + d) * 16384 + (size_t)(vq * 32 + l31) * 128;
#pragma unroll
        for (int kb = 0; kb < 4; ++kb)
#pragma unroll
            for (int g = 0; g < 4; ++g) { u32x2 w; w.x = pk2(acc[kb][4 * g], acc[kb][4 * g + 1]); w.y = pk2(acc[kb][4 * g + 2], acc[kb][4 * g + 3]);
                *(u32x2*)(S + kb * 32 + 8 * g + 4 * lh) = w; }
    }
    __syncthreads();
}

DI void ssd_dt(CParams& p, const bf16_t* PROJT, int l, int lt0, int head, int d, int lane, float& dt, float& a, float& ac, float& total) {
    const float raw = bf2f(PROJT[(size_t)(TDT + d * 16 + head) * HT + lt0 + lane]) + p.dt_bias[(l * 2 + d) * 16 + head];
    dt = raw > 20.f ? raw : log1pf(__expf(raw));
    a = -__expf(p.a_log[(l * 2 + d) * 16 + head]) * dt;
    ac = a;
#pragma unroll
    for (int o = 1; o < 64; o <<= 1) { const float t = __shfl_up(ac, o); if (lane >= o) ac += t; }
    total = __shfl(ac, 63);
}
constexpr int LDS_CW = 122880;
DI int cw_xcol(int g, int cl) { return cl < 256 ? g * 256 + cl : (cl < 320 ? 1024 + g * 64 + (cl - 256) : 1280 + g * 64 + (cl - 320)); }
DI void cw_fill(CParams& p, unsigned char* lds, int l, int g, int tid) {
    if (tid < 384) { const int xcol = cw_xcol(g, tid); f32x4 w; w[0] = p.conv_w[(l * 3 + 0) * 1536 + xcol]; w[1] = p.conv_w[(l * 3 + 1) * 1536 + xcol]; w[2] = p.conv_w[(l * 3 + 2) * 1536 + xcol]; w[3] = p.conv_b[l * 1536 + xcol];
        *(f32x4*)(lds + LDS_CW + tid * 16) = w; }
}
struct Conv8In { u32x4 cur; float xm, xn; };
DI Conv8In conv8_load(const bf16_t* PROJT, int lt0, int sg, int xcol, bool has_prev, bool has_next) {
    Conv8In r; const bf16_t* xp = PROJT + (size_t)(TX + xcol) * HT + lt0 + sg * 8;
    r.cur = *(const u32x4*)xp; r.xm = 0.f; r.xn = 0.f;
    if (sg == 0 && has_prev) r.xm = bf2f(xp[-1]);
    if (sg == 7 && has_next) r.xn = bf2f(xp[8]);
    return r;
}
DI void conv8_math(const Conv8In& r, int sg, const unsigned char* lds, int cl, float* y) {
    const unsigned pw = __shfl_up(r.cur.w, 1), nx = __shfl_down(r.cur.x, 1);
    const float xm = (sg == 0) ? r.xm : __uint_as_float(pw & 0xffff0000u);
    const float xn = (sg == 7) ? r.xn : __uint_as_float(nx << 16);
    const f32x4 w = *(const f32x4*)(lds + LDS_CW + cl * 16);
    float x[10]; x[0] = xm; unpack8(r.cur, &x[1]); x[9] = xn;
#pragma unroll
    for (int j = 0; j < 8; ++j) y[j] = silu(w[3] + w[0] * x[j] + w[1] * x[j + 1] + w[2] * x[j + 2]);
}

DI void scanA_ssd(CParams& p, unsigned char* lds, int l, int hf, int c, int g) {
    const int tid = get_tid(), lane = tid & 63, wave = __builtin_amdgcn_readfirstlane(tid >> 6), l31 = lane & 31, lh = lane >> 5;
    const bf16_t* PROJT = (const bf16_t*)(p.ws + WS_PROJ);
    bf16_t* XT = (bf16_t*)lds;
    bf16_t* BT = (bf16_t*)(lds + 36864);
    float* WS_ = (float*)(lds + 46080);
    const int lt0 = c * 64; bool hp, hn; chunk_halo(hf, c, hp, hn);
    Conv8In cin[5];
#pragma unroll
    for (int r = 0; r < 5; ++r) { const int it = tid + r * NTHR, cl = it >> 3, sg = it & 7; const int xcol = cl < 256 ? g * 256 + cl : 1024 + g * 64 + (cl - 256); cin[r] = conv8_load(PROJT, lt0, sg, xcol, hp, hn); }
    {
        const int hh = wave >> 1, d = wave & 1, head = g * 4 + hh; float dt, a, ac, total; ssd_dt(p, PROJT, l, lt0, head, d, lane, dt, a, ac, total);
        WS_[wave * 64 + lane] = ((d == 0) ? __expf(total - ac) : __expf(ac - a)) * dt;
        if (lane == 0) ((float*)(p.ws + WS_DECB))[(c * 16 + head) * 2 + d] = __expf(total);
    }
#pragma unroll
    for (int r = 0; r < 5; ++r) { const int it = tid + r * NTHR, cl = it >> 3, sg = it & 7; float y[8]; conv8_math(cin[r], sg, lds, cl, y);
        *(u32x4*)((cl < 256 ? XT + cl * 72 : BT + (cl - 256) * 72) + sg * 8) = pack8(y); }
    __syncthreads();
    {
        const int hh = wave >> 1, d = wave & 1, head = g * 4 + hh;
        f32x16 acc[2][2];
#pragma unroll
        for (int i = 0; i < 2; ++i)
#pragma unroll
            for (int j = 0; j < 2; ++j) acc[i][j] = zero16();
#pragma unroll
        for (int ks = 0; ks < 4; ++ks) { const f32x4 wa = *(const f32x4*)(WS_ + wave * 64 + ks * 16 + 8 * lh), wb = *(const f32x4*)(WS_ + wave * 64 + ks * 16 + 8 * lh + 4);
            bf16x8 bs[2];
#pragma unroll
            for (int ct = 0; ct < 2; ++ct) { const u32x4 r = *(const u32x4*)(XT + (hh * 64 + ct * 32 + l31) * 72 + ks * 16 + 8 * lh); u32x4 o;
                o.x = pk2(__uint_as_float(r.x << 16) * wa[0], __uint_as_float(r.x & 0xffff0000u) * wa[1]); o.y = pk2(__uint_as_float(r.y << 16) * wa[2], __uint_as_float(r.y & 0xffff0000u) * wa[3]);
                o.z = pk2(__uint_as_float(r.z << 16) * wb[0], __uint_as_float(r.z & 0xffff0000u) * wb[1]); o.w = pk2(__uint_as_float(r.w << 16) * wb[2], __uint_as_float(r.w & 0xffff0000u) * wb[3]);
                bs[ct] = __builtin_bit_cast(bf16x8, o); }
#pragma unroll
            for (int rt = 0; rt < 2; ++rt) { const bf16x8 a = *(const bf16x8*)(BT + (rt * 32 + l31) * 72 + ks * 16 + 8 * lh);
#pragma unroll
                for (int ct = 0; ct < 2; ++ct) acc[rt][ct] = mfma32(a, bs[ct], acc[rt][ct]); } }
        bf16_t* S = (bf16_t*)(p.ws + WS_SB) + (size_t)((c * 16 + head) * 2 + d) * 4096;
#pragma unroll
        for (int rt = 0; rt < 2; ++rt)
#pragma unroll
            for (int ct = 0; ct < 2; ++ct)
#pragma unroll
                for (int q = 0; q < 4; ++q) { u32x2 w; w.x = pk2(acc[rt][ct][4 * q], acc[rt][ct][4 * q + 1]); w.y = pk2(acc[rt][ct][4 * q + 2], acc[rt][ct][4 * q + 3]);
                    *(u32x2*)(S + (ct * 32 + l31) * 64 + rt * 32 + 8 * q + 4 * lh) = w; }
    }
    __syncthreads();
}
DI void phase_scanA(CParams& p, unsigned char* lds, int l, int hf, int bid, int nb, int rmode = 0) {
    int cwg = -1; const int tid0 = get_tid();
    for (int it = bid; it < 2 * NCH * 4; it += nb) { if (rmode == 1 && it < NCH * 4) continue; if (rmode == 2 && it >= NCH * 4) continue; if (it < NCH * 4) scanA_hgrn(p, lds, l, hf, it >> 2, it & 3);
        else { const int j = it - NCH * 4, g = j & 3; if (g != cwg) { __syncthreads(); cw_fill(p, lds, l, g, tid0); __syncthreads(); cwg = g; } scanA_ssd(p, lds, l, hf, j >> 2, g); } }
}

template <int NBAT> DI void scanB_hgrn_run(bf16_t* SA, const float* DECA, const SeqInfo& si, int h, int d, int v, int k4, float (&S)[4]) {
    for (int i0 = 0; i0 < si.nch; i0 += NBAT) { u32x2 raw[NBAT]; f32x4 dec[NBAT], em[NBAT]; bf16_t* sp[NBAT];
#pragma unroll
        for (int j = 0; j < NBAT; ++j) { const int i = i0 + j; const int c = si.first + (d == 0 ? i : si.nch - 1 - i); const size_t base = (size_t)((c * 4 + h) * 2 + d);
            sp[j] = SA + base * 16384 + v * 128 + k4; raw[j] = *(const u32x2*)sp[j]; dec[j] = *(const f32x4*)(DECA + base * 256 + k4); em[j] = *(const f32x4*)(DECA + base * 256 + 128 + k4); }
#pragma unroll
        for (int j = 0; j < NBAT; ++j) { u32x2 w; w.x = pk2(S[0] * em[j][0], S[1] * em[j][1]); w.y = pk2(S[2] * em[j][2], S[3] * em[j][3]); *(u32x2*)sp[j] = w;
            S[0] = dec[j][0] * S[0] + __uint_as_float(raw[j].x << 16); S[1] = dec[j][1] * S[1] + __uint_as_float(raw[j].x & 0xffff0000u);
            S[2] = dec[j][2] * S[2] + __uint_as_float(raw[j].y << 16); S[3] = dec[j][3] * S[3] + __uint_as_float(raw[j].y & 0xffff0000u); } }
}
template <int NBAT> DI void scanB_ssd_run(bf16_t* SB, const float* DECB, const SeqInfo& si, int head, int d, int pp, int n4, f32x4& S) {
    for (int i0 = 0; i0 < si.nch; i0 += NBAT) { u32x2 raw[NBAT]; float dec[NBAT]; bf16_t* sp[NBAT];
#pragma unroll
        for (int j = 0; j < NBAT; ++j) { const int i = i0 + j; const int c = si.first + (d == 0 ? i : si.nch - 1 - i); const size_t base = (size_t)((c * 16 + head) * 2 + d);
            sp[j] = SB + base * 4096 + pp * 64 + n4; raw[j] = *(const u32x2*)sp[j]; dec[j] = DECB[base]; }
#pragma unroll
        for (int j = 0; j < NBAT; ++j) { u32x2 w; w.x = pk2(S[0], S[1]); w.y = pk2(S[2], S[3]); *(u32x2*)sp[j] = w;
            S[0] = dec[j] * S[0] + __uint_as_float(raw[j].x << 16); S[1] = dec[j] * S[1] + __uint_as_float(raw[j].x & 0xffff0000u);
            S[2] = dec[j] * S[2] + __uint_as_float(raw[j].y << 16); S[3] = dec[j] * S[3] + __uint_as_float(raw[j].y & 0xffff0000u); } }
}
DI void phase_scanB(CParams& p, int l, int hf, int bid, int nb) {
    const int nseq = hf == 0 ? 33 : 3; const int total = nseq << 15;
    const int gt = bid * NTHR + get_tid(), gs = nb * NTHR;
    bf16_t* SA = (bf16_t*)(p.ws + WS_SA); const float* DECA = (const float*)(p.ws + WS_DECA);
    for (int it = gt; it < total; it += gs) {
        const int q = it & 4095, combo = (it >> 12) & 7, sq = it >> 15; const int h = combo >> 1, d = combo & 1; const int v = q >> 5, k4 = (q & 31) * 4;
        const SeqInfo si = seq_of(hf, sq);
        const float fz_ = __uint_as_float((unsigned)(gt >> 31)); float S[4] = {fz_, fz_, fz_, fz_};
        const size_t sidx = ((size_t)(((si.batch * 4 + l) * 2 + d) * 4 + h) * 128 + k4) * 128 + v;
        if (si.latent) {
#pragma unroll
            for (int j = 0; j < 4; ++j) S[j] = p.state_hgrn[sidx + (size_t)j * 128];
            scanB_hgrn_run<8>(SA, DECA, si, h, d, v, k4, S);
        } else {
            scanB_hgrn_run<4>(SA, DECA, si, h, d, v, k4, S);
#pragma unroll
            for (int j = 0; j < 4; ++j) p.out[OUT_SH + sidx + (size_t)j * 128] = S[j]; }
    }
    bf16_t* SB = (bf16_t*)(p.ws + WS_SB); const float* DECB = (const float*)(p.ws + WS_DECB);
    for (int it = gt; it < total; it += gs) {
        const int q = it & 1023, combo = (it >> 10) & 31, sq = it >> 15; const int head = combo >> 1, d = combo & 1; const int pp = q >> 4, n4 = (q & 15) * 4;
        const SeqInfo si = seq_of(hf, sq);
        const float fz_ = __uint_as_float((unsigned)(gt >> 31)); f32x4 S = {fz_, fz_, fz_, fz_};
        const size_t sidx = ((size_t)(((si.batch * 4 + l) * 2 + d) * 16 + head) * 64 + pp) * 64 + n4;
        if (si.latent) { S = *(const f32x4*)(p.state_ssd + sidx); scanB_ssd_run<8>(SB, DECB, si, head, d, pp, n4, S); }
        else { scanB_ssd_run<4>(SB, DECB, si, head, d, pp, n4, S); *(f32x4*)(p.out + OUT_SS + sidx) = S; }
    }
}

DI void scanC_hgrn(CParams& p, unsigned char* lds, int l, int hf, int c, int h) {
    const int tid = get_tid(), lane = tid & 63, wave = __builtin_amdgcn_readfirstlane(tid >> 6), l31 = lane & 31, lh = lane >> 5;
    const bf16_t* PROJT = (const bf16_t*)(p.ws + WS_PROJ);
    const bf16_t* PROJG = (const bf16_t*)(p.ws + WS_PROJG);
    bf16_t* QT = (bf16_t*)lds;
    bf16_t* KT = (bf16_t*)(lds + 34816);
    bf16_t* VT = (bf16_t*)(lds + 69632);
    bf16_t* PP = (bf16_t*)(lds + 88064);
    float* OO = (float*)(lds + 34816);
    float* SUMS = (float*)(lds + 106496);
    const int lt0 = c * 64;
    const int th = wave & 1, vq = wave >> 1;
    bf16x8 sfr[2][8];
    const int nt = tid >> 3, npart = tid & 7, nch0 = h * 128 + npart * 16;
    const bf16_t* gp = PROJG + (size_t)(lt0 + nt) * NG + G_GA + nch0; const u32x4 g0 = *(const u32x4*)gp, g1 = *(const u32x4*)(gp + 8);
    {
        const int d = tid >> 8, sh = (tid >> 7) & 1, k = tid & 127;
        const bf16_t* fp = PROJT + (size_t)(TF + d * 512 + h * 128 + k) * HT + lt0 + sh * 32;
        const bf16_t* qp = PROJT + (size_t)(TQ + h * 128 + k) * HT + lt0 + sh * 32;
        u32x4 raw[4], qraw[4];
#pragma unroll
        for (int j = 0; j < 4; ++j) { raw[j] = *(const u32x4*)(fp + 8 * j); qraw[j] = *(const u32x4*)(qp + 8 * j); }
        const float lb = ((const float*)(p.ws + WS_LB))[(l * 2 + d) * 512 + h * 128 + k];
        stage_vt(PROJT, lt0, h, VT, tid);
        float f[32], PA, PB; hgrn_gates(raw, lb, SUMS, d, sh, k, f, PA, PB);
        {
            const bf16_t* SA = (const bf16_t*)(p.ws + WS_SA);
#pragma unroll
            for (int dd = 0; dd < 2; ++dd)
#pragma unroll
                for (int ks = 0; ks < 8; ++ks) sfr[dd][ks] = *(const bf16x8*)(SA + (size_t)((c * 4 + h) * 2 + dd) * 16384 + (size_t)(vq * 32 + l31) * 128 + ks * 16 + 8 * lh);
        }
        float qv[32];
#pragma unroll
        for (int j8 = 0; j8 < 4; ++j8) unpack8(qraw[j8], &qv[8 * j8]);
        const float BIG = 5.5e34f;
        bf16_t* qd = QT + (d * 64 + sh * 32) * 136 + k; bf16_t* kd = KT + (d * 64 + sh * 32) * 136 + k;
        if (d == 0) {
            if (sh == 0) { float R = 1.f;
#pragma unroll
                for (int j = 31; j >= 0; --j) { qd[j * 136] = (bf16_t)f2bf(qv[j] * fminf(__builtin_amdgcn_rcpf(R), BIG)); kd[j * 136] = (bf16_t)f2bf((1.f - f[j]) * R); R *= f[j]; } }
            else { float P = 1.f;
#pragma unroll
                for (int j = 0; j < 32; ++j) { P *= f[j]; qd[j * 136] = (bf16_t)f2bf(qv[j] * P); kd[j * 136] = (bf16_t)f2bf((1.f - f[j]) * fminf(__builtin_amdgcn_rcpf(P), BIG)); } }
        } else {
            if (sh == 0) { float E = 1.f;
#pragma unroll
                for (int j = 31; j >= 0; --j) { E *= f[j]; qd[j * 136] = (bf16_t)f2bf(qv[j] * E); kd[j * 136] = (bf16_t)f2bf((1.f - f[j]) * fminf(__builtin_amdgcn_rcpf(E), BIG)); } }
            else { float G = 1.f;
#pragma unroll
                for (int j = 0; j < 32; ++j) { qd[j * 136] = (bf16_t)f2bf(qv[j] * fminf(__builtin_amdgcn_rcpf(G), BIG)); kd[j * 136] = (bf16_t)f2bf((1.f - f[j]) * G); G *= f[j]; } }
        }
    }
    __syncthreads();
    {
        const int d = wave >> 2, tr = (wave >> 1) & 1, tc = wave & 1; f32x16 acc = zero16();
#pragma unroll
        for (int ks = 0; ks < 8; ++ks) { const bf16x8 a = *(const bf16x8*)(QT + (d * 64 + tr * 32 + l31) * 136 + ks * 16 + 8 * lh), b = *(const bf16x8*)(KT + (d * 64 + tc * 32 + l31) * 136 + ks * 16 + 8 * lh); acc = mfma32(b, a, acc); }
        const int t = tr * 32 + l31;
#pragma unroll
        for (int g4 = 0; g4 < 4; ++g4) { const int sb = tc * 32 + 8 * g4 + 4 * lh; float v[4];
#pragma unroll
            for (int q = 0; q < 4; ++q) { const int s = sb + q; const bool keep = (d == 0) ? (t >= s) : (t <= s); v[q] = keep ? acc[4 * g4 + q] : 0.f; }
            u32x2 w; w.x = pk2(v[0], v[1]); w.y = pk2(v[2], v[3]); *(u32x2*)(PP + (d * 64 + t) * 72 + sb) = w; }
    }
    __syncthreads();
    {
        f32x16 acc = zero16();
#pragma unroll
        for (int d = 0; d < 2; ++d) {
#pragma unroll
            for (int ks = 0; ks < 4; ++ks) { const bf16x8 a = *(const bf16x8*)(PP + (d * 64 + th * 32 + l31) * 72 + ks * 16 + 8 * lh), b = *(const bf16x8*)(VT + (vq * 32 + l31) * 72 + ks * 16 + 8 * lh); acc = mfma32(b, a, acc); }
#pragma unroll
            for (int ks = 0; ks < 8; ++ks) { const bf16x8 a = *(const bf16x8*)(QT + (d * 64 + th * 32 + l31) * 136 + ks * 16 + 8 * lh); acc = mfma32(sfr[d][ks], a, acc); }
        }
#pragma unroll
        for (int g4 = 0; g4 < 4; ++g4) { const f32x4 o4 = {acc[4 * g4], acc[4 * g4 + 1], acc[4 * g4 + 2], acc[4 * g4 + 3]}; *(f32x4*)(OO + (th * 32 + l31) * 132 + vq * 32 + 8 * g4 + 4 * lh) = o4; }
    }
    __syncthreads();
    {
        const float* orow = OO + nt * 132 + npart * 16; float x[16]; float ss = 0.f;
#pragma unroll
        for (int j = 0; j < 4; ++j) { const f32x4 v4 = *(const f32x4*)(orow + 4 * j); x[4 * j] = v4[0]; x[4 * j + 1] = v4[1]; x[4 * j + 2] = v4[2]; x[4 * j + 3] = v4[3]; ss += (v4[0] * v4[0] + v4[1] * v4[1]) + (v4[2] * v4[2] + v4[3] * v4[3]); }
        ss += __shfl_xor(ss, 1); ss += __shfl_xor(ss, 2); ss += __shfl_xor(ss, 4);
        const float rstd = __builtin_amdgcn_rsqf(ss * (1.f / 128.f) + EPSN);
        const float* gn = p.a_norm + l * 512 + nch0;
        unsigned o[8];
#pragma unroll
        for (int q = 0; q < 8; ++q) { const unsigned gw = q < 4 ? g0[q & 3] : g1[q & 3];
            const float y0 = x[2 * q] * rstd * gn[2 * q] * __uint_as_float(gw << 16), y1 = x[2 * q + 1] * rstd * gn[2 * q + 1] * __uint_as_float(gw & 0xffff0000u); o[q] = pk2(y0, y1); }
        bf16_t* op = (bf16_t*)(p.ws + WS_OA) + (size_t)(lt0 + nt) * 1536 + nch0;
        *(u32x4*)op = (u32x4){o[0], o[1], o[2], o[3]}; *(u32x4*)(op + 8) = (u32x4){o[4], o[5], o[6], o[7]};
    }
    __syncthreads();
}

DI void scanC_ssd(CParams& p, unsigned char* lds, int l, int hf, int c, int g, int rmode = 0) {
    const int tid = get_tid(), lane = tid & 63, wave = __builtin_amdgcn_readfirstlane(tid >> 6), l31 = lane & 31, lh = lane >> 5;
    const bf16_t* PROJT = (const bf16_t*)(p.ws + WS_PROJ);
    const bf16_t* PROJG = (const bf16_t*)(p.ws + WS_PROJG);
    bf16_t* XT = (bf16_t*)lds;
    bf16_t* BM = (bf16_t*)(lds + 36864);
    bf16_t* CM = (bf16_t*)(lds + 46080);
    float* CB = (float*)(lds + 55296);
    float* ACUM = (float*)(lds + 72704);
    float* DTS = (float*)(lds + 74752);
    float* SSQ = (float*)(lds + 76800);
    float* EAC = (float*)(lds + 77824);
    const int lt0 = c * 64; bool hp, hn; chunk_halo(hf, c, hp, hn);
    const int hh = wave >> 1, th = wave & 1, head = g * 4 + hh;
    bf16x8 sfr[2][4];
    const bf16_t* SBp = (const bf16_t*)(p.ws + WS_SB) + (size_t)((c * 16 + head) * 2) * 4096 + l31 * 64 + 8 * lh;
#pragma unroll
    for (int ct = 0; ct < 2; ++ct)
#pragma unroll
        for (int ks = 0; ks < 4; ++ks) sfr[ct][ks] = *(const bf16x8*)(SBp + ct * 2048 + ks * 16);
    const int zt = tid >> 3, zpart = tid & 7;
    u32x4 zreg[4];
#pragma unroll
    for (int j = 0; j < 4; ++j) zreg[j] = *(const u32x4*)(PROJG + (size_t)(lt0 + zt) * NG + G_Z + g * 256 + zpart * 32 + 8 * j);
    bf16_t* ZT = (bf16_t*)(lds + 36864);
    bf16_t* YT = (bf16_t*)lds;
    Conv8In cin[6];
#ifdef PROBE_SSD
    if (rmode != 5)
#endif
    {
#pragma unroll
    for (int r = 0; r < 4; ++r) { const int it = tid + r * NTHR, cl = it >> 3, sg = it & 7; cin[r] = conv8_load(PROJT, lt0, sg, g * 256 + cl, hp, hn); }
#pragma unroll
    for (int r = 0; r < 2; ++r) { const int it = tid + r * NTHR, nn = it >> 3, sg = it & 7; const int isC = nn >> 6, n = nn & 63; cin[4 + r] = conv8_load(PROJT, lt0, sg, 1024 + isC * 256 + g * 64 + n, hp, hn); }
    }
    {
        const int d = wave & 1; float dt, a, ac, total; ssd_dt(p, PROJT, l, lt0, head, d, lane, dt, a, ac, total);
        const float av = (d == 0) ? ac : (total - ac + a); ACUM[wave * 64 + lane] = av; DTS[wave * 64 + lane] = dt; EAC[wave * 64 + lane] = __expf(av);
    }
#ifdef PROBE_SSD
    if (rmode != 5)
#endif
    {
#pragma unroll
    for (int r = 0; r < 4; ++r) { const int it = tid + r * NTHR, cl = it >> 3, sg = it & 7; float y[8]; conv8_math(cin[r], sg, lds, cl, y); *(u32x4*)(XT + cl * 72 + sg * 8) = pack8(y); }
#pragma unroll
    for (int r = 0; r < 2; ++r) { const int it = tid + r * NTHR, nn = it >> 3, sg = it & 7; const int isC = nn >> 6, n = nn & 63; float y[8]; conv8_math(cin[4 + r], sg, lds, 256 + nn, y);
        bf16_t* dst = (isC ? CM : BM) + (sg * 8) * 72 + n;
#pragma unroll
        for (int j = 0; j < 8; ++j) dst[j * 72] = (bf16_t)f2bf(y[j]); }
    }
    __syncthreads();
    if (wave < 4) { const int tr = wave >> 1, tc = wave & 1; f32x16 acc = zero16();
#pragma unroll
        for (int ks = 0; ks < 4; ++ks) { const bf16x8 a = *(const bf16x8*)(CM + (tr * 32 + l31) * 72 + ks * 16 + 8 * lh), b = *(const bf16x8*)(BM + (tc * 32 + l31) * 72 + ks * 16 + 8 * lh); acc = mfma32(a, b, acc); }
#pragma unroll
        for (int i = 0; i < 16; ++i) { const int t = tr * 32 + 8 * (i >> 2) + 4 * lh + (i & 3); CB[t * 68 + tc * 32 + l31] = acc[i]; }
    }
    __syncthreads();
    f32x16 acc[2]; acc[0] = zero16(); acc[1] = zero16();
    {
        const int t = th * 32 + l31;
#pragma unroll 1
        for (int d = 0; d < 2; ++d) { const int combo = hh * 2 + d;
#ifdef PROBE_SSD
            if (rmode == 4) break;
#endif
            bf16x8 nxt[2][4];
            if (d == 0) {
#pragma unroll
            for (int ct = 0; ct < 2; ++ct)
#pragma unroll
                for (int ks = 0; ks < 4; ++ks) nxt[ct][ks] = *(const bf16x8*)(SBp + 4096 + ct * 2048 + ks * 16);
            }
            const float at = ACUM[combo * 64 + t];
#pragma unroll
            for (int ks = 0; ks < 4; ++ks) { if ((d == 0 && th == 0 && ks >= 2) || (d == 1 && th == 1 && ks < 2)) continue;
                const int s0 = ks * 16 + 8 * lh; float m[8];
                const f32x4 c0 = *(const f32x4*)(CB + t * 68 + s0), c1 = *(const f32x4*)(CB + t * 68 + s0 + 4);
                const f32x4 a0 = *(const f32x4*)(ACUM + combo * 64 + s0), a1 = *(const f32x4*)(ACUM + combo * 64 + s0 + 4);
                const f32x4 d0 = *(const f32x4*)(DTS + combo * 64 + s0), d1 = *(const f32x4*)(DTS + combo * 64 + s0 + 4);
#pragma unroll
                for (int j = 0; j < 8; ++j) { const int s = s0 + j; const bool keep = (d == 0) ? (t >= s) : (t <= s); const float cbv = j < 4 ? c0[j & 3] : c1[j & 3], as = j < 4 ? a0[j & 3] : a1[j & 3], ds = j < 4 ? d0[j & 3] : d1[j & 3];
                    m[j] = keep ? cbv * __expf(fminf(at - as, 0.f)) * ds : 0.f; }
                u32x4 o; o.x = pk2(m[0], m[1]); o.y = pk2(m[2], m[3]); o.z = pk2(m[4], m[5]); o.w = pk2(m[6], m[7]); const bf16x8 a = __builtin_bit_cast(bf16x8, o);
#pragma unroll
                for (int ct = 0; ct < 2; ++ct) { const bf16x8 b = *(const bf16x8*)(XT + (hh * 64 + ct * 32 + l31) * 72 + s0); acc[ct] = mfma32(a, b, acc[ct]); } }
            f32x16 acc2[2]; acc2[0] = zero16(); acc2[1] = zero16();
#pragma unroll
            for (int ks = 0; ks < 4; ++ks) { const bf16x8 a = *(const bf16x8*)(CM + (th * 32 + l31) * 72 + ks * 16 + 8 * lh);
#pragma unroll
                for (int ct = 0; ct < 2; ++ct) acc2[ct] = mfma32(a, sfr[ct][ks], acc2[ct]); }
#pragma unroll
            for (int g4 = 0; g4 < 4; ++g4) { const f32x4 sc4 = *(const f32x4*)(EAC + combo * 64 + th * 32 + 8 * g4 + 4 * lh);
#pragma unroll
                for (int q = 0; q < 4; ++q) { const int i = 4 * g4 + q; acc[0][i] += sc4[q] * acc2[0][i]; acc[1][i] += sc4[q] * acc2[1][i]; } }
#pragma unroll
            for (int ct = 0; ct < 2; ++ct)
#pragma unroll
                for (int ks = 0; ks < 4; ++ks) sfr[ct][ks] = nxt[ct][ks];
        }
    }
    __syncthreads();
#pragma unroll
    for (int j = 0; j < 4; ++j) *(u32x4*)(ZT + zt * 264 + zpart * 32 + 8 * j) = zreg[j];
    __syncthreads();
    {
        const float dsk = p.d_skip[l * 16 + head]; float part[16];
#pragma unroll
        for (int g4 = 0; g4 < 4; ++g4) { const int tb = th * 32 + 8 * g4 + 4 * lh;
            const u32x2 xr0 = *(const u32x2*)(XT + (hh * 64 + l31) * 72 + tb), xr1 = *(const u32x2*)(XT + (hh * 64 + 32 + l31) * 72 + tb);
#pragma unroll
            for (int q = 0; q < 4; ++q) { const int i = 4 * g4 + q, ti = tb + q; float pt = 0.f;
#pragma unroll
                for (int ct = 0; ct < 2; ++ct) { const int pc = ct * 32 + l31; const unsigned xw = (ct == 0) ? (q < 2 ? xr0.x : xr0.y) : (q < 2 ? xr1.x : xr1.y);
                    const float xv = __uint_as_float((q & 1) ? (xw & 0xffff0000u) : (xw << 16)); const float z = bf2f(ZT[ti * 264 + hh * 64 + pc]);
                    const float y = (acc[ct][i] + dsk * xv) * z;   acc[ct][i] = y; pt += y * y; }
                part[i] = pt; } }
        const bool b4 = (l31 & 16) != 0, b3 = (l31 & 8) != 0, b2 = (l31 & 4) != 0, b1 = (l31 & 2) != 0;
        float p8[8], p4[4], p2[2], p1;
#pragma unroll
        for (int j = 0; j < 8; ++j) { const float snd = b4 ? part[j] : part[j + 8], kp = b4 ? part[j + 8] : part[j]; p8[j] = kp + __shfl_xor(snd, 16); }
#pragma unroll
        for (int j = 0; j < 4; ++j) { const float snd = b3 ? p8[j] : p8[j + 4], kp = b3 ? p8[j + 4] : p8[j]; p4[j] = kp + __shfl_xor(snd, 8); }
#pragma unroll
        for (int j = 0; j < 2; ++j) { const float snd = b2 ? p4[j] : p4[j + 2], kp = b2 ? p4[j + 2] : p4[j]; p2[j] = kp + __shfl_xor(snd, 4); }
        { const float snd = b1 ? p2[0] : p2[1], kp = b1 ? p2[1] : p2[0]; p1 = kp + __shfl_xor(snd, 2); }
        p1 += __shfl_xor(p1, 1);
        const int irow = l31 >> 1; const int tir = th * 32 + 8 * (irow >> 2) + 4 * lh + (irow & 3);
        if ((l31 & 1) == 0) SSQ[hh * 64 + tir] = p1;
    }
    __syncthreads();
    {
        const int irow = l31 >> 1; const int tir = th * 32 + 8 * (irow >> 2) + 4 * lh + (irow & 3);
        const float myr = __builtin_amdgcn_rsqf(((SSQ[tir] + SSQ[64 + tir]) + (SSQ[128 + tir] + SSQ[192 + tir])) * (1.f / 256.f) + EPSN);
        const float gn0 = p.b_norm[l * 1024 + g * 256 + hh * 64 + l31], gn1 = p.b_norm[l * 1024 + g * 256 + hh * 64 + 32 + l31];
#pragma unroll
        for (int i = 0; i < 16; ++i) { const int ti = th * 32 + 8 * (i >> 2) + 4 * lh + (i & 3); const float rstd = __shfl(myr, lh * 32 + 2 * i);
            YT[ti * 264 + hh * 64 + l31] = (bf16_t)f2bf(acc[0][i] * rstd * gn0); YT[ti * 264 + hh * 64 + 32 + l31] = (bf16_t)f2bf(acc[1][i] * rstd * gn1); }
    }
    __syncthreads();
    {
        bf16_t* YB = (bf16_t*)(p.ws + WS_OA) + (size_t)(lt0 + zt) * 1536 + 512 + g * 256 + zpart * 32;
#pragma unroll
        for (int j = 0; j < 4; ++j) {
#ifdef PROBE_SSD
            if (rmode >= 3) break;
#endif
            *(u32x4*)(YB + 8 * j) = *(const u32x4*)(YT + zt * 264 + zpart * 32 + 8 * j); }
    }
    __syncthreads();
}
DI void phase_scanC(CParams& p, unsigned char* lds, int l, int hf, int bid, int nb, int rmode = 0) {
    int cwg = -1; const int tid0 = get_tid();
    for (int it = bid; it < 2 * NCH * 4; it += nb) {
        if ((rmode == 1 || rmode >= 3) && it < NCH * 4) continue; if (rmode == 2 && it >= NCH * 4) continue;
#ifndef NO_C_HGRN
        if (it < NCH * 4) scanC_hgrn(p, lds, l, hf, it >> 2, it & 3);
#endif
#ifndef NO_C_SSD
        if (it >= NCH * 4) { const int j = it - NCH * 4, g = j & 3; if (g != cwg) { __syncthreads(); cw_fill(p, lds, l, g, tid0); __syncthreads(); cwg = g; } scanC_ssd(p, lds, l, hf, j >> 2, g, rmode); }
#endif
    }
}

template <class Epi> DI void run_gemm(unsigned char* lds, const bf16_t* A, const bf16_t* Bt, int M, int N, int K, const Epi& E, int bid, int nb) {
    asm volatile("" : "+s"(N), "+s"(K), "+s"(M));
    pg8::Gemm g{A, Bt, M, N, K}; pg8::StaticOrder S; S.init(M, N, nb, bid);
    pg8::gemm_phase<Epi, pg8::StaticOrder, false>((PG8_LAS unsigned char*)lds, g, S, E, nullptr);
    __syncthreads();
}

DI void run_phase(CParams& p, unsigned char* lds, int ph, int bid, int nb, int rmode = 0) {
    unsigned char* ws = p.ws;
    if (ph == 0) { phase_init(p, lds, bid, nb); __syncthreads(); phase_wconv(p, lds, 0, bid, nb, 0, WC_NIT); return; }
    if (ph == 89) { phase_final_norm(p, bid, nb); return; }
    const int q = ph - 1; const int lh2 = q / 11, sub = q % 11; const int l = lh2 >> 1, hf = lh2 & 1;
    const float* MODL = (const float*)(ws + WS_MOD) + (size_t)l * 5 * 6144;
    const unsigned char* wl = ws + ((l & 1) ? WS_W2OFS : 0);
#ifndef PH_MASK
#define PH_MASK 0xFFFF
#endif
#define PH_ON(i) ((PH_MASK >> (i)) & 1)
    switch (sub) {
    case 0: if (PH_ON(0)) { if (hf == 0 && l == 0) phase_norm(p, 0, 0, 0, bid, nb); } break;
    case 1: if (PH_ON(1)) { pg8::EpiBf16Act E1{(bf16_t*)(ws + WS_PROJ), HT, 2, 0, 9999}; run_gemm(lds, (const bf16_t*)(wl + WS_WIN), (const bf16_t*)(ws + WS_U), NTROW, HT, 1024, E1, bid, nb);
              pg8::EpiBf16Act E2{(bf16_t*)(ws + WS_PROJG), NG, 0, 6, 6}; run_gemm(lds, (const bf16_t*)(ws + WS_U), (const bf16_t*)(wl + WS_WIN) + (size_t)NTROW * 1024, HT, NG, 1024, E2, bid, nb); } break;
    case 2: if (PH_ON(2)) phase_scanA(p, lds, l, hf, bid, nb, rmode); break;
    case 3: if (PH_ON(3)) phase_scanB(p, l, hf, bid, nb); break;
    case 4: if (PH_ON(4)) phase_scanC(p, lds, l, hf, bid, nb, rmode); break;
    case 5: if (PH_ON(5)) { wconv_side(p, lds, l, hf, bid, nb, hf ? 4600 : 0, hf ? 6300 : 1700); pg8::EpiGateMerge E{(bf16_t*)(ws + WS_U), (const bf16_t*)(ws + WS_PROJG), NG, G_GATE, G_GATE + 1024};
              run_gemm(lds, (const bf16_t*)(ws + WS_OA), (const bf16_t*)(wl + WS_WBRA), HT, 1024, 1536, E, bid, nb); } break;
    case 6: if (PH_ON(6)) { wconv_side(p, lds, l, hf, bid, nb, hf ? 6300 : 1700, hf ? 7100 : 2500); pg8::EpiResid E{p.out, MODL + 2048, hf * HT, l == 0 ? p.x_prompt : nullptr, l == 0 ? p.x_sample : nullptr}; run_gemm(lds, (const bf16_t*)(ws + WS_U), (const bf16_t*)(wl + WS_WOUT), HT, 1024, 1024, E, bid, nb); } break;
    case 7: if (PH_ON(7)) phase_norm(p, l, hf, 1, bid, nb); break;
    case 8: if (PH_ON(8)) { pg8::EpiBf16<0> E{(bf16_t*)(ws + WS_PROJ), NUP, nullptr, 0, 0}; run_gemm(lds, (const bf16_t*)(ws + WS_U), (const bf16_t*)(wl + WS_WUP), HT, NUP, 1024, E, bid, nb); } break;
    case 9: if (PH_ON(9)) phase_convact(p, l, hf, bid, nb); break;
    case 10: if (PH_ON(10)) { wconv_side(p, lds, l, hf, bid, nb, hf ? 7100 : 2500, hf ? WC_NIT : 4600); pg8::EpiResid E{p.out, MODL + 5120, hf * HT, nullptr, nullptr}; run_gemm(lds, (const bf16_t*)(ws + WS_SA), (const bf16_t*)(wl + WS_WDN), HT, 1024, DFF, E, bid, nb);
               if (lh2 < 7) phase_norm(p, (lh2 + 1) >> 1, (lh2 + 1) & 1, 0, bid, nb); } break;
    }
}
constexpr int NPHASE = 90;

#define LAS __attribute__((address_space(3)))
#define XB_TMO      128
#define XB_XCNT(j)  (256  + 64 * (j))
#define XB_XSUB(j)  (1280 + 64 * (j))
#define XB_XGEN(j)  (2304 + 64 * (j))
#define XB_TOP      3328
#define XB_TOPGEN   3392
#define XCD_BAR_WORDS 3456
#define XB_SPIN_CAP (1u << 18)

__device__ __forceinline__ unsigned xb_ld(unsigned* p)              { return __hip_atomic_load(p, __ATOMIC_RELAXED, __HIP_MEMORY_SCOPE_AGENT); }
__device__ __forceinline__ unsigned xb_add(unsigned* p, unsigned v) { return __hip_atomic_fetch_add(p, v, __ATOMIC_RELAXED, __HIP_MEMORY_SCOPE_AGENT); }
__device__ __forceinline__ unsigned xb_xcc_id() { return (unsigned)__builtin_amdgcn_s_getreg((3 << 11) | 20) & 0xFu; }
#define XB_SPIN(cond, bar) do { unsigned _sp = 0; while (cond) { __builtin_amdgcn_s_sleep(1); \
    if ((++_sp & 255u) == 0u) { if (xb_ld(&(bar)[XB_TMO])) break; if (_sp > XB_SPIN_CAP) { atomicAdd(&(bar)[XB_TMO], 1u); break; } } } } while (0)

struct XcdBarrier {
    unsigned* bar; unsigned x;
    volatile LAS unsigned* st;
};

__device__ __forceinline__ XcdBarrier xcd_barrier_post(unsigned* bar, volatile LAS unsigned* st) {
    XcdBarrier b; b.bar = bar; b.x = xb_xcc_id(); b.st = st;
    if (threadIdx.x == 0) (void)xb_add(&bar[XB_XCNT(b.x)], 1u);
    return b;
}
__device__ __forceinline__ void xcd_barrier_complete(unsigned* bar, unsigned x, unsigned& nloc, unsigned& nx) {
    const unsigned G = gridDim.x * gridDim.y * gridDim.z;
    unsigned sum, cnt, mine, sp = 0u;
    for (;;) {
        sum = 0u; cnt = 0u; mine = 0u;
#pragma unroll
        for (unsigned j = 0; j < 16; ++j) { const unsigned c = xb_ld(&bar[XB_XCNT(j)]); sum += c; cnt += (c > 0u) ? 1u : 0u; mine = (j == x) ? c : mine; }
        if (sum == G) break;
        __builtin_amdgcn_s_sleep(1);
        if ((++sp & 255u) == 0u) { if (xb_ld(&bar[XB_TMO])) break; if (sp > XB_SPIN_CAP) { atomicAdd(&bar[XB_TMO], 1u); break; } }
    }
    nloc = mine > 0u ? mine : 1u; nx = cnt > 0u ? cnt : 1u;
}

__device__ __forceinline__ void xcd_barrier(const XcdBarrier& b) {
    asm volatile("s_waitcnt vmcnt(0)" ::: "memory");
    __syncthreads();
    if (threadIdx.x == 0) {
        unsigned* bar = b.bar;
        __builtin_amdgcn_s_waitcnt(0);
        unsigned nloc = b.st[0], nx = b.st[1];
        if (nloc == 0u) { xcd_barrier_complete(bar, b.x, nloc, nx); b.st[0] = nloc; b.st[1] = nx; }
        const unsigned old = xb_add(&bar[XB_XSUB(b.x)], 1u);
        const unsigned gen = old / nloc;
        if (old + 1u == (gen + 1u) * nloc) {
            __builtin_amdgcn_fence(__ATOMIC_RELEASE, "agent");
            asm volatile("s_waitcnt vmcnt(0)" ::: "memory");
            const unsigned og = xb_add(&bar[XB_TOP], 1u);
            const unsigned tg = og / nx;
            if (og + 1u == (tg + 1u) * nx) xb_add(&bar[XB_TOPGEN], 1u);
            else XB_SPIN(xb_ld(&bar[XB_TOPGEN]) == tg, bar);
            __builtin_amdgcn_fence(__ATOMIC_ACQUIRE, "agent");
            xb_add(&bar[XB_XGEN(b.x)], 1u);
            asm volatile("s_waitcnt vmcnt(0)" ::: "memory");
        } else {
            XB_SPIN(xb_ld(&bar[XB_XGEN(b.x)]) == gen, bar);
            __builtin_amdgcn_fence(__ATOMIC_ACQUIRE, "agent");
            asm volatile("s_waitcnt vmcnt(0)" ::: "memory");
        }
    }
    __syncthreads();
}

constexpr size_t WS_BAR = 3 * MiB + 512 * 1024;
__global__ void __launch_bounds__(512, 2) mega_fwd(Params p_unused) {
    extern __shared__ __attribute__((aligned(16))) unsigned char lds[];
    const int bid = blockIdx.x, nb = gridDim.x;
    CParams* pk = (CParams*)__builtin_amdgcn_kernarg_segment_ptr();
    volatile LAS unsigned* st = (volatile LAS unsigned*)((LAS unsigned char*)lds + 131072);
    if (threadIdx.x == 0) { st[0] = 0u; st[1] = 0u; }
    __syncthreads();
    unsigned* barw = (unsigned*)(pk->ws + WS_BAR);
    if (bid == 0) { for (int i = threadIdx.x; i < XCD_BAR_WORDS; i += NTHR) barw[i] = 0u; }
    {
        CParams* q = pk; asm volatile("" : "+s"(q));
        run_phase(*q, lds, 0, bid, nb);
    }
    cg::this_grid().sync();
    (void)xcd_barrier_post(barw, st);
    for (int ph = 1; ph < NPHASE; ++ph) {
        if (ph > 1 && ph < 89 && (ph - 1) % 11 == 0) continue;
        CParams* q = pk; int z_ = 0, b_ = bid, n_ = nb; asm volatile("" : "+s"(q), "+s"(z_), "+s"(b_), "+s"(n_));
        run_phase(*q, lds + z_, ph, b_, n_);
#ifndef RPT_MODE
#define RPT_MODE 0
#endif
#ifdef RPT_MASK
        if (ph < 89 && ((RPT_MASK >> ((ph - 1) % 11)) & 1)) { { XcdBarrier xb; xb.bar = (unsigned*)(q->ws + WS_BAR); xb.x = xb_xcc_id(); xb.st = st; xcd_barrier(xb); }
            CParams* q2 = pk; int z2_ = 0, b2_ = bid, n2_ = nb; asm volatile("" : "+s"(q2), "+s"(z2_), "+s"(b2_), "+s"(n2_)); run_phase(*q2, lds + z2_, ph, b2_, n2_, RPT_MODE); }
#endif
#ifdef RPT_AB
        if (ph < 89 && ((ph - 1) % 11) == 3) { for (int rr = 0; rr < 2; ++rr) { { XcdBarrier xb; xb.bar = (unsigned*)(q->ws + WS_BAR); xb.x = xb_xcc_id(); xb.st = st; xcd_barrier(xb); }
            CParams* q2 = pk; int z2_ = 0, b2_ = bid, n2_ = nb; asm volatile("" : "+s"(q2), "+s"(z2_), "+s"(b2_), "+s"(n2_)); run_phase(*q2, lds + z2_, ph - 1 + rr, b2_, n2_, 0); } }
#endif
        if (ph + 1 < NPHASE) { XcdBarrier xb; xb.bar = (unsigned*)(q->ws + WS_BAR); xb.x = xb_xcc_id(); xb.st = st; xcd_barrier(xb); }
    }
}

constexpr int LDS_BYTES = 131072 + 256;
extern "C" void kernel_launch(void* const* d_in, const int* in_sizes, int n_in, void* d_out, int out_size, void* d_ws, size_t ws_size, hipStream_t stream) {
    static int grid = 0;
    if (grid == 0) {
        if (n_in != 27 || ws_size < WS_END) { fprintf(stderr, "kernel_launch: unexpected n_in %d / ws_size %zu\n", n_in, ws_size); grid = -1; return; }
        int dev = 0, cus = 0, per_cu = 0;
        hipGetDevice(&dev); hipDeviceGetAttribute(&cus, hipDeviceAttributeMultiprocessorCount, dev);
        if (hipFuncSetAttribute((const void*)mega_fwd, hipFuncAttributeMaxDynamicSharedMemorySize, LDS_BYTES) != hipSuccess) { fprintf(stderr, "hipFuncSetAttribute failed\n"); grid = -1; return; }
        if (hipOccupancyMaxActiveBlocksPerMultiprocessor(&per_cu, (const void*)mega_fwd, 512, LDS_BYTES) != hipSuccess || per_cu < 1) { fprintf(stderr, "occupancy query: %d\n", per_cu); per_cu = 1; }
        (void)hipGetLastError();
        grid = cus * 1;
    }
    if (grid < 0) return;
    Params p{};
    const float** pp = (const float**)&p;
    for (int i = 0; i < 27; ++i) pp[i] = (const float*)d_in[i];
    p.out = (float*)d_out; p.ws = (unsigned char*)d_ws;
    p.ph_lo = 0; p.ph_hi = NPHASE;
    void* args[] = {&p};
    hipError_t e = hipLaunchCooperativeKernel((const void*)mega_fwd, dim3(grid), dim3(512), args, LDS_BYTES, stream);
    if (e != hipSuccess) fprintf(stderr, "cooperative launch failed: %s (grid %d)\n", hipGetErrorString(e), grid);
}
```
